# Optimizing an MI355X kernel written in HIP

```python
import math
import jax, jax.numpy as jnp
from jax import lax
import numpy as np

D_MODEL = 1024
BATCH = 4
SEQ = 4096
DEPTH = 2

CHUNK = 64
Q_BLOCK = 128
A_WIDTH = D_MODEL // 2
A_GROUPS = 4
A_GROUP_DIM = A_WIDTH // A_GROUPS
A_BLOCK = 128
B_HEADS = 4
B_HEAD_DIM = 64
B_V_DIM = 2 * B_HEAD_DIM
B_QK = B_HEADS * 2 * B_HEAD_DIM
B_VW = B_HEADS * B_V_DIM
C_WIDTH = D_MODEL // 2
CONV_K = 3
N_BRANCH = 3
D_FF = 4 * D_MODEL
SPLIT_SIZES = [A_WIDTH, A_WIDTH, B_QK, B_QK, B_VW, C_WIDTH, C_WIDTH, C_WIDTH, N_BRANCH * D_MODEL]
N_IN = int(sum(SPLIT_SIZES))
SPLIT_IDX = [int(v) for v in np.cumsum(SPLIT_SIZES)[:-1]]
EPS = 1e-6

kernel_name = "hybrid_gmlp_diffattn_shortconv_block"


def rms_norm(x, w):
    xf = x.astype(jnp.float32)
    y = xf * lax.rsqrt(jnp.mean(xf * xf, axis=-1, keepdims=True) + EPS)
    return (y * w.astype(jnp.float32)).astype(x.dtype)


def alibi_slopes(n_heads):
    return 2.0 ** (-8.0 * jnp.arange(1, n_heads + 1, dtype=jnp.float32) / n_heads)


def gmlp_spatial_gating(a_u, a_v, vnorm_w, ws, bs):
    b, s, _ = a_u.shape
    u = jax.nn.gelu(a_u)
    v = rms_norm(jax.nn.gelu(a_v), vnorm_w)
    vb = v.reshape(b, s // A_BLOCK, A_BLOCK, A_GROUPS, A_GROUP_DIM)
    causal = jnp.tril(jnp.ones((A_BLOCK, A_BLOCK), dtype=ws.dtype))
    ws_c = ws * causal[None]
    sv = jnp.einsum('gts,bnsgc->bntgc', ws_c, vb) + bs.T[:, :, None]
    return u * sv.reshape(b, s, A_WIDTH)


def differential_attention(q, k, v, lam, slopes):
    s_len = q.shape[1]
    scale = B_HEAD_DIM ** -0.5
    outs = []
    for i in range(s_len // Q_BLOCK):
        kv_len = (i + 1) * Q_BLOCK
        q_blk = q[:, i * Q_BLOCK:kv_len]
        k_blk = k[:, :kv_len]
        v_blk = v[:, :kv_len]
        sc = jnp.einsum('bqhmd,bkhmd->bhmqk', q_blk, k_blk).astype(jnp.float32) * scale
        qpos = i * Q_BLOCK + jnp.arange(Q_BLOCK)
        kpos = jnp.arange(kv_len)
        dist = jnp.abs(qpos[:, None] - kpos[None, :]).astype(jnp.float32)
        bias = -slopes[:, None, None, None] * dist
        mask = (kpos[None, :] // CHUNK) <= (qpos[:, None] // CHUNK)
        p = jax.nn.softmax(jnp.where(mask, sc + bias, -jnp.inf), axis=-1)
        a = p[:, :, 0] - lam * p[:, :, 1]
        outs.append(jnp.einsum('bhqk,bkhe->bqhe', a.astype(v.dtype), v_blk))
    return jnp.concatenate(outs, axis=1)


def causal_depthwise_conv(z, w):
    kern = w.astype(z.dtype)[:, None, :]
    return lax.conv_general_dilated(z, kern, window_strides=(1,), padding=[(CONV_K - 1, 0)],
                                    dimension_numbers=('NWC', 'WIO', 'NWC'),
                                    feature_group_count=z.shape[-1])


def setup_inputs(seed: int = 0) -> dict:
    key = jax.random.key(seed)
    ks = jax.random.split(key, 24)
    L, D = DEPTH, D_MODEL
    nrm = lambda k, shape, sc: jax.random.normal(k, shape, jnp.float32) * sc
    tri = jnp.tril(jnp.ones((A_BLOCK, A_BLOCK), jnp.float32))
    return {
        "x": nrm(ks[0], (BATCH, SEQ, D), 1.0),
        "norm1_w": 1.0 + nrm(ks[1], (L, D), 0.02),
        "w_in": nrm(ks[2], (L, D, N_IN), D ** -0.5),
        "gate_b": nrm(ks[3], (L, N_BRANCH, D), 0.02),
        "a_vnorm_w": 1.0 + nrm(ks[4], (L, A_WIDTH), 0.02),
        "a_ws": nrm(ks[5], (L, A_GROUPS, A_BLOCK, A_BLOCK), 0.5 * A_BLOCK ** -0.5) * tri,
        "a_bs": 1.0 + nrm(ks[6], (L, A_GROUPS, A_BLOCK), 0.02),
        "b_qnorm_w": 1.0 + nrm(ks[7], (L, 2, B_HEAD_DIM), 0.02),
        "b_knorm_w": 1.0 + nrm(ks[8], (L, 2, B_HEAD_DIM), 0.02),
        "b_lam": nrm(ks[9], (L, 4, B_HEAD_DIM), 0.1),
        "b_subnorm_w": 1.0 + nrm(ks[10], (L, B_V_DIM), 0.02),
        "c_conv_w": nrm(ks[11], (L, CONV_K, C_WIDTH), CONV_K ** -0.5),
        "w_br_a": nrm(ks[12], (L, A_WIDTH, D), A_WIDTH ** -0.5),
        "w_br_b": nrm(ks[13], (L, B_VW, D), B_VW ** -0.5),
        "w_br_c": nrm(ks[14], (L, C_WIDTH, D), C_WIDTH ** -0.5),
        "w_out": nrm(ks[15], (L, D, D), D ** -0.5),
        "norm2_w": 1.0 + nrm(ks[16], (L, D), 0.02),
        "w_ff1": nrm(ks[17], (L, D, D_FF), D ** -0.5),
        "w_ff2": nrm(ks[18], (L, D_FF, D), D_FF ** -0.5),
    }


def reference(x, norm1_w, w_in, gate_b, a_vnorm_w, a_ws, a_bs, b_qnorm_w, b_knorm_w, b_lam,
              b_subnorm_w, c_conv_w, w_br_a, w_br_b, w_br_c, w_out, norm2_w, w_ff1, w_ff2):
    b, s, d = x.shape
    slopes = alibi_slopes(B_HEADS)
    for l in range(DEPTH):
        h = rms_norm(x, norm1_w[l])
        proj = h @ w_in[l]
        a_u, a_v, q, k, v, c_b, c_c, c_x, g_pre = jnp.split(proj, SPLIT_IDX, axis=-1)

        y_a = gmlp_spatial_gating(a_u, a_v, a_vnorm_w[l], a_ws[l], a_bs[l])

        q = rms_norm(q.reshape(b, s, B_HEADS, 2, B_HEAD_DIM), b_qnorm_w[l])
        k = rms_norm(k.reshape(b, s, B_HEADS, 2, B_HEAD_DIM), b_knorm_w[l])
        v = v.reshape(b, s, B_HEADS, B_V_DIM)
        lam_p = b_lam[l].astype(jnp.float32)
        lambda_init = 0.8 - 0.6 * math.exp(-0.3 * l)
        lam = (jnp.exp(jnp.sum(lam_p[0] * lam_p[1])) - jnp.exp(jnp.sum(lam_p[2] * lam_p[3]))
               + lambda_init)
        o = differential_attention(q, k, v, lam, slopes)
        o = rms_norm(o, b_subnorm_w[l]) * (1.0 - lambda_init)
        y_b = o.reshape(b, s, B_VW)

        y_c = c_b * causal_depthwise_conv(c_c * c_x, c_conv_w[l])

        gates = jax.nn.sigmoid((g_pre.reshape(b, s, N_BRANCH, d) + gate_b[l]).astype(jnp.float32)).astype(x.dtype)
        merged = (gates[:, :, 0] * (y_a @ w_br_a[l])
                  + gates[:, :, 1] * (y_b @ w_br_b[l])
                  + gates[:, :, 2] * (y_c @ w_br_c[l]))
        x = x + merged @ w_out[l]

        h2 = rms_norm(x, norm2_w[l])
        x = x + jnp.square(jax.nn.relu(h2 @ w_ff1[l])) @ w_ff2[l]
    return x
```

```cpp
#include <hip/hip_runtime.h>
#include <hip/hip_cooperative_groups.h>
#include <cstdio>
#include <cstdint>
namespace cg = cooperative_groups;

#ifndef MK_MULTI
#define MK_MULTI 0
#endif

namespace pg8 {
#define PG8_LAS __attribute__((address_space(3)))
typedef unsigned short bf16_t;
typedef short bf16x8 __attribute__((ext_vector_type(8)));
typedef float f32x4 __attribute__((ext_vector_type(4)));
typedef unsigned u32x4 __attribute__((ext_vector_type(4)));
typedef unsigned u32x2 __attribute__((ext_vector_type(2)));
constexpr int BM = 256, BK = 64, HALF = 128, HTB = HALF * BK * 2, STAGE_BYTES = 8 * HTB, NXCD = 8, WGM = 8;

__host__ __device__ __forceinline__ int lds_byte(int r, int c) { const int st = (r >> 4) * 2 + (c >> 5), rr = r & 15, cc = c & 31, ob = rr * 64 + cc * 2; return st * 1024 + (ob ^ (((ob >> 9) & 1) << 5)); }
__host__ __device__ __forceinline__ void stage_rc(int b, int& R, int& C) { const int st = b / 1024, sb = b % 1024, swz = sb ^ (((sb >> 9) & 1) << 5); R = (st >> 1) * 16 + swz / 64; C = (st & 1) * 32 + (swz % 64) / 2; }
__host__ __device__ __forceinline__ int perm32(int rho) { const int n = rho >> 4, i = rho & 15; return 8 * (i >> 2) + 4 * n + (i & 3); }

struct Unit { int pm, pn, j; };
struct Gemm { const bf16_t* A; const bf16_t* Bt; int lda, K; size_t a_j1, a_j2, b_j;
    __device__ __forceinline__ size_t aoff(int j) const { return j == 0 ? (size_t)0 : (j == 1 ? a_j1 : a_j2); } };

struct StaticOrder {
    int nM, nN, nwg, G, c, NJ;
    __host__ __device__ void init(int M, int N, int G_, int c_, int NJ_ = 1) { nM = M / BM; nN = N / BM; nwg = nM * nN; G = G_; c = c_; NJ = NJ_; }
    __host__ __device__ bool next(int i, Unit& u) const {
        const int ti = i / NJ; u.j = i - ti * NJ;
        const long L = (long)ti * G + c; if (L >= nwg) return false;
        int wgid = (int)L; { const int q = nwg / NXCD, r = nwg % NXCD, xcd = wgid % NXCD, off = wgid / NXCD; wgid = (xcd < r ? xcd * (q + 1) : r * (q + 1) + (xcd - r) * q) + off; }
        const int nig = WGM * nN, gid = wgid / nig, fm = gid * WGM, gsz = (nM - fm) < WGM ? (nM - fm) : WGM;
        u.pm = fm + ((wgid % nig) % gsz); u.pn = (wgid % nig) / gsz; return true;
    }
};

__device__ __forceinline__ unsigned cvt_pk_bf16(float lo, float hi) { unsigned r; asm volatile("v_cvt_pk_bf16_f32 %0, %1, %2" : "=v"(r) : "v"(lo), "v"(hi)); return r; }

template <class Epi, class Sched>
__device__ __forceinline__ void gemm_phase(PG8_LAS unsigned char* lds, const Gemm g, const Sched& S, const Epi& E) {
    int tid_ = threadIdx.x; asm volatile("" : "+v"(tid_));
    const int tid = tid_, wid = __builtin_amdgcn_readfirstlane(tid >> 6), lane = tid & 63, wr = wid >> 2, wc = wid & 3, fr = lane & 15, fq = lane >> 4;
    const int K = g.K, nt = K / BK, lda = g.lda;
    unsigned voffA[2], voffB[2];
#pragma unroll
    for (int i = 0; i < 2; ++i) { int R, C; stage_rc(tid * 16 + i * 8192, R, C); const int Rb = Epi::PERM ? ((R & ~31) + perm32(R & 31)) : R;
        voffA[i] = (unsigned)(R * lda + C) * 2u; voffB[i] = (unsigned)(Rb * K + C) * 2u; }
    const size_t kstep = (size_t)(BK * 2);
    const size_t hstepA = (size_t)HALF * lda * 2, hstepB = (size_t)HALF * K * 2;
    const size_t tstepA = 2 * hstepA, tstepB = 2 * hstepB;
    const unsigned ldsw = (unsigned)wid * 1024u;
    const int aoff = lds_byte(wr * 64 + fr, fq * 8), boff = lds_byte(wc * 32 + fr, fq * 8);
#define PG8_SA(b, h) (((b) * 2 + (h)) * HTB)
#define PG8_SB(b, h) ((4 + (b) * 2 + (h)) * HTB)
#define PG8_STAGE(bufoff, gbase, voff) do { _Pragma("unroll") for (int _i = 0; _i < 2; ++_i) \
        __builtin_amdgcn_global_load_lds((const unsigned*)((const char*)(gbase) + (voff)[_i]), (PG8_LAS unsigned*)(lds + (bufoff) + ldsw + _i * 8192), 16, 0, 0); } while (0)
#define PG8_LDA(dst, b, h) do { _Pragma("unroll") for (int m = 0; m < 4; ++m) _Pragma("unroll") for (int k = 0; k < 2; ++k) dst[m][k] = *(const PG8_LAS bf16x8*)(lds + PG8_SA(b, h) + aoff + m * 2048 + k * 1024); } while (0)
#define PG8_LDB(dst, b, h) do { _Pragma("unroll") for (int n = 0; n < 2; ++n) _Pragma("unroll") for (int k = 0; k < 2; ++k) dst[n][k] = *(const PG8_LAS bf16x8*)(lds + PG8_SB(b, h) + boff + n * 2048 + k * 1024); } while (0)
#define PG8_MMA(ai, bj, At, Bt) do { __builtin_amdgcn_s_setprio(1); _Pragma("unroll") for (int m = 0; m < 4; ++m) _Pragma("unroll") for (int n = 0; n < 2; ++n) _Pragma("unroll") for (int k = 0; k < 2; ++k) \
        acc[ai][bj][m][n] = __builtin_amdgcn_mfma_f32_16x16x32_bf16(Bt[n][k], At[m][k], acc[ai][bj][m][n], 0, 0, 0); __builtin_amdgcn_s_setprio(0); } while (0)
#define PG8_WAIT_V(n) asm volatile("s_waitcnt vmcnt(" #n ")" ::: "memory")
#define PG8_WAIT_L(n) asm volatile("s_waitcnt lgkmcnt(" #n ")" ::: "memory")
#define PG8_BAR __builtin_amdgcn_s_barrier()
#define PG8_SCHED __builtin_amdgcn_sched_barrier(0)
    Unit cur, nxt; int ui = 0;
    if (!S.next(0, cur)) return;
    f32x4 acc[2][2][4][2];
#pragma unroll
    for (int a = 0; a < 2; ++a)
#pragma unroll
        for (int b = 0; b < 2; ++b)
#pragma unroll
            for (int m = 0; m < 4; ++m)
#pragma unroll
                for (int n = 0; n < 2; ++n) acc[a][b][m][n] = (f32x4){0.f, 0.f, 0.f, 0.f};
    bf16x8 At[4][2], B0[2][2], B1[2][2];
    const char* cA = (const char*)g.A + (size_t)cur.pm * tstepA + g.aoff(cur.j); const char* cB = (const char*)g.Bt + (size_t)cur.pn * tstepB + (size_t)cur.j * g.b_j;
    {
        PG8_STAGE(PG8_SB(0, 0), cB, voffB); PG8_STAGE(PG8_SB(0, 1), cB + hstepB, voffB); PG8_STAGE(PG8_SA(0, 0), cA, voffA); PG8_STAGE(PG8_SA(0, 1), cA + hstepA, voffA);
        if (wr == 1) PG8_BAR;
        PG8_WAIT_V(2); PG8_BAR;
        PG8_STAGE(PG8_SB(1, 0), cB + kstep, voffB); PG8_STAGE(PG8_SA(1, 0), cA + kstep, voffA); PG8_STAGE(PG8_SB(1, 1), cB + hstepB + kstep, voffB);
        PG8_WAIT_V(6); PG8_BAR;
    }
    for (;;) {
        const bool has_next = S.next(ui + 1, nxt);
        const char* nA = has_next ? (const char*)g.A + (size_t)nxt.pm * tstepA + g.aoff(nxt.j) : cA; const char* nB = has_next ? (const char*)g.Bt + (size_t)nxt.pn * tstepB + (size_t)nxt.j * g.b_j : cB;
        for (int t = 0; t < nt; t += 2) {
            const bool last = (t == nt - 2);
            const char* a1 = cA + (size_t)(t + 1) * kstep;
            const char* a2 = last ? nA : cA + (size_t)(t + 2) * kstep; const char* b2 = last ? nB : cB + (size_t)(t + 2) * kstep;
            const char* a3 = a2 + kstep; const char* b3 = b2 + kstep;
            PG8_LDB(B0, 0, 0); PG8_LDB(B1, 0, 1); PG8_SCHED; PG8_LDA(At, 0, 0); PG8_STAGE(PG8_SA(1, 1), a1 + hstepA, voffA);
            PG8_WAIT_V(8); PG8_WAIT_L(0); PG8_BAR; PG8_MMA(0, 0, At, B0); PG8_MMA(0, 1, At, B1); PG8_BAR; PG8_SCHED;
            PG8_LDA(At, 0, 1); PG8_STAGE(PG8_SB(0, 0), b2, voffB); PG8_STAGE(PG8_SB(0, 1), b2 + hstepB, voffB); PG8_STAGE(PG8_SA(0, 0), a2, voffA);
            PG8_WAIT_V(8); PG8_WAIT_L(0); PG8_BAR; PG8_MMA(1, 0, At, B0); PG8_MMA(1, 1, At, B1); PG8_BAR; PG8_SCHED;
            PG8_LDB(B0, 1, 0); PG8_LDB(B1, 1, 1); PG8_SCHED; PG8_LDA(At, 1, 0); PG8_STAGE(PG8_SA(0, 1), a2 + hstepA, voffA);
            PG8_WAIT_V(8); PG8_WAIT_L(0); PG8_BAR; PG8_MMA(0, 0, At, B0); PG8_MMA(0, 1, At, B1); PG8_BAR; PG8_SCHED;
            PG8_LDA(At, 1, 1); PG8_STAGE(PG8_SB(1, 0), b3, voffB); PG8_STAGE(PG8_SB(1, 1), b3 + hstepB, voffB); PG8_STAGE(PG8_SA(1, 0), a3, voffA);
            PG8_WAIT_V(8); PG8_WAIT_L(0); PG8_BAR; PG8_MMA(1, 0, At, B0); PG8_MMA(1, 1, At, B1); PG8_BAR; PG8_SCHED;
        }
        if (wr == 0) PG8_BAR;
        E(acc, cur, wr, wc, fr, fq);
        if (!has_next) break;
        if (!(Epi::ACCUM && nxt.j != 0)) {
#pragma unroll
        for (int a = 0; a < 2; ++a)
#pragma unroll
            for (int b = 0; b < 2; ++b)
#pragma unroll
                for (int m = 0; m < 4; ++m)
#pragma unroll
                    for (int n = 0; n < 2; ++n) acc[a][b][m][n] = (f32x4){0.f, 0.f, 0.f, 0.f};
        }
        cur = nxt; cA = nA; cB = nB; ++ui;
        if (wr == 1) PG8_BAR;
    }
    PG8_WAIT_V(0);
    PG8_BAR;
#undef PG8_SA
#undef PG8_SB
#undef PG8_STAGE
#undef PG8_LDA
#undef PG8_LDB
#undef PG8_MMA
#undef PG8_WAIT_V
#undef PG8_WAIT_L
#undef PG8_BAR
#undef PG8_SCHED
}
}

using pg8::bf16_t; using pg8::f32x4; using pg8::u32x4; using pg8::u32x2; using pg8::cvt_pk_bf16;
#define LAS __attribute__((address_space(3)))

constexpr int DM = 1024, NB = 4, SEQ = 4096, M = NB * SEQ, DEPTH = 2;
constexpr int NIN = 7168, NPM = 4096, NG = 3072, FF = 4096;
constexpr int C_AU = 0, C_AV = 512, C_Q = 1024, C_K = 1536, C_V = 2048, C_CB = 2560, C_CC = 3072, C_CX = 3584;
constexpr float EPS = 1e-6f;
constexpr float LOG2E = 1.4426950408889634f;

constexpr size_t MiB = 1u << 20;
constexpr size_t WS_CTL = 0, CTL_BYTES = 1 * MiB;
constexpr size_t WS_WIN = 1 * MiB, WS_WBR = 15 * MiB, WS_WOUT = 18 * MiB;
constexpr size_t WS_WF1 = 20 * MiB, WS_WF2 = 28 * MiB;
constexpr size_t WS_XB = 36 * MiB;
constexpr size_t WS_PM = 68 * MiB;
constexpr size_t WS_G8 = 196 * MiB;
constexpr size_t WS_HB = 100 * MiB;
constexpr size_t WS_END = 244 * MiB;

constexpr int NWAVES = 8;
constexpr int RING_BYTES = 131072, LDS_BYTES = 139264;

struct Args { const float* in[19]; float* out; unsigned char* ws; int ph_lo, ph_hi; };

__device__ __forceinline__ float bf_lo(unsigned w) { return __uint_as_float(w << 16); }
__device__ __forceinline__ float bf_hi(unsigned w) { return __uint_as_float(w & 0xffff0000u); }
__device__ __forceinline__ float wave_sum(float v) {
#pragma unroll
    for (int o = 1; o < 64; o <<= 1) v += __shfl_xor(v, o);
    return v;
}
__device__ __forceinline__ float gelu_tanh(float x) {
    const float u = 0.7978845608028654f * (x + 0.044715f * x * x * x);
    return x * __builtin_amdgcn_rcpf(1.f + __builtin_amdgcn_exp2f(-2.f * LOG2E * u));
}
__device__ __forceinline__ float sigmoidf(float x) { return __builtin_amdgcn_rcpf(1.f + __builtin_amdgcn_exp2f(-LOG2E * x)); }
__device__ __forceinline__ float g8f(unsigned b) { return ((float)b + 0.5f) * (1.f / 256.f); }

__device__ __forceinline__ int inproj_phys(int n) {
    if (n < C_Q || n >= C_V) return n;
    const int t = n & ~255, g = (n & 255) >> 6, d = n & 63;
    return t + ((d >> 5) << 7) + (g << 5) + (d & 31);
}

struct EpiInProj {
    static constexpr bool PERM = true, ACCUM = false;
    bf16_t* PM; unsigned char* G8; const float* rowss; const float* gate_b; const float* qnw; const float* knw;
    __device__ __forceinline__ void operator()(f32x4 (&acc)[2][2][4][2], const pg8::Unit& u, int wr, int wc, int fr, int fq) const {
        const int row0 = u.pm * 256 + wr * 64 + fr;
        float rs[2][4];
#pragma unroll
        for (int ai = 0; ai < 2; ++ai)
#pragma unroll
            for (int m = 0; m < 4; ++m) rs[ai][m] = rsqrtf(rowss[row0 + ai * 128 + m * 16] * (1.f / DM) + EPS);
        const int pn = u.pn;
        if (pn < 4) {
            const int col0 = pn * 256 + wc * 32 + 8 * fq;
#pragma unroll
            for (int ai = 0; ai < 2; ++ai)
#pragma unroll
                for (int m = 0; m < 4; ++m) { bf16_t* rowp = PM + (size_t)(row0 + ai * 128 + m * 16) * NPM + col0; const float r = rs[ai][m];
#pragma unroll
                    for (int bj = 0; bj < 2; ++bj) { const f32x4 v0 = acc[ai][bj][m][0] * r, v1 = acc[ai][bj][m][1] * r; u32x4 w;
                        w.x = cvt_pk_bf16(gelu_tanh(v0[0]), gelu_tanh(v0[1])); w.y = cvt_pk_bf16(gelu_tanh(v0[2]), gelu_tanh(v0[3]));
                        w.z = cvt_pk_bf16(gelu_tanh(v1[0]), gelu_tanh(v1[1])); w.w = cvt_pk_bf16(gelu_tanh(v1[2]), gelu_tanh(v1[3]));
                        *(u32x4*)(rowp + bj * 128) = w; } }
        } else if (pn < 8) {
            const bool isq = pn < 6;
            const float* nw = (isq ? qnw : knw) + (wc & 1) * 64 + 8 * fq;
            const float extra = isq ? 0.125f : 1.f;
            float wv[2][8];
#pragma unroll
            for (int bj = 0; bj < 2; ++bj)
#pragma unroll
                for (int i = 0; i < 8; ++i) wv[bj][i] = nw[32 * bj + i] * extra;
            const int col0 = pn * 256 + 64 * wc + 8 * fq;
#pragma unroll
            for (int ai = 0; ai < 2; ++ai)
#pragma unroll
                for (int m = 0; m < 4; ++m) { bf16_t* rowp = PM + (size_t)(row0 + ai * 128 + m * 16) * NPM + col0; const float r = rs[ai][m];
                    f32x4 v[2][2]; float ss = 0.f;
#pragma unroll
                    for (int bj = 0; bj < 2; ++bj)
#pragma unroll
                        for (int n = 0; n < 2; ++n) { v[bj][n] = acc[ai][bj][m][n] * r; const f32x4 x = v[bj][n]; ss += (x[0] * x[0] + x[1] * x[1]) + (x[2] * x[2] + x[3] * x[3]); }
                    ss += __shfl_xor(ss, 16); ss += __shfl_xor(ss, 32);
                    const float rn = rsqrtf(ss * (1.f / 64.f) + EPS);
#pragma unroll
                    for (int bj = 0; bj < 2; ++bj) { const f32x4 v0 = v[bj][0] * rn, v1 = v[bj][1] * rn; u32x4 w;
                        w.x = cvt_pk_bf16(v0[0] * wv[bj][0], v0[1] * wv[bj][1]); w.y = cvt_pk_bf16(v0[2] * wv[bj][2], v0[3] * wv[bj][3]);
                        w.z = cvt_pk_bf16(v1[0] * wv[bj][4], v1[1] * wv[bj][5]); w.w = cvt_pk_bf16(v1[2] * wv[bj][6], v1[3] * wv[bj][7]);
                        *(u32x4*)(rowp + bj * 32) = w; } }
        } else if (pn < 16) {
            const int col0 = pn * 256 + wc * 32 + 8 * fq;
#pragma unroll
            for (int ai = 0; ai < 2; ++ai)
#pragma unroll
                for (int m = 0; m < 4; ++m) { bf16_t* rowp = PM + (size_t)(row0 + ai * 128 + m * 16) * NPM + col0; const float r = rs[ai][m];
#pragma unroll
                    for (int bj = 0; bj < 2; ++bj) { const f32x4 v0 = acc[ai][bj][m][0] * r, v1 = acc[ai][bj][m][1] * r; u32x4 w;
                        w.x = cvt_pk_bf16(v0[0], v0[1]); w.y = cvt_pk_bf16(v0[2], v0[3]); w.z = cvt_pk_bf16(v1[0], v1[1]); w.w = cvt_pk_bf16(v1[2], v1[3]);
                        *(u32x4*)(rowp + bj * 128) = w; } }
        } else {
            const int col0 = (pn - 16) * 256 + wc * 32 + 8 * fq;
            f32x4 bv[2][2];
#pragma unroll
            for (int bj = 0; bj < 2; ++bj)
#pragma unroll
                for (int n = 0; n < 2; ++n) bv[bj][n] = *(const f32x4*)(gate_b + col0 + bj * 128 + 4 * n);
#pragma unroll
            for (int ai = 0; ai < 2; ++ai)
#pragma unroll
                for (int m = 0; m < 4; ++m) { unsigned char* rowp = G8 + (size_t)(row0 + ai * 128 + m * 16) * NG + col0; const float r = rs[ai][m];
#pragma unroll
                    for (int bj = 0; bj < 2; ++bj) { unsigned q[8];
#pragma unroll
                        for (int n = 0; n < 2; ++n)
#pragma unroll
                            for (int e = 0; e < 4; ++e) { const float gx = sigmoidf(acc[ai][bj][m][n][e] * r + bv[bj][n][e]); q[4 * n + e] = (unsigned)__builtin_fminf(gx * 256.f, 255.f); }
                        u32x2 w; w.x = q[0] | (q[1] << 8) | (q[2] << 16) | (q[3] << 24); w.y = q[4] | (q[5] << 8) | (q[6] << 16) | (q[7] << 24);
                        *(u32x2*)(rowp + bj * 128) = w; } }
        }
    }
};

struct EpiBranch {
    static constexpr bool PERM = true, ACCUM = true;
    bf16_t* O; const unsigned char* G8;
    __device__ __forceinline__ void operator()(f32x4 (&acc)[2][2][4][2], const pg8::Unit& u, int wr, int wc, int fr, int fq) const {
        const int row0 = u.pm * 256 + wr * 64 + fr, col0 = u.pn * 256 + wc * 32 + 8 * fq, j = u.j;
#pragma unroll
        for (int ai = 0; ai < 2; ++ai)
#pragma unroll
            for (int m = 0; m < 4; ++m) { const size_t row = (size_t)(row0 + ai * 128 + m * 16);
#pragma unroll
                for (int bj = 0; bj < 2; ++bj) {
                    const u32x2 ga = *(const u32x2*)(G8 + row * NG + j * 1024 + col0 + bj * 128);
                    float f[8];
#pragma unroll
                    for (int e = 0; e < 4; ++e) { f[e] = g8f((ga.x >> (8 * e)) & 0xffu); f[4 + e] = g8f((ga.y >> (8 * e)) & 0xffu); }
                    if (j < 2) {
                        const u32x2 gb = *(const u32x2*)(G8 + row * NG + (j + 1) * 1024 + col0 + bj * 128);
#pragma unroll
                        for (int e = 0; e < 4; ++e) { f[e] *= __builtin_amdgcn_rcpf(g8f((gb.x >> (8 * e)) & 0xffu)); f[4 + e] *= __builtin_amdgcn_rcpf(g8f((gb.y >> (8 * e)) & 0xffu)); }
                    }
#pragma unroll
                    for (int e = 0; e < 4; ++e) { acc[ai][bj][m][0][e] *= f[e]; acc[ai][bj][m][1][e] *= f[4 + e]; }
                    if (j == 2) { const f32x4 v0 = acc[ai][bj][m][0], v1 = acc[ai][bj][m][1]; u32x4 w;
                        w.x = cvt_pk_bf16(v0[0], v0[1]); w.y = cvt_pk_bf16(v0[2], v0[3]); w.z = cvt_pk_bf16(v1[0], v1[1]); w.w = cvt_pk_bf16(v1[2], v1[3]);
                        *(u32x4*)(O + row * DM + col0 + bj * 128) = w; }
                } }
    }
};

struct EpiResid {
    static constexpr bool PERM = false, ACCUM = false;
    const float* xin; float* xout; bf16_t* xb; float* rowss;
    __device__ __forceinline__ void operator()(f32x4 (&acc)[2][2][4][2], const pg8::Unit& u, int wr, int wc, int fr, int fq) const {
        const int row0 = u.pm * 256 + wr * 64 + fr, col0 = u.pn * 256 + wc * 32 + 4 * fq;
#pragma unroll
        for (int ai = 0; ai < 2; ++ai)
#pragma unroll
            for (int m = 0; m < 4; ++m) { const int row = row0 + ai * 128 + m * 16; const size_t off = (size_t)row * DM + col0; float ss = 0.f;
#pragma unroll
                for (int bj = 0; bj < 2; ++bj)
#pragma unroll
                    for (int n = 0; n < 2; ++n) { const size_t o = off + bj * 128 + n * 16; const f32x4 x = *(const f32x4*)(xin + o) + acc[ai][bj][m][n];
                        *(f32x4*)(xout + o) = x;
                        if (xb) { u32x2 w; w.x = cvt_pk_bf16(x[0], x[1]); w.y = cvt_pk_bf16(x[2], x[3]); *(u32x2*)(xb + o) = w; ss += (x[0] * x[0] + x[1] * x[1]) + (x[2] * x[2] + x[3] * x[3]); } }
                if (xb) { ss += __shfl_xor(ss, 16); ss += __shfl_xor(ss, 32); if (fq == 0) atomicAdd(rowss + row, ss); } }
    }
};

struct EpiFF1 {
    static constexpr bool PERM = true, ACCUM = false;
    bf16_t* O; const float* rowss;
    __device__ __forceinline__ void operator()(f32x4 (&acc)[2][2][4][2], const pg8::Unit& u, int wr, int wc, int fr, int fq) const {
        const int row0 = u.pm * 256 + wr * 64 + fr, col0 = u.pn * 256 + wc * 32 + 8 * fq;
#pragma unroll
        for (int ai = 0; ai < 2; ++ai)
#pragma unroll
            for (int m = 0; m < 4; ++m) { const int row = row0 + ai * 128 + m * 16; const float r = rsqrtf(rowss[row] * (1.f / DM) + EPS); bf16_t* rowp = O + (size_t)row * FF + col0;
#pragma unroll
                for (int bj = 0; bj < 2; ++bj) { f32x4 v0 = acc[ai][bj][m][0] * r, v1 = acc[ai][bj][m][1] * r;
#pragma unroll
                    for (int e = 0; e < 4; ++e) { const float a = __builtin_fmaxf(v0[e], 0.f), b = __builtin_fmaxf(v1[e], 0.f); v0[e] = a * a; v1[e] = b * b; }
                    u32x4 w; w.x = cvt_pk_bf16(v0[0], v0[1]); w.y = cvt_pk_bf16(v0[2], v0[3]); w.z = cvt_pk_bf16(v1[0], v1[1]); w.w = cvt_pk_bf16(v1[2], v1[3]);
                    *(u32x4*)(rowp + bj * 128) = w; } }
    }
};

template <bool INPERM>
__device__ __forceinline__ void transpose_item(const float* W, const float* kscale, int K, int N, bf16_t* WT, LAS float* scr, int item, int lane) {
    const int nblk = N / 32, kb = item / nblk, nb = item % nblk, k0 = 64 * kb, n0 = 32 * nb;
#pragma unroll 8
    for (int i = 0; i < 32; ++i) { const int kk = 2 * i + (lane >> 5); float v = W[(size_t)(k0 + kk) * N + n0 + (lane & 31)]; if (kscale) v *= kscale[k0 + kk]; scr[kk * 33 + (lane & 31)] = v; }
    asm volatile("s_waitcnt lgkmcnt(0)" ::: "memory");
    const int c = lane & 7;
    const int r0 = INPERM ? inproj_phys(n0) : n0;
#pragma unroll
    for (int j = 0; j < 4; ++j) { const int n = (lane >> 3) + 8 * j; const LAS float* s = scr + (8 * c) * 33 + n;
        u32x4 o; o.x = cvt_pk_bf16(s[0 * 33], s[1 * 33]); o.y = cvt_pk_bf16(s[2 * 33], s[3 * 33]); o.z = cvt_pk_bf16(s[4 * 33], s[5 * 33]); o.w = cvt_pk_bf16(s[6 * 33], s[7 * 33]);
        *(u32x4*)(WT + (size_t)(r0 + n) * K + k0 + 8 * c) = o; }
    asm volatile("s_waitcnt lgkmcnt(0)" ::: "memory");
}
constexpr int IT_WIN = 16 * 224, IT_BR = 8 * 32, IT_OUT = 16 * 32, IT_F1 = 16 * 128, IT_F2 = 64 * 32;
__device__ __forceinline__ void convert_region_a(const Args& a, int l, LAS unsigned char* lds, int gw, int ngw, int wave, int lane) {
    LAS float* scr = (LAS float*)(lds + wave * 16384);
    unsigned char* ws = a.ws;
    constexpr int NIT = IT_WIN + 3 * IT_BR + IT_OUT;
    for (int it = gw; it < NIT; it += ngw) {
        int r = it;
        if (r < IT_WIN) { transpose_item<true>(a.in[2] + (size_t)l * DM * NIN, a.in[1] + l * DM, DM, NIN, (bf16_t*)(ws + WS_WIN), scr, r, lane); continue; } r -= IT_WIN;
        if (r < 3 * IT_BR) { const int j = r / IT_BR; transpose_item<false>(a.in[12 + j] + (size_t)l * 512 * DM, nullptr, 512, DM, (bf16_t*)(ws + WS_WBR + j * MiB), scr, r % IT_BR, lane); continue; } r -= 3 * IT_BR;
        transpose_item<false>(a.in[15] + (size_t)l * DM * DM, nullptr, DM, DM, (bf16_t*)(ws + WS_WOUT), scr, r, lane);
    }
}
__device__ __forceinline__ void convert_region_b(const Args& a, int l, LAS unsigned char* lds, int gw, int ngw, int wave, int lane) {
    LAS float* scr = (LAS float*)(lds + wave * 16384);
    unsigned char* ws = a.ws;
    constexpr int NIT = IT_F1 + IT_F2;
    for (int it = gw; it < NIT; it += ngw) {
        int r = it;
        if (r < IT_F1) { transpose_item<false>(a.in[17] + (size_t)l * DM * FF, a.in[16] + l * DM, DM, FF, (bf16_t*)(ws + WS_WF1), scr, r, lane); continue; } r -= IT_F1;
        transpose_item<false>(a.in[18] + (size_t)l * FF * DM, nullptr, FF, DM, (bf16_t*)(ws + WS_WF2), scr, r, lane);
    }
}

__device__ __forceinline__ void attn_naive(bf16_t* PM, float lam, float post, const float* subw, int gtid, int gthreads) {
    for (int idx = gtid; idx < NB * 4 * SEQ * 4; idx += gthreads) {
        const int m = idx & 1, eh = (idx >> 1) & 1, q = (idx >> 2) & (SEQ - 1), bh = idx >> 14, b = bh >> 2, h = bh & 3;
        bf16_t* rowq = PM + (size_t)(b * SEQ + q) * NPM;
        float qv[64];
        { const u32x4* q4 = (const u32x4*)(rowq + C_Q + h * 128 + m * 64);
#pragma unroll
          for (int i = 0; i < 8; ++i) { const u32x4 w = q4[i]; qv[8 * i] = bf_lo(w.x); qv[8 * i + 1] = bf_hi(w.x); qv[8 * i + 2] = bf_lo(w.y); qv[8 * i + 3] = bf_hi(w.y); qv[8 * i + 4] = bf_lo(w.z); qv[8 * i + 5] = bf_hi(w.z); qv[8 * i + 6] = bf_lo(w.w); qv[8 * i + 7] = bf_hi(w.w); } }
        const float slope = __builtin_amdgcn_exp2f(-2.f * (float)(h + 1));
        const int nk = ((q >> 6) + 1) << 6;
        float mx = -1e30f, l = 0.f; float o[64];
#pragma unroll
        for (int e = 0; e < 64; ++e) o[e] = 0.f;
        const bf16_t* kp = PM + (size_t)b * SEQ * NPM + C_K + h * 128 + m * 64;
        const bf16_t* vp = PM + (size_t)b * SEQ * NPM + C_V + h * 128 + eh * 64;
        for (int k = 0; k < nk; ++k) {
            const u32x4* k4 = (const u32x4*)(kp + (size_t)k * NPM);
            float s0 = 0.f, s1 = 0.f;
#pragma unroll
            for (int i = 0; i < 8; ++i) { const u32x4 w = k4[i];
                s0 += qv[8 * i] * bf_lo(w.x) + qv[8 * i + 2] * bf_lo(w.y) + qv[8 * i + 4] * bf_lo(w.z) + qv[8 * i + 6] * bf_lo(w.w);
                s1 += qv[8 * i + 1] * bf_hi(w.x) + qv[8 * i + 3] * bf_hi(w.y) + qv[8 * i + 5] * bf_hi(w.z) + qv[8 * i + 7] * bf_hi(w.w); }
            const float s = (s0 + s1) - slope * fabsf((float)(q - k));
            if (__any(s > mx)) { const float mn = __builtin_fmaxf(mx, s); const float f = __builtin_amdgcn_exp2f((mx - mn) * LOG2E); l *= f;
#pragma unroll
                for (int e = 0; e < 64; ++e) o[e] *= f;
                mx = mn; }
            const float p = __builtin_amdgcn_exp2f((s - mx) * LOG2E); l += p;
            const u32x4* v4 = (const u32x4*)(vp + (size_t)k * NPM);
#pragma unroll
            for (int i = 0; i < 8; ++i) { const u32x4 w = v4[i];
                o[8 * i] += p * bf_lo(w.x); o[8 * i + 1] += p * bf_hi(w.x); o[8 * i + 2] += p * bf_lo(w.y); o[8 * i + 3] += p * bf_hi(w.y);
                o[8 * i + 4] += p * bf_lo(w.z); o[8 * i + 5] += p * bf_hi(w.z); o[8 * i + 6] += p * bf_lo(w.w); o[8 * i + 7] += p * bf_hi(w.w); }
        }
        const float il = 1.f / l; float ss = 0.f;
#pragma unroll
        for (int e = 0; e < 64; ++e) { const float mine = o[e] * il; const float other = __shfl_xor(mine, 1); o[e] = mine - lam * other; ss += o[e] * o[e]; }
        ss += __shfl_xor(ss, 2);
        const float rn = rsqrtf(ss * (1.f / 128.f) + EPS) * post;
        if (m == 0) {
            u32x4* dst = (u32x4*)(rowq + C_Q + h * 128 + eh * 64); const float* sw = subw + eh * 64;
#pragma unroll
            for (int i = 0; i < 8; ++i) { u32x4 w;
                w.x = cvt_pk_bf16(o[8 * i] * rn * sw[8 * i], o[8 * i + 1] * rn * sw[8 * i + 1]); w.y = cvt_pk_bf16(o[8 * i + 2] * rn * sw[8 * i + 2], o[8 * i + 3] * rn * sw[8 * i + 3]);
                w.z = cvt_pk_bf16(o[8 * i + 4] * rn * sw[8 * i + 4], o[8 * i + 5] * rn * sw[8 * i + 5]); w.w = cvt_pk_bf16(o[8 * i + 6] * rn * sw[8 * i + 6], o[8 * i + 7] * rn * sw[8 * i + 7]);
                dst[i] = w; }
        }
    }
}

__device__ __forceinline__ void gmlp_unit(bf16_t* PM, const float* vnw, const float* ws_g, const float* bs_g, int rowbase, int g, LAS unsigned char* lds, int tid) {
    LAS float* Vt = (LAS float*)lds; LAS float* Wsl = (LAS float*)(lds + 65536);
    __syncthreads();
    {
        const int row = tid >> 2, part = tid & 3;
        const bf16_t* rp = PM + (size_t)(rowbase + row) * NPM + C_AV;
        float ss = 0.f;
#pragma unroll
        for (int i = 0; i < 16; ++i) { const u32x4 w = *(const u32x4*)(rp + part * 128 + i * 8);
            const float a0 = bf_lo(w.x), a1 = bf_hi(w.x), a2 = bf_lo(w.y), a3 = bf_hi(w.y), a4 = bf_lo(w.z), a5 = bf_hi(w.z), a6 = bf_lo(w.w), a7 = bf_hi(w.w);
            ss += (a0 * a0 + a1 * a1) + (a2 * a2 + a3 * a3) + (a4 * a4 + a5 * a5) + (a6 * a6 + a7 * a7); }
        ss += __shfl_xor(ss, 1); ss += __shfl_xor(ss, 2);
        const float r = rsqrtf(ss * (1.f / 512.f) + EPS);
        const int c0 = part * 32;
#pragma unroll
        for (int i = 0; i < 4; ++i) { const u32x4 w = *(const u32x4*)(rp + g * 128 + c0 + i * 8); const float* nw = vnw + g * 128 + c0 + i * 8;
            f32x4 lo, hi; lo[0] = bf_lo(w.x) * r * nw[0]; lo[1] = bf_hi(w.x) * r * nw[1]; lo[2] = bf_lo(w.y) * r * nw[2]; lo[3] = bf_hi(w.y) * r * nw[3];
            hi[0] = bf_lo(w.z) * r * nw[4]; hi[1] = bf_hi(w.z) * r * nw[5]; hi[2] = bf_lo(w.w) * r * nw[6]; hi[3] = bf_hi(w.w) * r * nw[7];
            *(LAS f32x4*)(Vt + row * 128 + c0 + i * 8) = lo; *(LAS f32x4*)(Vt + row * 128 + c0 + i * 8 + 4) = hi; }
#pragma unroll 4
        for (int i = 0; i < 8; ++i) { const int e4 = (i * 512 + tid) * 4, t = e4 >> 7, s = e4 & 127; f32x4 w = *(const f32x4*)(ws_g + e4);
#pragma unroll
            for (int e = 0; e < 4; ++e) if (s + e > t) w[e] = 0.f;
            *(LAS f32x4*)(Wsl + e4) = w; }
    }
    __syncthreads();
    const int c = tid & 127, tg = tid >> 7;
    float acc[32];
#pragma unroll
    for (int i = 0; i < 32; ++i) acc[i] = 0.f;
    const int smax = 32 * (tg + 1);
    for (int s = 0; s < smax; s += 4) {
        const float v0 = Vt[s * 128 + c], v1 = Vt[(s + 1) * 128 + c], v2 = Vt[(s + 2) * 128 + c], v3 = Vt[(s + 3) * 128 + c];
#pragma unroll
        for (int i = 0; i < 32; ++i) { const f32x4 w = *(const LAS f32x4*)(Wsl + (32 * tg + i) * 128 + s); acc[i] += (w[0] * v0 + w[1] * v1) + (w[2] * v2 + w[3] * v3); }
    }
#pragma unroll
    for (int i = 0; i < 32; ++i) { const int t = 32 * tg + i; bf16_t* p = PM + (size_t)(rowbase + t) * NPM + C_AU + g * 128 + c;
        const float uu = __uint_as_float((unsigned)(*p) << 16); const float y = uu * (acc[i] + bs_g[t]);
        *p = (bf16_t)(cvt_pk_bf16(y, 0.f) & 0xffffu); }
}

__device__ __forceinline__ void conv_items(bf16_t* PM, const float* cw, int gtid, int gthreads) {
    for (int idx = gtid; idx < M * 64; idx += gthreads) {
        const int row = idx >> 6, c0 = (idx & 63) * 8, spos = row & (SEQ - 1);
        bf16_t* rp = PM + (size_t)row * NPM;
        float z[3][8];
#pragma unroll
        for (int j = 0; j < 3; ++j) { const int dt = 2 - j;
            if (spos >= dt) { const u32x4 a = *(const u32x4*)(rp - (size_t)dt * NPM + C_CC + c0), b = *(const u32x4*)(rp - (size_t)dt * NPM + C_CX + c0);
                z[j][0] = bf_lo(a.x) * bf_lo(b.x); z[j][1] = bf_hi(a.x) * bf_hi(b.x); z[j][2] = bf_lo(a.y) * bf_lo(b.y); z[j][3] = bf_hi(a.y) * bf_hi(b.y);
                z[j][4] = bf_lo(a.z) * bf_lo(b.z); z[j][5] = bf_hi(a.z) * bf_hi(b.z); z[j][6] = bf_lo(a.w) * bf_lo(b.w); z[j][7] = bf_hi(a.w) * bf_hi(b.w);
            } else {
#pragma unroll
                for (int e = 0; e < 8; ++e) z[j][e] = 0.f; } }
        const u32x4 cb = *(const u32x4*)(rp + C_CB + c0);
        float y[8];
#pragma unroll
        for (int e = 0; e < 8; ++e) y[e] = cw[c0 + e] * z[0][e] + cw[512 + c0 + e] * z[1][e] + cw[1024 + c0 + e] * z[2][e];
        u32x4 w; w.x = cvt_pk_bf16(bf_lo(cb.x) * y[0], bf_hi(cb.x) * y[1]); w.y = cvt_pk_bf16(bf_lo(cb.y) * y[2], bf_hi(cb.y) * y[3]);
        w.z = cvt_pk_bf16(bf_lo(cb.z) * y[4], bf_hi(cb.z) * y[5]); w.w = cvt_pk_bf16(bf_lo(cb.w) * y[6], bf_hi(cb.w) * y[7]);
        *(u32x4*)(rp + C_CB + c0) = w;
    }
}

constexpr int N_PHASES = 1 + 6 * DEPTH;
__global__ void __launch_bounds__(NWAVES * 64, 2) fwd_kernel(Args args) {
    extern __shared__ __attribute__((aligned(16))) unsigned char lds_raw[];
    LAS unsigned char* lds = (LAS unsigned char*)lds_raw;
    const int G = gridDim.x, bx = blockIdx.x, ngw = G * NWAVES, gthreads = G * NWAVES * 64;
#define TIDS() int tid_ = threadIdx.x; asm volatile("" : "+v"(tid_)); const int tid = tid_, lane = tid & 63, wave = __builtin_amdgcn_readfirstlane(tid >> 6), gw = bx * NWAVES + wave, gtid = bx * (NWAVES * 64) + tid; (void)lane; (void)gw; (void)gtid
    unsigned char* ws = args.ws;
    float* ROWSS = (float*)(ws + WS_CTL);
    bf16_t* XB = (bf16_t*)(ws + WS_XB); bf16_t* PM = (bf16_t*)(ws + WS_PM); bf16_t* XBM = (bf16_t*)(ws + WS_PM); bf16_t* HB = (bf16_t*)(ws + WS_HB);
    unsigned char* G8 = ws + WS_G8;
    const int lo = args.ph_lo, hi = args.ph_hi;
#if !MK_MULTI
    cg::grid_group grid = cg::this_grid();
#define SEAM(ph) do { if ((ph) + 1 < hi) grid.sync(); } while (0)
#else
#define SEAM(ph) do { } while (0)
#endif
#define IN(k) (lo <= (k) && (k) < hi)

    if (IN(0)) {
        TIDS();
        convert_region_a(args, 0, lds, gw, ngw, wave, lane);
        convert_region_b(args, 0, lds, gw, ngw, wave, lane);
        const float* x = args.in[0];
        for (int r = gw; r < M; r += ngw) {
            const f32x4* xr = (const f32x4*)(x + (size_t)r * DM) + lane; u32x2* o = (u32x2*)(XB + (size_t)r * DM) + lane; float s = 0.f;
#pragma unroll
            for (int j = 0; j < 4; ++j) { const f32x4 v = xr[64 * j]; s += (v[0] * v[0] + v[1] * v[1]) + (v[2] * v[2] + v[3] * v[3]); u32x2 w; w.x = cvt_pk_bf16(v[0], v[1]); w.y = cvt_pk_bf16(v[2], v[3]); o[64 * j] = w; }
            s = wave_sum(s); if (lane == 0) ROWSS[r] = s;
        }
        SEAM(0);
    }
    for (int l = 0; l < DEPTH; ++l) {
        const int pb = 1 + 6 * l;
        const float* xres_in = (l == 0) ? args.in[0] : args.out;
        if (IN(pb + 0)) {
            pg8::Gemm g{XB, (const bf16_t*)(ws + WS_WIN), DM, DM, 0, 0, 0}; pg8::StaticOrder S; S.init(M, NIN, G, bx);
            EpiInProj E{PM, G8, ROWSS + (size_t)(2 * l) * M, args.in[3] + l * NG, args.in[7] + l * 128, args.in[8] + l * 128};
            pg8::gemm_phase<EpiInProj, pg8::StaticOrder>(lds, g, S, E);
            SEAM(pb + 0);
        }
        if (IN(pb + 1)) {
            TIDS();
            if (l == 1) convert_region_b(args, 1, lds, gw, ngw, wave, lane);
            const float* lp = args.in[9] + l * 256;
            const float sa = wave_sum(lp[lane] * lp[64 + lane]), sb = wave_sum(lp[128 + lane] * lp[192 + lane]);
            const float lam_init = 0.8f - 0.6f * expf(-0.3f * (float)l);
            const float lam = expf(sa) - expf(sb) + lam_init;
            attn_naive(PM, lam, 1.f - lam_init, args.in[10] + l * 128, gtid, gthreads);
            for (int uu = bx; uu < 512; uu += G) { const int g4 = uu & 3, blk = uu >> 2;
                gmlp_unit(PM, args.in[4] + l * 512, args.in[5] + (size_t)(l * 4 + g4) * 16384, args.in[6] + (l * 4 + g4) * 128, blk * 128, g4, lds, tid); }
            conv_items(PM, args.in[11] + l * 1536, gtid, gthreads);
            SEAM(pb + 1);
        }
        if (IN(pb + 2)) {
            pg8::Gemm g{PM + C_AU, (const bf16_t*)(ws + WS_WBR), NPM, 512, (size_t)(C_Q - C_AU) * 2, (size_t)(C_CB - C_AU) * 2, MiB}; pg8::StaticOrder S; S.init(M, DM, G, bx, 3);
            EpiBranch E{XB, G8};
            pg8::gemm_phase<EpiBranch, pg8::StaticOrder>(lds, g, S, E);
            SEAM(pb + 2);
        }
        if (IN(pb + 3)) {
            pg8::Gemm g{XB, (const bf16_t*)(ws + WS_WOUT), DM, DM, 0, 0, 0}; pg8::StaticOrder S; S.init(M, DM, G, bx);
            EpiResid E{xres_in, args.out, XBM, ROWSS + (size_t)(2 * l + 1) * M};
            pg8::gemm_phase<EpiResid, pg8::StaticOrder>(lds, g, S, E);
            SEAM(pb + 3);
        }
        if (IN(pb + 4)) {
            if (l == 0) { TIDS(); convert_region_a(args, 1, lds, gw, ngw, wave, lane); }
            __syncthreads();
            pg8::Gemm g{XBM, (const bf16_t*)(ws + WS_WF1), DM, DM, 0, 0, 0}; pg8::StaticOrder S; S.init(M, FF, G, bx);
            EpiFF1 E{HB, ROWSS + (size_t)(2 * l + 1) * M};
            pg8::gemm_phase<EpiFF1, pg8::StaticOrder>(lds, g, S, E);
            SEAM(pb + 4);
        }
        if (IN(pb + 5)) {
            pg8::Gemm g{HB, (const bf16_t*)(ws + WS_WF2), FF, FF, 0, 0, 0}; pg8::StaticOrder S; S.init(M, DM, G, bx);
            EpiResid E{args.out, args.out, (l + 1 < DEPTH) ? XB : nullptr, ROWSS + (size_t)(2 * l + 2 < 4 ? 2 * l + 2 : 0) * M};
            pg8::gemm_phase<EpiResid, pg8::StaticOrder>(lds, g, S, E);
            SEAM(pb + 5);
        }
    }
#undef IN
#undef SEAM
}

extern "C" void kernel_launch(void* const* d_in, const int* in_sizes, int n_in, void* d_out, int out_size, void* d_ws, size_t ws_size, hipStream_t stream) {
    static int grid = 0;
    if (grid == 0) {
        if (n_in != 19 || in_sizes[0] != M * DM || out_size != M * DM || ws_size < WS_END) { fprintf(stderr, "kernel_launch: unexpected shapes / workspace (%d inputs, ws %zu)\n", n_in, ws_size); grid = -1; return; }
        int dev = 0, cus = 0, per_cu = 0;
        if (hipGetDevice(&dev) != hipSuccess || hipDeviceGetAttribute(&cus, hipDeviceAttributeMultiprocessorCount, dev) != hipSuccess) { grid = -1; return; }
        if (hipFuncSetAttribute((const void*)fwd_kernel, hipFuncAttributeMaxDynamicSharedMemorySize, LDS_BYTES) != hipSuccess) { fprintf(stderr, "kernel_launch: hipFuncSetAttribute failed\n"); grid = -1; return; }
        if (hipOccupancyMaxActiveBlocksPerMultiprocessor(&per_cu, (const void*)fwd_kernel, NWAVES * 64, LDS_BYTES) != hipSuccess || per_cu < 1) { fprintf(stderr, "kernel_launch: occupancy query says %d blocks per CU\n", per_cu); grid = -1; return; }
        grid = cus;
    }
    if (grid < 0) return;
    (void)hipMemsetAsync((char*)d_ws + WS_CTL, 0, CTL_BYTES, stream);
    Args a{};
    for (int i = 0; i < 19; ++i) a.in[i] = (const float*)d_in[i];
    a.out = (float*)d_out; a.ws = (unsigned char*)d_ws;
#if MK_MULTI
    for (int p = 0; p < N_PHASES; ++p) { a.ph_lo = p; a.ph_hi = p + 1; hipLaunchKernelGGL(fwd_kernel, dim3(grid), dim3(NWAVES * 64), LDS_BYTES, stream, a); }
#else
    a.ph_lo = 0; a.ph_hi = N_PHASES;
    void* kargs[] = {&a};
    hipError_t e = hipLaunchCooperativeKernel((const void*)fwd_kernel, dim3(grid), dim3(NWAVES * 64), kargs, LDS_BYTES, stream);
    if (e != hipSuccess) fprintf(stderr, "kernel_launch: cooperative launch failed: %s (grid %d)\n", hipGetErrorString(e), grid);
#endif
}
```

```cpp
#include <hip/hip_runtime.h>
#include <hip/hip_cooperative_groups.h>
#include <cstdio>
#include <cstdint>
namespace cg = cooperative_groups;

#ifndef MK_MULTI
#define MK_MULTI 0
#endif

namespace pg8 {
#define PG8_LAS __attribute__((address_space(3)))
typedef unsigned short bf16_t;
typedef short bf16x8 __attribute__((ext_vector_type(8)));
typedef float f32x4 __attribute__((ext_vector_type(4)));
typedef unsigned u32x4 __attribute__((ext_vector_type(4)));
typedef unsigned u32x2 __attribute__((ext_vector_type(2)));
constexpr int BM = 256, BK = 64, HALF = 128, HTB = HALF * BK * 2, STAGE_BYTES = 8 * HTB, NXCD = 8, WGM = 8;

__host__ __device__ __forceinline__ int lds_byte(int r, int c) { const int st = (r >> 4) * 2 + (c >> 5), rr = r & 15, cc = c & 31, ob = rr * 64 + cc * 2; return st * 1024 + (ob ^ (((ob >> 9) & 1) << 5)); }
__host__ __device__ __forceinline__ void stage_rc(int b, int& R, int& C) { const int st = b / 1024, sb = b % 1024, swz = sb ^ (((sb >> 9) & 1) << 5); R = (st >> 1) * 16 + swz / 64; C = (st & 1) * 32 + (swz % 64) / 2; }
__host__ __device__ __forceinline__ int perm32(int rho) { const int n = rho >> 4, i = rho & 15; return 8 * (i >> 2) + 4 * n + (i & 3); }

struct Unit { int pm, pn, j; };
struct Gemm { const bf16_t* A; const bf16_t* Bt; int lda, K; size_t a_j1, a_j2, b_j;
    __device__ __forceinline__ size_t aoff(int j) const { return j == 0 ? (size_t)0 : (j == 1 ? a_j1 : a_j2); } };

struct StaticOrder {
    int nM, nN, nwg, G, c, NJ;
    __host__ __device__ void init(int M, int N, int G_, int c_, int NJ_ = 1) { nM = M / BM; nN = N / BM; nwg = nM * nN; G = G_; c = c_; NJ = NJ_; }
    __host__ __device__ bool next(int i, Unit& u) const {
        const int ti = i / NJ; u.j = i - ti * NJ;
        const long L = (long)ti * G + c; if (L >= nwg) return false;
        int wgid = (int)L; { const int q = nwg / NXCD, r = nwg % NXCD, xcd = wgid % NXCD, off = wgid / NXCD; wgid = (xcd < r ? xcd * (q + 1) : r * (q + 1) + (xcd - r) * q) + off; }
        const int nig = WGM * nN, gid = wgid / nig, fm = gid * WGM, gsz = (nM - fm) < WGM ? (nM - fm) : WGM;
        u.pm = fm + ((wgid % nig) % gsz); u.pn = (wgid % nig) / gsz; return true;
    }
};

__device__ __forceinline__ unsigned cvt_pk_bf16(float lo, float hi) { unsigned r; asm volatile("v_cvt_pk_bf16_f32 %0, %1, %2" : "=v"(r) : "v"(lo), "v"(hi)); return r; }

template <class Epi, class Sched>
__device__ __forceinline__ void gemm_phase(PG8_LAS unsigned char* lds, const Gemm g, const Sched& S, const Epi& E) {
    int tid_ = threadIdx.x; asm volatile("" : "+v"(tid_));
    const int tid = tid_, wid = __builtin_amdgcn_readfirstlane(tid >> 6), lane = tid & 63, wr = wid >> 2, wc = wid & 3, fr = lane & 15, fq = lane >> 4;
    const int K = g.K, nt = K / BK, lda = g.lda;
    unsigned voffA[2], voffB[2];
#pragma unroll
    for (int i = 0; i < 2; ++i) { int R, C; stage_rc(tid * 16 + i * 8192, R, C); const int Rb = Epi::PERM ? ((R & ~31) + perm32(R & 31)) : R;
        voffA[i] = (unsigned)(R * lda + C) * 2u; voffB[i] = (unsigned)(Rb * K + C) * 2u; }
    const size_t kstep = (size_t)(BK * 2);
    const size_t hstepA = (size_t)HALF * lda * 2, hstepB = (size_t)HALF * K * 2;
    const size_t tstepA = 2 * hstepA, tstepB = 2 * hstepB;
    const unsigned ldsw = (unsigned)wid * 1024u;
    const int aoff = lds_byte(wr * 64 + fr, fq * 8), boff = lds_byte(wc * 32 + fr, fq * 8);
#define PG8_SA(b, h) (((b) * 2 + (h)) * HTB)
#define PG8_SB(b, h) ((4 + (b) * 2 + (h)) * HTB)
#define PG8_STAGE(bufoff, gbase, voff) do { _Pragma("unroll") for (int _i = 0; _i < 2; ++_i) \
        __builtin_amdgcn_global_load_lds((const unsigned*)((const char*)(gbase) + (voff)[_i]), (PG8_LAS unsigned*)(lds + (bufoff) + ldsw + _i * 8192), 16, 0, 0); } while (0)
#define PG8_LDA(dst, b, h) do { _Pragma("unroll") for (int m = 0; m < 4; ++m) _Pragma("unroll") for (int k = 0; k < 2; ++k) dst[m][k] = *(const PG8_LAS bf16x8*)(lds + PG8_SA(b, h) + aoff + m * 2048 + k * 1024); } while (0)
#define PG8_LDB(dst, b, h) do { _Pragma("unroll") for (int n = 0; n < 2; ++n) _Pragma("unroll") for (int k = 0; k < 2; ++k) dst[n][k] = *(const PG8_LAS bf16x8*)(lds + PG8_SB(b, h) + boff + n * 2048 + k * 1024); } while (0)
#define PG8_MMA(ai, bj, At, Bt) do { __builtin_amdgcn_s_setprio(1); _Pragma("unroll") for (int m = 0; m < 4; ++m) _Pragma("unroll") for (int n = 0; n < 2; ++n) _Pragma("unroll") for (int k = 0; k < 2; ++k) \
        acc[ai][bj][m][n] = __builtin_amdgcn_mfma_f32_16x16x32_bf16(Bt[n][k], At[m][k], acc[ai][bj][m][n], 0, 0, 0); __builtin_amdgcn_s_setprio(0); } while (0)
#define PG8_WAIT_V(n) asm volatile("s_waitcnt vmcnt(" #n ")" ::: "memory")
#define PG8_WAIT_L(n) asm volatile("s_waitcnt lgkmcnt(" #n ")" ::: "memory")
#define PG8_BAR __builtin_amdgcn_s_barrier()
#define PG8_SCHED __builtin_amdgcn_sched_barrier(0)
    Unit cur, nxt; int ui = 0;
    if (!S.next(0, cur)) return;
    f32x4 acc[2][2][4][2];
#pragma unroll
    for (int a = 0; a < 2; ++a)
#pragma unroll
        for (int b = 0; b < 2; ++b)
#pragma unroll
            for (int m = 0; m < 4; ++m)
#pragma unroll
                for (int n = 0; n < 2; ++n) acc[a][b][m][n] = (f32x4){0.f, 0.f, 0.f, 0.f};
    bf16x8 At[4][2], B0[2][2], B1[2][2];
    const char* cA = (const char*)g.A + (size_t)cur.pm * tstepA + g.aoff(cur.j); const char* cB = (const char*)g.Bt + (size_t)cur.pn * tstepB + (size_t)cur.j * g.b_j;
    {
        PG8_STAGE(PG8_SB(0, 0), cB, voffB); PG8_STAGE(PG8_SB(0, 1), cB + hstepB, voffB); PG8_STAGE(PG8_SA(0, 0), cA, voffA); PG8_STAGE(PG8_SA(0, 1), cA + hstepA, voffA);
        if (wr == 1) PG8_BAR;
        PG8_WAIT_V(2); PG8_BAR;
        PG8_STAGE(PG8_SB(1, 0), cB + kstep, voffB); PG8_STAGE(PG8_SA(1, 0), cA + kstep, voffA); PG8_STAGE(PG8_SB(1, 1), cB + hstepB + kstep, voffB);
        PG8_WAIT_V(6); PG8_BAR;
    }
    for (;;) {
        const bool has_next = S.next(ui + 1, nxt);
        const char* nA = has_next ? (const char*)g.A + (size_t)nxt.pm * tstepA + g.aoff(nxt.j) : cA; const char* nB = has_next ? (const char*)g.Bt + (size_t)nxt.pn * tstepB + (size_t)nxt.j * g.b_j : cB;
        for (int t = 0; t < nt; t += 2) {
            const bool last = (t == nt - 2);
            const char* a1 = cA + (size_t)(t + 1) * kstep;
            const char* a2 = last ? nA : cA + (size_t)(t + 2) * kstep; const char* b2 = last ? nB : cB + (size_t)(t + 2) * kstep;
            const char* a3 = a2 + kstep; const char* b3 = b2 + kstep;
            PG8_LDB(B0, 0, 0); PG8_LDB(B1, 0, 1); PG8_SCHED; PG8_LDA(At, 0, 0); PG8_STAGE(PG8_SA(1, 1), a1 + hstepA, voffA);
            PG8_WAIT_V(8); PG8_WAIT_L(0); PG8_BAR; PG8_MMA(0, 0, At, B0); PG8_MMA(0, 1, At, B1); PG8_BAR; PG8_SCHED;
            PG8_LDA(At, 0, 1); PG8_STAGE(PG8_SB(0, 0), b2, voffB); PG8_STAGE(PG8_SB(0, 1), b2 + hstepB, voffB); PG8_STAGE(PG8_SA(0, 0), a2, voffA);
            PG8_WAIT_V(8); PG8_WAIT_L(0); PG8_BAR; PG8_MMA(1, 0, At, B0); PG8_MMA(1, 1, At, B1); PG8_BAR; PG8_SCHED;
            PG8_LDB(B0, 1, 0); PG8_LDB(B1, 1, 1); PG8_SCHED; PG8_LDA(At, 1, 0); PG8_STAGE(PG8_SA(0, 1), a2 + hstepA, voffA);
            PG8_WAIT_V(8); PG8_WAIT_L(0); PG8_BAR; PG8_MMA(0, 0, At, B0); PG8_MMA(0, 1, At, B1); PG8_BAR; PG8_SCHED;
            PG8_LDA(At, 1, 1); PG8_STAGE(PG8_SB(1, 0), b3, voffB); PG8_STAGE(PG8_SB(1, 1), b3 + hstepB, voffB); PG8_STAGE(PG8_SA(1, 0), a3, voffA);
            PG8_WAIT_V(8); PG8_WAIT_L(0); PG8_BAR; PG8_MMA(1, 0, At, B0); PG8_MMA(1, 1, At, B1); PG8_BAR; PG8_SCHED;
        }
        if (wr == 0) PG8_BAR;
        E(acc, cur, wr, wc, fr, fq);
        if (!has_next) break;
        if (!(Epi::ACCUM && nxt.j != 0)) {
#pragma unroll
        for (int a = 0; a < 2; ++a)
#pragma unroll
            for (int b = 0; b < 2; ++b)
#pragma unroll
                for (int m = 0; m < 4; ++m)
#pragma unroll
                    for (int n = 0; n < 2; ++n) acc[a][b][m][n] = (f32x4){0.f, 0.f, 0.f, 0.f};
        }
        cur = nxt; cA = nA; cB = nB; ++ui;
        if (wr == 1) PG8_BAR;
    }
    PG8_WAIT_V(0);
    PG8_BAR;
#undef PG8_SA
#undef PG8_SB
#undef PG8_STAGE
#undef PG8_LDA
#undef PG8_LDB
#undef PG8_MMA
#undef PG8_WAIT_V
#undef PG8_WAIT_L
#undef PG8_BAR
#undef PG8_SCHED
}
}

using pg8::bf16_t; using pg8::f32x4; using pg8::u32x4; using pg8::u32x2; using pg8::cvt_pk_bf16;
#define LAS __attribute__((address_space(3)))

constexpr int DM = 1024, NB = 4, SEQ = 4096, M = NB * SEQ, DEPTH = 2;
constexpr int NIN = 7168, NPM = 4096, NG = 3072, FF = 4096;
constexpr int C_AU = 0, C_AV = 512, C_Q = 1024, C_K = 1536, C_V = 2048, C_CB = 2560, C_CC = 3072, C_CX = 3584;
constexpr float EPS = 1e-6f;
constexpr float LOG2E = 1.4426950408889634f;

constexpr size_t MiB = 1u << 20;
constexpr size_t WS_CTL = 0, CTL_BYTES = 1 * MiB;
constexpr size_t WS_WIN = 1 * MiB, WS_WBR = 15 * MiB, WS_WOUT = 18 * MiB;
constexpr size_t WS_WF1 = 20 * MiB, WS_WF2 = 28 * MiB;
constexpr size_t WS_XB = 36 * MiB;
constexpr size_t WS_PM = 68 * MiB;
constexpr size_t WS_G8 = 196 * MiB;
constexpr size_t WS_HB = 100 * MiB;
constexpr size_t WS_END = 244 * MiB;

constexpr int NWAVES = 8;
constexpr int RING_BYTES = 131072, LDS_BYTES = 139264;

struct Args { const float* in[19]; float* out; unsigned char* ws; int ph_lo, ph_hi; };

__device__ __forceinline__ float bf_lo(unsigned w) { return __uint_as_float(w << 16); }
__device__ __forceinline__ float bf_hi(unsigned w) { return __uint_as_float(w & 0xffff0000u); }
__device__ __forceinline__ float wave_sum(float v) {
#pragma unroll
    for (int o = 1; o < 64; o <<= 1) v += __shfl_xor(v, o);
    return v;
}
__device__ __forceinline__ float gelu_tanh(float x) {
    const float u = 0.7978845608028654f * (x + 0.044715f * x * x * x);
    return x * __builtin_amdgcn_rcpf(1.f + __builtin_amdgcn_exp2f(-2.f * LOG2E * u));
}
__device__ __forceinline__ float sigmoidf(float x) { return __builtin_amdgcn_rcpf(1.f + __builtin_amdgcn_exp2f(-LOG2E * x)); }
__device__ __forceinline__ float g8f(unsigned b) { return ((float)b + 0.5f) * (1.f / 256.f); }

__device__ __forceinline__ int inproj_phys(int n) {
    if (n < C_Q || n >= C_V) return n;
    const int t = n & ~255, g = (n & 255) >> 6, d = n & 63;
    return t + ((d >> 5) << 7) + (g << 5) + (d & 31);
}

struct EpiInProj {
    static constexpr bool PERM = true, ACCUM = false;
    bf16_t* PM; unsigned char* G8; const float* rowss; const float* gate_b; const float* qnw; const float* knw;
    __device__ __forceinline__ void operator()(f32x4 (&acc)[2][2][4][2], const pg8::Unit& u, int wr, int wc, int fr, int fq) const {
        const int row0 = u.pm * 256 + wr * 64 + fr;
        float rs[2][4];
#pragma unroll
        for (int ai = 0; ai < 2; ++ai)
#pragma unroll
            for (int m = 0; m < 4; ++m) rs[ai][m] = rsqrtf(rowss[row0 + ai * 128 + m * 16] * (1.f / DM) + EPS);
        const int pn = u.pn;
        if (pn < 4) {
            const int col0 = pn * 256 + wc * 32 + 8 * fq;
#pragma unroll
            for (int ai = 0; ai < 2; ++ai)
#pragma unroll
                for (int m = 0; m < 4; ++m) { bf16_t* rowp = PM + (size_t)(row0 + ai * 128 + m * 16) * NPM + col0; const float r = rs[ai][m];
#pragma unroll
                    for (int bj = 0; bj < 2; ++bj) { const f32x4 v0 = acc[ai][bj][m][0] * r, v1 = acc[ai][bj][m][1] * r; u32x4 w;
                        w.x = cvt_pk_bf16(gelu_tanh(v0[0]), gelu_tanh(v0[1])); w.y = cvt_pk_bf16(gelu_tanh(v0[2]), gelu_tanh(v0[3]));
                        w.z = cvt_pk_bf16(gelu_tanh(v1[0]), gelu_tanh(v1[1])); w.w = cvt_pk_bf16(gelu_tanh(v1[2]), gelu_tanh(v1[3]));
                        *(u32x4*)(rowp + bj * 128) = w; } }
        } else if (pn < 8) {
            const bool isq = pn < 6;
            const float* nw = (isq ? qnw : knw) + (wc & 1) * 64 + 8 * fq;
            const float extra = isq ? 0.125f * LOG2E : 1.f;
            float wv[2][8];
#pragma unroll
            for (int bj = 0; bj < 2; ++bj)
#pragma unroll
                for (int i = 0; i < 8; ++i) wv[bj][i] = nw[32 * bj + i] * extra;
            const int col0 = pn * 256 + 64 * wc + 8 * fq;
#pragma unroll
            for (int ai = 0; ai < 2; ++ai)
#pragma unroll
                for (int m = 0; m < 4; ++m) { bf16_t* rowp = PM + (size_t)(row0 + ai * 128 + m * 16) * NPM + col0; const float r = rs[ai][m];
                    f32x4 v[2][2]; float ss = 0.f;
#pragma unroll
                    for (int bj = 0; bj < 2; ++bj)
#pragma unroll
                        for (int n = 0; n < 2; ++n) { v[bj][n] = acc[ai][bj][m][n] * r; const f32x4 x = v[bj][n]; ss += (x[0] * x[0] + x[1] * x[1]) + (x[2] * x[2] + x[3] * x[3]); }
                    ss += __shfl_xor(ss, 16); ss += __shfl_xor(ss, 32);
                    const float rn = rsqrtf(ss * (1.f / 64.f) + EPS);
#pragma unroll
                    for (int bj = 0; bj < 2; ++bj) { const f32x4 v0 = v[bj][0] * rn, v1 = v[bj][1] * rn; u32x4 w;
                        w.x = cvt_pk_bf16(v0[0] * wv[bj][0], v0[1] * wv[bj][1]); w.y = cvt_pk_bf16(v0[2] * wv[bj][2], v0[3] * wv[bj][3]);
                        w.z = cvt_pk_bf16(v1[0] * wv[bj][4], v1[1] * wv[bj][5]); w.w = cvt_pk_bf16(v1[2] * wv[bj][6], v1[3] * wv[bj][7]);
                        *(u32x4*)(rowp + bj * 32) = w; } }
        } else if (pn < 16) {
            const int col0 = pn * 256 + wc * 32 + 8 * fq;
#pragma unroll
            for (int ai = 0; ai < 2; ++ai)
#pragma unroll
                for (int m = 0; m < 4; ++m) { bf16_t* rowp = PM + (size_t)(row0 + ai * 128 + m * 16) * NPM + col0; const float r = rs[ai][m];
#pragma unroll
                    for (int bj = 0; bj < 2; ++bj) { const f32x4 v0 = acc[ai][bj][m][0] * r, v1 = acc[ai][bj][m][1] * r; u32x4 w;
                        w.x = cvt_pk_bf16(v0[0], v0[1]); w.y = cvt_pk_bf16(v0[2], v0[3]); w.z = cvt_pk_bf16(v1[0], v1[1]); w.w = cvt_pk_bf16(v1[2], v1[3]);
                        *(u32x4*)(rowp + bj * 128) = w; } }
        } else {
            const int col0 = (pn - 16) * 256 + wc * 32 + 8 * fq;
            f32x4 bv[2][2];
#pragma unroll
            for (int bj = 0; bj < 2; ++bj)
#pragma unroll
                for (int n = 0; n < 2; ++n) bv[bj][n] = *(const f32x4*)(gate_b + col0 + bj * 128 + 4 * n);
#pragma unroll
            for (int ai = 0; ai < 2; ++ai)
#pragma unroll
                for (int m = 0; m < 4; ++m) { unsigned char* rowp = G8 + (size_t)(row0 + ai * 128 + m * 16) * NG + col0; const float r = rs[ai][m];
#pragma unroll
                    for (int bj = 0; bj < 2; ++bj) { unsigned q[8];
#pragma unroll
                        for (int n = 0; n < 2; ++n)
#pragma unroll
                            for (int e = 0; e < 4; ++e) { const float gx = sigmoidf(acc[ai][bj][m][n][e] * r + bv[bj][n][e]); q[4 * n + e] = (unsigned)__builtin_fminf(gx * 256.f, 255.f); }
                        u32x2 w; w.x = q[0] | (q[1] << 8) | (q[2] << 16) | (q[3] << 24); w.y = q[4] | (q[5] << 8) | (q[6] << 16) | (q[7] << 24);
                        *(u32x2*)(rowp + bj * 128) = w; } }
        }
    }
};

struct EpiBranch {
    static constexpr bool PERM = true, ACCUM = true;
    bf16_t* O; const unsigned char* G8;
    __device__ __forceinline__ void operator()(f32x4 (&acc)[2][2][4][2], const pg8::Unit& u, int wr, int wc, int fr, int fq) const {
        const int row0 = u.pm * 256 + wr * 64 + fr, col0 = u.pn * 256 + wc * 32 + 8 * fq, j = u.j;
#pragma unroll
        for (int ai = 0; ai < 2; ++ai)
#pragma unroll
            for (int m = 0; m < 4; ++m) { const size_t row = (size_t)(row0 + ai * 128 + m * 16);
#pragma unroll
                for (int bj = 0; bj < 2; ++bj) {
                    const u32x2 ga = *(const u32x2*)(G8 + row * NG + j * 1024 + col0 + bj * 128);
                    float f[8];
#pragma unroll
                    for (int e = 0; e < 4; ++e) { f[e] = g8f((ga.x >> (8 * e)) & 0xffu); f[4 + e] = g8f((ga.y >> (8 * e)) & 0xffu); }
                    if (j < 2) {
                        const u32x2 gb = *(const u32x2*)(G8 + row * NG + (j + 1) * 1024 + col0 + bj * 128);
#pragma unroll
                        for (int e = 0; e < 4; ++e) { f[e] *= __builtin_amdgcn_rcpf(g8f((gb.x >> (8 * e)) & 0xffu)); f[4 + e] *= __builtin_amdgcn_rcpf(g8f((gb.y >> (8 * e)) & 0xffu)); }
                    }
#pragma unroll
                    for (int e = 0; e < 4; ++e) { acc[ai][bj][m][0][e] *= f[e]; acc[ai][bj][m][1][e] *= f[4 + e]; }
                    if (j == 2) { const f32x4 v0 = acc[ai][bj][m][0], v1 = acc[ai][bj][m][1]; u32x4 w;
                        w.x = cvt_pk_bf16(v0[0], v0[1]); w.y = cvt_pk_bf16(v0[2], v0[3]); w.z = cvt_pk_bf16(v1[0], v1[1]); w.w = cvt_pk_bf16(v1[2], v1[3]);
                        *(u32x4*)(O + row * DM + col0 + bj * 128) = w; }
                } }
    }
};

struct EpiResid {
    static constexpr bool PERM = false, ACCUM = false;
    const float* xin; float* xout; bf16_t* xb; float* rowss;
    __device__ __forceinline__ void operator()(f32x4 (&acc)[2][2][4][2], const pg8::Unit& u, int wr, int wc, int fr, int fq) const {
        const int row0 = u.pm * 256 + wr * 64 + fr, col0 = u.pn * 256 + wc * 32 + 4 * fq;
#pragma unroll
        for (int ai = 0; ai < 2; ++ai)
#pragma unroll
            for (int m = 0; m < 4; ++m) { const int row = row0 + ai * 128 + m * 16; const size_t off = (size_t)row * DM + col0; float ss = 0.f;
#pragma unroll
                for (int bj = 0; bj < 2; ++bj)
#pragma unroll
                    for (int n = 0; n < 2; ++n) { const size_t o = off + bj * 128 + n * 16; const f32x4 x = *(const f32x4*)(xin + o) + acc[ai][bj][m][n];
                        *(f32x4*)(xout + o) = x;
                        if (xb) { u32x2 w; w.x = cvt_pk_bf16(x[0], x[1]); w.y = cvt_pk_bf16(x[2], x[3]); *(u32x2*)(xb + o) = w; ss += (x[0] * x[0] + x[1] * x[1]) + (x[2] * x[2] + x[3] * x[3]); } }
                if (xb) { ss += __shfl_xor(ss, 16); ss += __shfl_xor(ss, 32); if (fq == 0) atomicAdd(rowss + row, ss); } }
    }
};

struct EpiFF1 {
    static constexpr bool PERM = true, ACCUM = false;
    bf16_t* O; const float* rowss;
    __device__ __forceinline__ void operator()(f32x4 (&acc)[2][2][4][2], const pg8::Unit& u, int wr, int wc, int fr, int fq) const {
        const int row0 = u.pm * 256 + wr * 64 + fr, col0 = u.pn * 256 + wc * 32 + 8 * fq;
#pragma unroll
        for (int ai = 0; ai < 2; ++ai)
#pragma unroll
            for (int m = 0; m < 4; ++m) { const int row = row0 + ai * 128 + m * 16; const float r = rsqrtf(rowss[row] * (1.f / DM) + EPS); bf16_t* rowp = O + (size_t)row * FF + col0;
#pragma unroll
                for (int bj = 0; bj < 2; ++bj) { f32x4 v0 = acc[ai][bj][m][0] * r, v1 = acc[ai][bj][m][1] * r;
#pragma unroll
                    for (int e = 0; e < 4; ++e) { const float a = __builtin_fmaxf(v0[e], 0.f), b = __builtin_fmaxf(v1[e], 0.f); v0[e] = a * a; v1[e] = b * b; }
                    u32x4 w; w.x = cvt_pk_bf16(v0[0], v0[1]); w.y = cvt_pk_bf16(v0[2], v0[3]); w.z = cvt_pk_bf16(v1[0], v1[1]); w.w = cvt_pk_bf16(v1[2], v1[3]);
                    *(u32x4*)(rowp + bj * 128) = w; } }
    }
};

template <bool INPERM>
__device__ __forceinline__ void transpose_item(const float* W, const float* kscale, int K, int N, bf16_t* WT, LAS float* scr, int item, int lane) {
    const int nblk = N / 32, kb = item / nblk, nb = item % nblk, k0 = 64 * kb, n0 = 32 * nb;
#pragma unroll 8
    for (int i = 0; i < 32; ++i) { const int kk = 2 * i + (lane >> 5); float v = W[(size_t)(k0 + kk) * N + n0 + (lane & 31)]; if (kscale) v *= kscale[k0 + kk]; scr[kk * 33 + (lane & 31)] = v; }
    asm volatile("s_waitcnt lgkmcnt(0)" ::: "memory");
    const int c = lane & 7;
    const int r0 = INPERM ? inproj_phys(n0) : n0;
#pragma unroll
    for (int j = 0; j < 4; ++j) { const int n = (lane >> 3) + 8 * j; const LAS float* s = scr + (8 * c) * 33 + n;
        u32x4 o; o.x = cvt_pk_bf16(s[0 * 33], s[1 * 33]); o.y = cvt_pk_bf16(s[2 * 33], s[3 * 33]); o.z = cvt_pk_bf16(s[4 * 33], s[5 * 33]); o.w = cvt_pk_bf16(s[6 * 33], s[7 * 33]);
        *(u32x4*)(WT + (size_t)(r0 + n) * K + k0 + 8 * c) = o; }
    asm volatile("s_waitcnt lgkmcnt(0)" ::: "memory");
}
constexpr int IT_WIN = 16 * 224, IT_BR = 8 * 32, IT_OUT = 16 * 32, IT_F1 = 16 * 128, IT_F2 = 64 * 32;
__device__ __forceinline__ void convert_region_a(const Args& a, int l, LAS unsigned char* lds, int gw, int ngw, int wave, int lane) {
    LAS float* scr = (LAS float*)(lds + wave * 16384);
    unsigned char* ws = a.ws;
    constexpr int NIT = IT_WIN + 3 * IT_BR + IT_OUT;
    for (int it = gw; it < NIT; it += ngw) {
        int r = it;
        if (r < IT_WIN) { transpose_item<true>(a.in[2] + (size_t)l * DM * NIN, a.in[1] + l * DM, DM, NIN, (bf16_t*)(ws + WS_WIN), scr, r, lane); continue; } r -= IT_WIN;
        if (r < 3 * IT_BR) { const int j = r / IT_BR; transpose_item<false>(a.in[12 + j] + (size_t)l * 512 * DM, nullptr, 512, DM, (bf16_t*)(ws + WS_WBR + j * MiB), scr, r % IT_BR, lane); continue; } r -= 3 * IT_BR;
        transpose_item<false>(a.in[15] + (size_t)l * DM * DM, nullptr, DM, DM, (bf16_t*)(ws + WS_WOUT), scr, r, lane);
    }
}
__device__ __forceinline__ void convert_region_b(const Args& a, int l, LAS unsigned char* lds, int gw, int ngw, int wave, int lane) {
    LAS float* scr = (LAS float*)(lds + wave * 16384);
    unsigned char* ws = a.ws;
    constexpr int NIT = IT_F1 + IT_F2;
    for (int it = gw; it < NIT; it += ngw) {
        int r = it;
        if (r < IT_F1) { transpose_item<false>(a.in[17] + (size_t)l * DM * FF, a.in[16] + l * DM, DM, FF, (bf16_t*)(ws + WS_WF1), scr, r, lane); continue; } r -= IT_F1;
        transpose_item<false>(a.in[18] + (size_t)l * FF * DM, nullptr, FF, DM, (bf16_t*)(ws + WS_WF2), scr, r, lane);
    }
}

namespace att {
typedef short bf16x8 __attribute__((ext_vector_type(8)));
typedef short s16x4 __attribute__((ext_vector_type(4)));
typedef short v4i16_t __attribute__((ext_vector_type(4)));
typedef float f32x16 __attribute__((ext_vector_type(16)));
typedef float f32x2_t __attribute__((ext_vector_type(2))); typedef __bf16 bf16x2_t __attribute__((ext_vector_type(2)));
__device__ __forceinline__ unsigned cvtpk_s(float lo, float hi) { f32x2_t v = {lo, hi}; bf16x2_t b = __builtin_convertvector(v, bf16x2_t); return __builtin_bit_cast(unsigned, b); }
__device__ __forceinline__ s16x4 vtr(const LAS unsigned char* p) { return __builtin_bit_cast(s16x4, __builtin_amdgcn_ds_read_tr16_b64_v4i16((LAS v4i16_t*)p)); }
constexpr int KSTR = 144, VSTR = 320, KMAP = 64 * KSTR, V_OFF = 2 * KMAP, BUF = V_OFF + 64 * VSTR;
__device__ __forceinline__ bf16x8 pack8(const f32x16& p, int o) {
    u32x4 w; w.x = cvtpk_s(p[o], p[o + 1]); w.y = cvtpk_s(p[o + 2], p[o + 3]); w.z = cvtpk_s(p[o + 4], p[o + 5]); w.w = cvtpk_s(p[o + 6], p[o + 7]); return __builtin_bit_cast(bf16x8, w); }

__device__ __forceinline__ void attn_unit(bf16_t* PM, int b, int h, int qb, float lam, float post, const float* subw, LAS unsigned char* lds, int tid) {
    const int lane = tid & 63, wid = __builtin_amdgcn_readfirstlane(tid >> 6), r32 = lane & 31, hi = lane >> 5, m = wid >> 2, qs = wid & 3;
    const int qpos = 128 * qb + 32 * qs + r32;
    bf16_t* base = PM + (size_t)b * SEQ * NPM;
    bf16_t* qrow = base + (size_t)qpos * NPM + C_Q + h * 128;
    bf16x8 qr[4];
#pragma unroll
    for (int d0 = 0; d0 < 4; ++d0) qr[d0] = *(const bf16x8*)(qrow + m * 64 + d0 * 16 + hi * 8);
    const int NT = 2 * (qb + 1), my_nt = (qs < 2) ? NT - 1 : NT;
    const float sl2 = __builtin_amdgcn_exp2f(-2.f * (float)(h + 1)) * LOG2E;
    const bf16_t* gk = base + (size_t)(tid >> 3) * NPM + C_K + h * 128 + (tid & 7) * 8;
    const bf16_t* gv = base + (size_t)(tid >> 4) * NPM + C_V + h * 128 + (tid & 15) * 8;
    const int lk = (tid >> 3) * KSTR + (tid & 7) * 16, lv = V_OFF + (tid >> 4) * VSTR + (tid & 15) * 16;
    u32x4 st0, st1, st2, st3;
#define ATT_LOAD(t) do { const size_t ro = (size_t)(t) * 64 * NPM; st0 = *(const u32x4*)(gk + ro); st1 = *(const u32x4*)(gk + ro + 64); st2 = *(const u32x4*)(gv + ro); st3 = *(const u32x4*)(gv + ro + (size_t)32 * NPM); } while (0)
#define ATT_STORE(bufp) do { *(LAS u32x4*)((bufp) + lk) = st0; *(LAS u32x4*)((bufp) + KMAP + lk) = st1; *(LAS u32x4*)((bufp) + lv) = st2; *(LAS u32x4*)((bufp) + lv + 32 * VSTR) = st3; } while (0)
    __syncthreads();
    ATT_LOAD(0); ATT_STORE(lds);
    __syncthreads();
    f32x16 OT[4];
#pragma unroll
    for (int eb = 0; eb < 4; ++eb)
#pragma unroll
        for (int r = 0; r < 16; ++r) OT[eb][r] = 0.f;
    float mrun = -1e30f, lsum = 0.f;
    for (int t = 0; t < NT; ++t) {
        LAS unsigned char* buf = lds + (t & 1) * BUF;
        if (t + 1 < NT) ATT_LOAD(t + 1);
        if (t < my_nt) {
            const LAS unsigned char* kp = buf + m * KMAP + r32 * KSTR + hi * 16;
            f32x16 p0, p1;
#pragma unroll
            for (int r = 0; r < 16; ++r) { p0[r] = 0.f; p1[r] = 0.f; }
#pragma unroll
            for (int d0 = 0; d0 < 4; ++d0) {
                const bf16x8 ka = *(const LAS bf16x8*)(kp + d0 * 32), kb2 = *(const LAS bf16x8*)(kp + 32 * KSTR + d0 * 32);
                p0 = __builtin_amdgcn_mfma_f32_32x32x16_bf16(ka, qr[d0], p0, 0, 0, 0);
                p1 = __builtin_amdgcn_mfma_f32_32x32x16_bf16(kb2, qr[d0], p1, 0, 0, 0);
            }
            const float dq = (float)(qpos - 64 * t - 4 * hi);
            float mt = -1e30f;
#pragma unroll
            for (int r = 0; r < 16; ++r) { const float c = (float)((r & 3) + 8 * (r >> 2));
                p0[r] = __builtin_fmaf(-sl2, __builtin_fabsf(dq - c), p0[r]); p1[r] = __builtin_fmaf(-sl2, __builtin_fabsf(dq - (c + 32.f)), p1[r]);
                mt = __builtin_fmaxf(mt, __builtin_fmaxf(p0[r], p1[r])); }
            mt = __builtin_fmaxf(mt, __shfl_xor(mt, 32));
            const float mnew = __builtin_fmaxf(mrun, mt);
            if (__any(mnew > mrun)) {
                const float alpha = __builtin_amdgcn_exp2f(mrun - mnew); lsum *= alpha;
#pragma unroll
                for (int eb = 0; eb < 4; ++eb)
#pragma unroll
                    for (int r = 0; r < 16; ++r) OT[eb][r] *= alpha;
                mrun = mnew;
            }
            float sacc = 0.f;
#pragma unroll
            for (int r = 0; r < 16; ++r) { p0[r] = __builtin_amdgcn_exp2f(p0[r] - mrun); p1[r] = __builtin_amdgcn_exp2f(p1[r] - mrun); sacc += p0[r] + p1[r]; }
            lsum += sacc;
            bf16x8 pf[4]; pf[0] = pack8(p0, 0); pf[1] = pack8(p0, 8); pf[2] = pack8(p1, 0); pf[3] = pack8(p1, 8);
            const LAS unsigned char* vp = buf + V_OFF + (4 * hi + ((lane & 15) >> 2)) * VSTR + ((lane >> 4) & 1) * 32 + (lane & 3) * 8;
#pragma unroll
            for (int s4 = 0; s4 < 4; ++s4)
#pragma unroll
                for (int eb = 0; eb < 4; ++eb) {
                    const s16x4 vlo = vtr(vp + (16 * s4) * VSTR + eb * 64), vhi = vtr(vp + (16 * s4 + 8) * VSTR + eb * 64);
                    const bf16x8 vf = (bf16x8){vlo[0], vlo[1], vlo[2], vlo[3], vhi[0], vhi[1], vhi[2], vhi[3]};
                    OT[eb] = __builtin_amdgcn_mfma_f32_32x32x16_bf16(vf, pf[s4], OT[eb], 0, 0, 0);
                }
        }
        if (t + 1 < NT) ATT_STORE(lds + ((t + 1) & 1) * BUF);
        __syncthreads();
    }
#undef ATT_LOAD
#undef ATT_STORE
    lsum += __shfl_xor(lsum, 32);
    const float inv = 1.f / lsum;
#pragma unroll
    for (int eb = 0; eb < 4; ++eb)
#pragma unroll
        for (int r = 0; r < 16; ++r) OT[eb][r] *= inv;
    LAS float* X = (LAS float*)(lds + qs * 16384) + lane;
    if (m == 1) {
#pragma unroll
        for (int eb = 0; eb < 4; ++eb)
#pragma unroll
            for (int r = 0; r < 16; ++r) X[(eb * 16 + r) * 64] = OT[eb][r];
    }
    __syncthreads();
    if (m == 0) {
        float ss = 0.f;
#pragma unroll
        for (int eb = 0; eb < 4; ++eb)
#pragma unroll
            for (int r = 0; r < 16; ++r) { const float o = OT[eb][r] - lam * X[(eb * 16 + r) * 64]; OT[eb][r] = o; ss += o * o; }
        ss += __shfl_xor(ss, 32);
        const float rn = rsqrtf(ss * (1.f / 128.f) + EPS) * post;
#pragma unroll
        for (int eb = 0; eb < 4; ++eb)
#pragma unroll
            for (int rg = 0; rg < 4; ++rg) { const int e = 32 * eb + 8 * rg + 4 * hi; const f32x4 w4 = *(const f32x4*)(subw + e);
                u32x2 w; w.x = cvtpk_s(OT[eb][4 * rg] * rn * w4[0], OT[eb][4 * rg + 1] * rn * w4[1]); w.y = cvtpk_s(OT[eb][4 * rg + 2] * rn * w4[2], OT[eb][4 * rg + 3] * rn * w4[3]);
                *(u32x2*)(qrow + e) = w; }
    }
}
}

__device__ __forceinline__ void gmlp_unit(bf16_t* PM, const float* vnw, const float* ws_g, const float* bs_g, int rowbase, int g, LAS unsigned char* lds, int tid) {
    LAS float* Vt = (LAS float*)lds; LAS float* Wsl = (LAS float*)(lds + 65536);
    __syncthreads();
    {
        const int row = tid >> 2, part = tid & 3;
        const bf16_t* rp = PM + (size_t)(rowbase + row) * NPM + C_AV;
        float ss = 0.f;
#pragma unroll
        for (int i = 0; i < 16; ++i) { const u32x4 w = *(const u32x4*)(rp + part * 128 + i * 8);
            const float a0 = bf_lo(w.x), a1 = bf_hi(w.x), a2 = bf_lo(w.y), a3 = bf_hi(w.y), a4 = bf_lo(w.z), a5 = bf_hi(w.z), a6 = bf_lo(w.w), a7 = bf_hi(w.w);
            ss += (a0 * a0 + a1 * a1) + (a2 * a2 + a3 * a3) + (a4 * a4 + a5 * a5) + (a6 * a6 + a7 * a7); }
        ss += __shfl_xor(ss, 1); ss += __shfl_xor(ss, 2);
        const float r = rsqrtf(ss * (1.f / 512.f) + EPS);
        const int c0 = part * 32;
#pragma unroll
        for (int i = 0; i < 4; ++i) { const u32x4 w = *(const u32x4*)(rp + g * 128 + c0 + i * 8); const float* nw = vnw + g * 128 + c0 + i * 8;
            f32x4 lo, hi; lo[0] = bf_lo(w.x) * r * nw[0]; lo[1] = bf_hi(w.x) * r * nw[1]; lo[2] = bf_lo(w.y) * r * nw[2]; lo[3] = bf_hi(w.y) * r * nw[3];
            hi[0] = bf_lo(w.z) * r * nw[4]; hi[1] = bf_hi(w.z) * r * nw[5]; hi[2] = bf_lo(w.w) * r * nw[6]; hi[3] = bf_hi(w.w) * r * nw[7];
            *(LAS f32x4*)(Vt + row * 128 + c0 + i * 8) = lo; *(LAS f32x4*)(Vt + row * 128 + c0 + i * 8 + 4) = hi; }
#pragma unroll 4
        for (int i = 0; i < 8; ++i) { const int e4 = (i * 512 + tid) * 4, t = e4 >> 7, s = e4 & 127; f32x4 w = *(const f32x4*)(ws_g + e4);
#pragma unroll
            for (int e = 0; e < 4; ++e) if (s + e > t) w[e] = 0.f;
            *(LAS f32x4*)(Wsl + e4) = w; }
    }
    __syncthreads();
    const int c = tid & 127, tg = tid >> 7;
    float acc[32];
#pragma unroll
    for (int i = 0; i < 32; ++i) acc[i] = 0.f;
    const int smax = 32 * (tg + 1);
    for (int s = 0; s < smax; s += 4) {
        const float v0 = Vt[s * 128 + c], v1 = Vt[(s + 1) * 128 + c], v2 = Vt[(s + 2) * 128 + c], v3 = Vt[(s + 3) * 128 + c];
#pragma unroll
        for (int i = 0; i < 32; ++i) { const f32x4 w = *(const LAS f32x4*)(Wsl + (32 * tg + i) * 128 + s); acc[i] += (w[0] * v0 + w[1] * v1) + (w[2] * v2 + w[3] * v3); }
    }
#pragma unroll
    for (int i = 0; i < 32; ++i) { const int t = 32 * tg + i; bf16_t* p = PM + (size_t)(rowbase + t) * NPM + C_AU + g * 128 + c;
        const float uu = __uint_as_float((unsigned)(*p) << 16); const float y = uu * (acc[i] + bs_g[t]);
        *p = (bf16_t)(cvt_pk_bf16(y, 0.f) & 0xffffu); }
}

__device__ __forceinline__ void conv_items(bf16_t* PM, const float* cw, int gtid, int gthreads) {
    for (int idx = gtid; idx < M * 64; idx += gthreads) {
        const int row = idx >> 6, c0 = (idx & 63) * 8, spos = row & (SEQ - 1);
        bf16_t* rp = PM + (size_t)row * NPM;
        float z[3][8];
#pragma unroll
        for (int j = 0; j < 3; ++j) { const int dt = 2 - j;
            if (spos >= dt) { const u32x4 a = *(const u32x4*)(rp - (size_t)dt * NPM + C_CC + c0), b = *(const u32x4*)(rp - (size_t)dt * NPM + C_CX + c0);
                z[j][0] = bf_lo(a.x) * bf_lo(b.x); z[j][1] = bf_hi(a.x) * bf_hi(b.x); z[j][2] = bf_lo(a.y) * bf_lo(b.y); z[j][3] = bf_hi(a.y) * bf_hi(b.y);
                z[j][4] = bf_lo(a.z) * bf_lo(b.z); z[j][5] = bf_hi(a.z) * bf_hi(b.z); z[j][6] = bf_lo(a.w) * bf_lo(b.w); z[j][7] = bf_hi(a.w) * bf_hi(b.w);
            } else {
#pragma unroll
                for (int e = 0; e < 8; ++e) z[j][e] = 0.f; } }
        const u32x4 cb = *(const u32x4*)(rp + C_CB + c0);
        float y[8];
#pragma unroll
        for (int e = 0; e < 8; ++e) y[e] = cw[c0 + e] * z[0][e] + cw[512 + c0 + e] * z[1][e] + cw[1024 + c0 + e] * z[2][e];
        u32x4 w; w.x = cvt_pk_bf16(bf_lo(cb.x) * y[0], bf_hi(cb.x) * y[1]); w.y = cvt_pk_bf16(bf_lo(cb.y) * y[2], bf_hi(cb.y) * y[3]);
        w.z = cvt_pk_bf16(bf_lo(cb.z) * y[4], bf_hi(cb.z) * y[5]); w.w = cvt_pk_bf16(bf_lo(cb.w) * y[6], bf_hi(cb.w) * y[7]);
        *(u32x4*)(rp + C_CB + c0) = w;
    }
}

constexpr int N_PHASES = 1 + 6 * DEPTH;
__global__ void __launch_bounds__(NWAVES * 64, 2) fwd_kernel(Args args) {
    extern __shared__ __attribute__((aligned(16))) unsigned char lds_raw[];
    LAS unsigned char* lds = (LAS unsigned char*)lds_raw;
    const int G = gridDim.x, bx = blockIdx.x, ngw = G * NWAVES, gthreads = G * NWAVES * 64;
#define TIDS() int tid_ = threadIdx.x; asm volatile("" : "+v"(tid_)); const int tid = tid_, lane = tid & 63, wave = __builtin_amdgcn_readfirstlane(tid >> 6), gw = bx * NWAVES + wave, gtid = bx * (NWAVES * 64) + tid; (void)lane; (void)gw; (void)gtid
    unsigned char* ws = args.ws;
    float* ROWSS = (float*)(ws + WS_CTL);
    bf16_t* XB = (bf16_t*)(ws + WS_XB); bf16_t* PM = (bf16_t*)(ws + WS_PM); bf16_t* XBM = (bf16_t*)(ws + WS_PM); bf16_t* HB = (bf16_t*)(ws + WS_HB);
    unsigned char* G8 = ws + WS_G8;
    const int lo = args.ph_lo, hi = args.ph_hi;
#if !MK_MULTI
    cg::grid_group grid = cg::this_grid();
#define SEAM(ph) do { if ((ph) + 1 < hi) grid.sync(); } while (0)
#else
#define SEAM(ph) do { } while (0)
#endif
#define IN(k) (lo <= (k) && (k) < hi)

    if (IN(0)) {
        TIDS();
        convert_region_a(args, 0, lds, gw, ngw, wave, lane);
        convert_region_b(args, 0, lds, gw, ngw, wave, lane);
        const float* x = args.in[0];
        for (int r = gw; r < M; r += ngw) {
            const f32x4* xr = (const f32x4*)(x + (size_t)r * DM) + lane; u32x2* o = (u32x2*)(XB + (size_t)r * DM) + lane; float s = 0.f;
#pragma unroll
            for (int j = 0; j < 4; ++j) { const f32x4 v = xr[64 * j]; s += (v[0] * v[0] + v[1] * v[1]) + (v[2] * v[2] + v[3] * v[3]); u32x2 w; w.x = cvt_pk_bf16(v[0], v[1]); w.y = cvt_pk_bf16(v[2], v[3]); o[64 * j] = w; }
            s = wave_sum(s); if (lane == 0) ROWSS[r] = s;
        }
        SEAM(0);
    }
    for (int l = 0; l < DEPTH; ++l) {
        const int pb = 1 + 6 * l;
        const float* xres_in = (l == 0) ? args.in[0] : args.out;
        if (IN(pb + 0)) {
            pg8::Gemm g{XB, (const bf16_t*)(ws + WS_WIN), DM, DM, 0, 0, 0}; pg8::StaticOrder S; S.init(M, NIN, G, bx);
            EpiInProj E{PM, G8, ROWSS + (size_t)(2 * l) * M, args.in[3] + l * NG, args.in[7] + l * 128, args.in[8] + l * 128};
            pg8::gemm_phase<EpiInProj, pg8::StaticOrder>(lds, g, S, E);
            SEAM(pb + 0);
        }
        if (IN(pb + 1)) {
            TIDS();
            if (l == 1) convert_region_b(args, 1, lds, gw, ngw, wave, lane);
            const float* lp = args.in[9] + l * 256;
            const float sa = wave_sum(lp[lane] * lp[64 + lane]), sb = wave_sum(lp[128 + lane] * lp[192 + lane]);
            const float lam_init = 0.8f - 0.6f * expf(-0.3f * (float)l);
            const float lam = expf(sa) - expf(sb) + lam_init;
            for (int pi = bx; pi < 256; pi += G) { const int bh = pi >> 4, sq = pi & 15;
                att::attn_unit(PM, bh >> 2, bh & 3, 31 - sq, lam, 1.f - lam_init, args.in[10] + l * 128, lds, tid);
                att::attn_unit(PM, bh >> 2, bh & 3, sq, lam, 1.f - lam_init, args.in[10] + l * 128, lds, tid); }
            for (int uu = bx; uu < 512; uu += G) { const int g4 = uu & 3, blk = uu >> 2;
                gmlp_unit(PM, args.in[4] + l * 512, args.in[5] + (size_t)(l * 4 + g4) * 16384, args.in[6] + (l * 4 + g4) * 128, blk * 128, g4, lds, tid); }
            conv_items(PM, args.in[11] + l * 1536, gtid, gthreads);
            SEAM(pb + 1);
        }
        if (IN(pb + 2)) {
            pg8::Gemm g{PM + C_AU, (const bf16_t*)(ws + WS_WBR), NPM, 512, (size_t)(C_Q - C_AU) * 2, (size_t)(C_CB - C_AU) * 2, MiB}; pg8::StaticOrder S; S.init(M, DM, G, bx, 3);
            EpiBranch E{XB, G8};
            pg8::gemm_phase<EpiBranch, pg8::StaticOrder>(lds, g, S, E);
            SEAM(pb + 2);
        }
        if (IN(pb + 3)) {
            pg8::Gemm g{XB, (const bf16_t*)(ws + WS_WOUT), DM, DM, 0, 0, 0}; pg8::StaticOrder S; S.init(M, DM, G, bx);
            EpiResid E{xres_in, args.out, XBM, ROWSS + (size_t)(2 * l + 1) * M};
            pg8::gemm_phase<EpiResid, pg8::StaticOrder>(lds, g, S, E);
            SEAM(pb + 3);
        }
        if (IN(pb + 4)) {
            if (l == 0) { TIDS(); convert_region_a(args, 1, lds, gw, ngw, wave, lane); }
            __syncthreads();
            pg8::Gemm g{XBM, (const bf16_t*)(ws + WS_WF1), DM, DM, 0, 0, 0}; pg8::StaticOrder S; S.init(M, FF, G, bx);
            EpiFF1 E{HB, ROWSS + (size_t)(2 * l + 1) * M};
            pg8::gemm_phase<EpiFF1, pg8::StaticOrder>(lds, g, S, E);
            SEAM(pb + 4);
        }
        if (IN(pb + 5)) {
            pg8::Gemm g{HB, (const bf16_t*)(ws + WS_WF2), FF, FF, 0, 0, 0}; pg8::StaticOrder S; S.init(M, DM, G, bx);
            EpiResid E{args.out, args.out, (l + 1 < DEPTH) ? XB : nullptr, ROWSS + (size_t)(2 * l + 2 < 4 ? 2 * l + 2 : 0) * M};
            pg8::gemm_phase<EpiResid, pg8::StaticOrder>(lds, g, S, E);
            SEAM(pb + 5);
        }
    }
#undef IN
#undef SEAM
}

extern "C" void kernel_launch(void* const* d_in, const int* in_sizes, int n_in, void* d_out, int out_size, void* d_ws, size_t ws_size, hipStream_t stream) {
    static int grid = 0;
    if (grid == 0) {
        if (n_in != 19 || in_sizes[0] != M * DM || out_size != M * DM || ws_size < WS_END) { fprintf(stderr, "kernel_launch: unexpected shapes / workspace (%d inputs, ws %zu)\n", n_in, ws_size); grid = -1; return; }
        int dev = 0, cus = 0, per_cu = 0;
        if (hipGetDevice(&dev) != hipSuccess || hipDeviceGetAttribute(&cus, hipDeviceAttributeMultiprocessorCount, dev) != hipSuccess) { grid = -1; return; }
        if (hipFuncSetAttribute((const void*)fwd_kernel, hipFuncAttributeMaxDynamicSharedMemorySize, LDS_BYTES) != hipSuccess) { fprintf(stderr, "kernel_launch: hipFuncSetAttribute failed\n"); grid = -1; return; }
        if (hipOccupancyMaxActiveBlocksPerMultiprocessor(&per_cu, (const void*)fwd_kernel, NWAVES * 64, LDS_BYTES) != hipSuccess || per_cu < 1) { fprintf(stderr, "kernel_launch: occupancy query says %d blocks per CU\n", per_cu); grid = -1; return; }
        grid = cus;
    }
    if (grid < 0) return;
    (void)hipMemsetAsync((char*)d_ws + WS_CTL, 0, CTL_BYTES, stream);
    Args a{};
    for (int i = 0; i < 19; ++i) a.in[i] = (const float*)d_in[i];
    a.out = (float*)d_out; a.ws = (unsigned char*)d_ws;
#if MK_MULTI
    for (int p = 0; p < N_PHASES; ++p) { a.ph_lo = p; a.ph_hi = p + 1; hipLaunchKernelGGL(fwd_kernel, dim3(grid), dim3(NWAVES * 64), LDS_BYTES, stream, a); }
#else
    a.ph_lo = 0; a.ph_hi = N_PHASES;
    void* kargs[] = {&a};
    hipError_t e = hipLaunchCooperativeKernel((const void*)fwd_kernel, dim3(grid), dim3(NWAVES * 64), kargs, LDS_BYTES, stream);
    if (e != hipSuccess) fprintf(stderr, "kernel_launch: cooperative launch failed: %s (grid %d)\n", hipGetErrorString(e), grid);
#endif
}
```

```cpp
#include <hip/hip_runtime.h>
#include <hip/hip_cooperative_groups.h>
#include <cstdio>
#include <cstdint>
namespace cg = cooperative_groups;

#ifndef PROBE
#define PROBE 0
#endif
#ifndef MK_MULTI
#define MK_MULTI 0
#endif

namespace pg8 {
#define PG8_LAS __attribute__((address_space(3)))
typedef unsigned short bf16_t;
typedef short bf16x8 __attribute__((ext_vector_type(8)));
typedef float f32x4 __attribute__((ext_vector_type(4)));
typedef unsigned u32x4 __attribute__((ext_vector_type(4)));
typedef unsigned u32x2 __attribute__((ext_vector_type(2)));
constexpr int BM = 256, BK = 64, HALF = 128, HTB = HALF * BK * 2, STAGE_BYTES = 8 * HTB, NXCD = 8, WGM = 8;

__host__ __device__ __forceinline__ int lds_byte(int r, int c) { const int st = (r >> 4) * 2 + (c >> 5), rr = r & 15, cc = c & 31, ob = rr * 64 + cc * 2; return st * 1024 + (ob ^ (((ob >> 9) & 1) << 5)); }
__host__ __device__ __forceinline__ void stage_rc(int b, int& R, int& C) { const int st = b / 1024, sb = b % 1024, swz = sb ^ (((sb >> 9) & 1) << 5); R = (st >> 1) * 16 + swz / 64; C = (st & 1) * 32 + (swz % 64) / 2; }
__host__ __device__ __forceinline__ int perm32(int rho) { const int n = rho >> 4, i = rho & 15; return 8 * (i >> 2) + 4 * n + (i & 3); }

struct Unit { int pm, pn, j; };
struct Gemm { const bf16_t* A; const bf16_t* Bt; int lda, K; size_t a_j1, a_j2, b_j;
    __device__ __forceinline__ size_t aoff(int j) const { return j == 0 ? (size_t)0 : (j == 1 ? a_j1 : a_j2); } };

struct StaticOrder {
    int nM, nN, nwg, G, c, NJ;
    __host__ __device__ void init(int M, int N, int G_, int c_, int NJ_ = 1) { nM = M / BM; nN = N / BM; nwg = nM * nN; G = G_; c = c_; NJ = NJ_; }
    __host__ __device__ bool next(int i, Unit& u) const {
        const int ti = i / NJ; u.j = i - ti * NJ;
        const long L = (long)ti * G + c; if (L >= nwg) return false;
        int wgid = (int)L; { const int q = nwg / NXCD, r = nwg % NXCD, xcd = wgid % NXCD, off = wgid / NXCD; wgid = (xcd < r ? xcd * (q + 1) : r * (q + 1) + (xcd - r) * q) + off; }
        const int nig = WGM * nN, gid = wgid / nig, fm = gid * WGM, gsz = (nM - fm) < WGM ? (nM - fm) : WGM;
        u.pm = fm + ((wgid % nig) % gsz); u.pn = (wgid % nig) / gsz; return true;
    }
};

__device__ __forceinline__ unsigned cvt_pk_bf16(float lo, float hi) { unsigned r; asm volatile("v_cvt_pk_bf16_f32 %0, %1, %2" : "=v"(r) : "v"(lo), "v"(hi)); return r; }

template <class Epi, class Sched>
__device__ __forceinline__ void gemm_phase(PG8_LAS unsigned char* lds, const Gemm g, const Sched& S, const Epi& E) {
    int tid_ = threadIdx.x; asm volatile("" : "+v"(tid_));
    const int tid = tid_, wid = __builtin_amdgcn_readfirstlane(tid >> 6), lane = tid & 63, wr = wid >> 2, wc = wid & 3, fr = lane & 15, fq = lane >> 4;
    const int K = g.K, nt = K / BK, lda = g.lda;
    unsigned voffA[2], voffB[2];
#pragma unroll
    for (int i = 0; i < 2; ++i) { int R, C; stage_rc(tid * 16 + i * 8192, R, C); const int Rb = Epi::PERM ? ((R & ~31) + perm32(R & 31)) : R;
        voffA[i] = (unsigned)(R * lda + C) * 2u; voffB[i] = (unsigned)(Rb * K + C) * 2u; }
    const size_t kstep = (size_t)(BK * 2);
    const size_t hstepA = (size_t)HALF * lda * 2, hstepB = (size_t)HALF * K * 2;
    const size_t tstepA = 2 * hstepA, tstepB = 2 * hstepB;
    const unsigned ldsw = (unsigned)wid * 1024u;
    const int aoff = lds_byte(wr * 64 + fr, fq * 8), boff = lds_byte(wc * 32 + fr, fq * 8);
#define PG8_SA(b, h) (((b) * 2 + (h)) * HTB)
#define PG8_SB(b, h) ((4 + (b) * 2 + (h)) * HTB)
#define PG8_STAGE(bufoff, gbase, voff) do { _Pragma("unroll") for (int _i = 0; _i < 2; ++_i) \
        __builtin_amdgcn_global_load_lds((const unsigned*)((const char*)(gbase) + (voff)[_i]), (PG8_LAS unsigned*)(lds + (bufoff) + ldsw + _i * 8192), 16, 0, 0); } while (0)
#define PG8_LDA(dst, b, h) do { _Pragma("unroll") for (int m = 0; m < 4; ++m) _Pragma("unroll") for (int k = 0; k < 2; ++k) dst[m][k] = *(const PG8_LAS bf16x8*)(lds + PG8_SA(b, h) + aoff + m * 2048 + k * 1024); } while (0)
#define PG8_LDB(dst, b, h) do { _Pragma("unroll") for (int n = 0; n < 2; ++n) _Pragma("unroll") for (int k = 0; k < 2; ++k) dst[n][k] = *(const PG8_LAS bf16x8*)(lds + PG8_SB(b, h) + boff + n * 2048 + k * 1024); } while (0)
#define PG8_MMA(ai, bj, At, Bt) do { __builtin_amdgcn_s_setprio(1); _Pragma("unroll") for (int m = 0; m < 4; ++m) _Pragma("unroll") for (int n = 0; n < 2; ++n) _Pragma("unroll") for (int k = 0; k < 2; ++k) \
        acc[ai][bj][m][n] = __builtin_amdgcn_mfma_f32_16x16x32_bf16(Bt[n][k], At[m][k], acc[ai][bj][m][n], 0, 0, 0); __builtin_amdgcn_s_setprio(0); } while (0)
#define PG8_WAIT_V(n) asm volatile("s_waitcnt vmcnt(" #n ")" ::: "memory")
#define PG8_WAIT_L(n) asm volatile("s_waitcnt lgkmcnt(" #n ")" ::: "memory")
#define PG8_BAR __builtin_amdgcn_s_barrier()
#define PG8_SCHED __builtin_amdgcn_sched_barrier(0)
    Unit cur, nxt; int ui = 0;
    if (!S.next(0, cur)) return;
    f32x4 acc[2][2][4][2];
#pragma unroll
    for (int a = 0; a < 2; ++a)
#pragma unroll
        for (int b = 0; b < 2; ++b)
#pragma unroll
            for (int m = 0; m < 4; ++m)
#pragma unroll
                for (int n = 0; n < 2; ++n) acc[a][b][m][n] = (f32x4){0.f, 0.f, 0.f, 0.f};
    bf16x8 At[4][2], B0[2][2], B1[2][2];
    const char* cA = (const char*)g.A + (size_t)cur.pm * tstepA + g.aoff(cur.j); const char* cB = (const char*)g.Bt + (size_t)cur.pn * tstepB + (size_t)cur.j * g.b_j;
    {
        PG8_STAGE(PG8_SB(0, 0), cB, voffB); PG8_STAGE(PG8_SB(0, 1), cB + hstepB, voffB); PG8_STAGE(PG8_SA(0, 0), cA, voffA); PG8_STAGE(PG8_SA(0, 1), cA + hstepA, voffA);
        if (wr == 1) PG8_BAR;
        PG8_WAIT_V(2); PG8_BAR;
        PG8_STAGE(PG8_SB(1, 0), cB + kstep, voffB); PG8_STAGE(PG8_SA(1, 0), cA + kstep, voffA); PG8_STAGE(PG8_SB(1, 1), cB + hstepB + kstep, voffB);
        PG8_WAIT_V(6); PG8_BAR;
    }
    for (;;) {
        const bool has_next = S.next(ui + 1, nxt);
        const char* nA = has_next ? (const char*)g.A + (size_t)nxt.pm * tstepA + g.aoff(nxt.j) : cA; const char* nB = has_next ? (const char*)g.Bt + (size_t)nxt.pn * tstepB + (size_t)nxt.j * g.b_j : cB;
        for (int t = 0; t < nt; t += 2) {
            const bool last = (t == nt - 2);
            const char* a1 = cA + (size_t)(t + 1) * kstep;
            const char* a2 = last ? nA : cA + (size_t)(t + 2) * kstep; const char* b2 = last ? nB : cB + (size_t)(t + 2) * kstep;
            const char* a3 = a2 + kstep; const char* b3 = b2 + kstep;
            PG8_LDB(B0, 0, 0); PG8_LDB(B1, 0, 1); PG8_SCHED; PG8_LDA(At, 0, 0); PG8_STAGE(PG8_SA(1, 1), a1 + hstepA, voffA);
            PG8_WAIT_V(8); PG8_WAIT_L(0); PG8_BAR; PG8_MMA(0, 0, At, B0); PG8_MMA(0, 1, At, B1); PG8_BAR; PG8_SCHED;
            PG8_LDA(At, 0, 1); PG8_STAGE(PG8_SB(0, 0), b2, voffB); PG8_STAGE(PG8_SB(0, 1), b2 + hstepB, voffB); PG8_STAGE(PG8_SA(0, 0), a2, voffA);
            PG8_WAIT_V(8); PG8_WAIT_L(0); PG8_BAR; PG8_MMA(1, 0, At, B0); PG8_MMA(1, 1, At, B1); PG8_BAR; PG8_SCHED;
            PG8_LDB(B0, 1, 0); PG8_LDB(B1, 1, 1); PG8_SCHED; PG8_LDA(At, 1, 0); PG8_STAGE(PG8_SA(0, 1), a2 + hstepA, voffA);
            PG8_WAIT_V(8); PG8_WAIT_L(0); PG8_BAR; PG8_MMA(0, 0, At, B0); PG8_MMA(0, 1, At, B1); PG8_BAR; PG8_SCHED;
            PG8_LDA(At, 1, 1); PG8_STAGE(PG8_SB(1, 0), b3, voffB); PG8_STAGE(PG8_SB(1, 1), b3 + hstepB, voffB); PG8_STAGE(PG8_SA(1, 0), a3, voffA);
            PG8_WAIT_V(8); PG8_WAIT_L(0); PG8_BAR; PG8_MMA(1, 0, At, B0); PG8_MMA(1, 1, At, B1); PG8_BAR; PG8_SCHED;
        }
        if (wr == 0) PG8_BAR;
        E(acc, cur, wr, wc, fr, fq);
        if (!has_next) break;
        if (!(Epi::ACCUM && nxt.j != 0)) {
#pragma unroll
        for (int a = 0; a < 2; ++a)
#pragma unroll
            for (int b = 0; b < 2; ++b)
#pragma unroll
                for (int m = 0; m < 4; ++m)
#pragma unroll
                    for (int n = 0; n < 2; ++n) acc[a][b][m][n] = (f32x4){0.f, 0.f, 0.f, 0.f};
        }
        cur = nxt; cA = nA; cB = nB; ++ui;
        if (wr == 1) PG8_BAR;
    }
    PG8_WAIT_V(0);
    PG8_BAR;
#undef PG8_SA
#undef PG8_SB
#undef PG8_STAGE
#undef PG8_LDA
#undef PG8_LDB
#undef PG8_MMA
#undef PG8_WAIT_V
#undef PG8_WAIT_L
#undef PG8_BAR
#undef PG8_SCHED
}
}

using pg8::bf16_t; using pg8::f32x4; using pg8::u32x4; using pg8::u32x2; using pg8::cvt_pk_bf16;
#define LAS __attribute__((address_space(3)))

constexpr int DM = 1024, NB = 4, SEQ = 4096, M = NB * SEQ, DEPTH = 2;
constexpr int NIN = 7168, NPM = 4096, NG = 3072, FF = 4096;
constexpr int C_AU = 0, C_AV = 512, C_Q = 1024, C_K = 1536, C_V = 2048, C_CB = 2560, C_CC = 3072, C_CX = 3584;
constexpr float EPS = 1e-6f;
constexpr float LOG2E = 1.4426950408889634f;

constexpr size_t MiB = 1u << 20;
constexpr size_t WS_CTL = 0, CTL_BYTES = 1 * MiB, WS_BAR = 512 * 1024;
constexpr size_t WS_WIN = 1 * MiB, WS_WBR = 15 * MiB, WS_WOUT = 18 * MiB;
constexpr size_t WS_WF1 = 20 * MiB, WS_WF2 = 28 * MiB;
constexpr size_t WS_XB = 36 * MiB;
constexpr size_t WS_PM = 68 * MiB;
constexpr size_t WS_G8 = 196 * MiB;
constexpr size_t WS_HB = 100 * MiB;
constexpr size_t WS_END = 244 * MiB;

constexpr int NWAVES = 8;
constexpr int RING_BYTES = 131072, LDS_BYTES = 139264;

struct Args { const float* in[19]; float* out; unsigned char* ws; int ph_lo, ph_hi; };

#define GAS __attribute__((address_space(1)))
#define XB_TMO      128
#define XB_XCNT(j)  (256  + 64 * (j))
#define XB_XSUB(j)  (1280 + 64 * (j))
#define XB_XGEN(j)  (2304 + 64 * (j))
#define XB_TOP      3328
#define XB_TOPGEN   3392
#define XCD_BAR_WORDS 3456
#define XB_SPIN_CAP (1u << 18)

__device__ __forceinline__ unsigned xb_ld(unsigned* p)              { return __hip_atomic_load(p, __ATOMIC_RELAXED, __HIP_MEMORY_SCOPE_AGENT); }
__device__ __forceinline__ unsigned xb_add(unsigned* p, unsigned v) { return __hip_atomic_fetch_add(p, v, __ATOMIC_RELAXED, __HIP_MEMORY_SCOPE_AGENT); }
__device__ __forceinline__ unsigned xb_xcc_id() { return (unsigned)__builtin_amdgcn_s_getreg((3 << 11) | 20) & 0xFu; }
#define XB_SPIN(cond, bar) do { unsigned _sp = 0; while (cond) { __builtin_amdgcn_s_sleep(1); \
    if ((++_sp & 255u) == 0u) { if (xb_ld(&(bar)[XB_TMO])) break; if (_sp > XB_SPIN_CAP) { atomicAdd(&(bar)[XB_TMO], 1u); break; } } } } while (0)

struct XcdBarrier {
    unsigned* bar; unsigned x;
    volatile LAS unsigned* st;
};

__device__ __forceinline__ XcdBarrier xcd_barrier_post(unsigned* bar, volatile LAS unsigned* st) {
    XcdBarrier b; b.bar = bar; b.x = xb_xcc_id(); b.st = st;
    if (threadIdx.x == 0) (void)xb_add(&bar[XB_XCNT(b.x)], 1u);
    return b;
}
__device__ __forceinline__ void xcd_barrier_complete(unsigned* bar, unsigned x, unsigned& nloc, unsigned& nx) {
    const unsigned G = gridDim.x * gridDim.y * gridDim.z;
    unsigned sum, cnt, mine, sp = 0u;
    for (;;) {
        sum = 0u; cnt = 0u; mine = 0u;
#pragma unroll
        for (unsigned j = 0; j < 16; ++j) { const unsigned c = xb_ld(&bar[XB_XCNT(j)]); sum += c; cnt += (c > 0u) ? 1u : 0u; mine = (j == x) ? c : mine; }
        if (sum == G) break;
        __builtin_amdgcn_s_sleep(1);
        if ((++sp & 255u) == 0u) { if (xb_ld(&bar[XB_TMO])) break; if (sp > XB_SPIN_CAP) { atomicAdd(&bar[XB_TMO], 1u); break; } }
    }
    nloc = mine > 0u ? mine : 1u; nx = cnt > 0u ? cnt : 1u;
}

__device__ __forceinline__ void xcd_barrier(const XcdBarrier& b) {
    asm volatile("s_waitcnt vmcnt(0)" ::: "memory");
    __syncthreads();
    if (threadIdx.x == 0) {
        unsigned* bar = b.bar;
        __builtin_amdgcn_s_waitcnt(0);
        unsigned nloc = b.st[0], nx = b.st[1];
        if (nloc == 0u) { xcd_barrier_complete(bar, b.x, nloc, nx); b.st[0] = nloc; b.st[1] = nx; }
        const unsigned old = xb_add(&bar[XB_XSUB(b.x)], 1u);
        const unsigned gen = old / nloc;
        if (old + 1u == (gen + 1u) * nloc) {
            __builtin_amdgcn_fence(__ATOMIC_RELEASE, "agent");
            asm volatile("s_waitcnt vmcnt(0)" ::: "memory");
            const unsigned og = xb_add(&bar[XB_TOP], 1u);
            const unsigned tg = og / nx;
            if (og + 1u == (tg + 1u) * nx) xb_add(&bar[XB_TOPGEN], 1u);
            else XB_SPIN(xb_ld(&bar[XB_TOPGEN]) == tg, bar);
            __builtin_amdgcn_fence(__ATOMIC_ACQUIRE, "agent");
            xb_add(&bar[XB_XGEN(b.x)], 1u);
            asm volatile("s_waitcnt vmcnt(0)" ::: "memory");
        } else {
            XB_SPIN(xb_ld(&bar[XB_XGEN(b.x)]) == gen, bar);
            __builtin_amdgcn_fence(__ATOMIC_ACQUIRE, "agent");
            asm volatile("s_waitcnt vmcnt(0)" ::: "memory");
        }
    }
    __syncthreads();
}

__device__ __forceinline__ float bf_lo(unsigned w) { return __uint_as_float(w << 16); }
__device__ __forceinline__ float bf_hi(unsigned w) { return __uint_as_float(w & 0xffff0000u); }
__device__ __forceinline__ float wave_sum(float v) {
#pragma unroll
    for (int o = 1; o < 64; o <<= 1) v += __shfl_xor(v, o);
    return v;
}
__device__ __forceinline__ float gelu_tanh(float x) {
    const float u = 0.7978845608028654f * (x + 0.044715f * x * x * x);
    return x * __builtin_amdgcn_rcpf(1.f + __builtin_amdgcn_exp2f(-2.f * LOG2E * u));
}
__device__ __forceinline__ float sigmoidf(float x) { return __builtin_amdgcn_rcpf(1.f + __builtin_amdgcn_exp2f(-LOG2E * x)); }
__device__ __forceinline__ float g8f(unsigned b) { return ((float)b + 0.5f) * (1.f / 256.f); }

__device__ __forceinline__ int inproj_phys(int n) {
    if (n < C_Q || n >= C_V) return n;
    const int t = n & ~255, g = (n & 255) >> 6, d = n & 63;
    return t + ((d >> 5) << 7) + (g << 5) + (d & 31);
}

struct EpiInProj {
    static constexpr bool PERM = true, ACCUM = false;
    bf16_t* PM; unsigned char* G8; const float* rowss; const float* gate_b; const float* qnw; const float* knw;
    __device__ __forceinline__ void operator()(f32x4 (&acc)[2][2][4][2], const pg8::Unit& u, int wr, int wc, int fr, int fq) const {
        const int row0 = u.pm * 256 + wr * 64 + fr;
        float rs[2][4];
#pragma unroll
        for (int ai = 0; ai < 2; ++ai)
#pragma unroll
            for (int m = 0; m < 4; ++m) rs[ai][m] = rsqrtf(rowss[row0 + ai * 128 + m * 16] * (1.f / DM) + EPS);
        const int pn = u.pn;
        if (pn < 4) {
            const int col0 = pn * 256 + wc * 32 + 8 * fq;
#pragma unroll
            for (int ai = 0; ai < 2; ++ai)
#pragma unroll
                for (int m = 0; m < 4; ++m) { bf16_t* rowp = PM + (size_t)(row0 + ai * 128 + m * 16) * NPM + col0; const float r = rs[ai][m];
#pragma unroll
                    for (int bj = 0; bj < 2; ++bj) { const f32x4 v0 = acc[ai][bj][m][0] * r, v1 = acc[ai][bj][m][1] * r; u32x4 w;
                        w.x = cvt_pk_bf16(gelu_tanh(v0[0]), gelu_tanh(v0[1])); w.y = cvt_pk_bf16(gelu_tanh(v0[2]), gelu_tanh(v0[3]));
                        w.z = cvt_pk_bf16(gelu_tanh(v1[0]), gelu_tanh(v1[1])); w.w = cvt_pk_bf16(gelu_tanh(v1[2]), gelu_tanh(v1[3]));
                        *(u32x4*)(rowp + bj * 128) = w; } }
        } else if (pn < 8) {
            const bool isq = pn < 6;
            const float* nw = (isq ? qnw : knw) + (wc & 1) * 64 + 8 * fq;
            const float extra = isq ? 0.125f * LOG2E : 1.f;
            float wv[2][8];
#pragma unroll
            for (int bj = 0; bj < 2; ++bj)
#pragma unroll
                for (int i = 0; i < 8; ++i) wv[bj][i] = nw[32 * bj + i] * extra;
            const int col0 = pn * 256 + 64 * wc + 8 * fq;
#pragma unroll
            for (int ai = 0; ai < 2; ++ai)
#pragma unroll
                for (int m = 0; m < 4; ++m) { bf16_t* rowp = PM + (size_t)(row0 + ai * 128 + m * 16) * NPM + col0; const float r = rs[ai][m];
                    f32x4 v[2][2]; float ss = 0.f;
#pragma unroll
                    for (int bj = 0; bj < 2; ++bj)
#pragma unroll
                        for (int n = 0; n < 2; ++n) { v[bj][n] = acc[ai][bj][m][n] * r; const f32x4 x = v[bj][n]; ss += (x[0] * x[0] + x[1] * x[1]) + (x[2] * x[2] + x[3] * x[3]); }
                    ss += __shfl_xor(ss, 16); ss += __shfl_xor(ss, 32);
                    const float rn = rsqrtf(ss * (1.f / 64.f) + EPS);
#pragma unroll
                    for (int bj = 0; bj < 2; ++bj) { const f32x4 v0 = v[bj][0] * rn, v1 = v[bj][1] * rn; u32x4 w;
                        w.x = cvt_pk_bf16(v0[0] * wv[bj][0], v0[1] * wv[bj][1]); w.y = cvt_pk_bf16(v0[2] * wv[bj][2], v0[3] * wv[bj][3]);
                        w.z = cvt_pk_bf16(v1[0] * wv[bj][4], v1[1] * wv[bj][5]); w.w = cvt_pk_bf16(v1[2] * wv[bj][6], v1[3] * wv[bj][7]);
                        *(u32x4*)(rowp + bj * 32) = w; } }
        } else if (pn < 16) {
            const int col0 = pn * 256 + wc * 32 + 8 * fq;
#pragma unroll
            for (int ai = 0; ai < 2; ++ai)
#pragma unroll
                for (int m = 0; m < 4; ++m) { bf16_t* rowp = PM + (size_t)(row0 + ai * 128 + m * 16) * NPM + col0; const float r = rs[ai][m];
#pragma unroll
                    for (int bj = 0; bj < 2; ++bj) { const f32x4 v0 = acc[ai][bj][m][0] * r, v1 = acc[ai][bj][m][1] * r; u32x4 w;
                        w.x = cvt_pk_bf16(v0[0], v0[1]); w.y = cvt_pk_bf16(v0[2], v0[3]); w.z = cvt_pk_bf16(v1[0], v1[1]); w.w = cvt_pk_bf16(v1[2], v1[3]);
                        *(u32x4*)(rowp + bj * 128) = w; } }
        } else {
            const int col0 = (pn - 16) * 256 + wc * 32 + 8 * fq;
            f32x4 bv[2][2];
#pragma unroll
            for (int bj = 0; bj < 2; ++bj)
#pragma unroll
                for (int n = 0; n < 2; ++n) bv[bj][n] = *(const f32x4*)(gate_b + col0 + bj * 128 + 4 * n);
#pragma unroll
            for (int ai = 0; ai < 2; ++ai)
#pragma unroll
                for (int m = 0; m < 4; ++m) { unsigned char* rowp = G8 + (size_t)(row0 + ai * 128 + m * 16) * NG + col0; const float r = rs[ai][m];
#pragma unroll
                    for (int bj = 0; bj < 2; ++bj) { unsigned q[8];
#pragma unroll
                        for (int n = 0; n < 2; ++n)
#pragma unroll
                            for (int e = 0; e < 4; ++e) { const float gx = sigmoidf(acc[ai][bj][m][n][e] * r + bv[bj][n][e]); q[4 * n + e] = (unsigned)__builtin_fminf(gx * 256.f, 255.f); }
                        u32x2 w; w.x = q[0] | (q[1] << 8) | (q[2] << 16) | (q[3] << 24); w.y = q[4] | (q[5] << 8) | (q[6] << 16) | (q[7] << 24);
                        *(u32x2*)(rowp + bj * 128) = w; } }
        }
    }
};

struct EpiBranch {
    static constexpr bool PERM = true, ACCUM = true;
    bf16_t* O; const unsigned char* G8;
    __device__ __forceinline__ void operator()(f32x4 (&acc)[2][2][4][2], const pg8::Unit& u, int wr, int wc, int fr, int fq) const {
        const int row0 = u.pm * 256 + wr * 64 + fr, col0 = u.pn * 256 + wc * 32 + 8 * fq, j = u.j;
#pragma unroll
        for (int ai = 0; ai < 2; ++ai)
#pragma unroll
            for (int m = 0; m < 4; ++m) { const size_t row = (size_t)(row0 + ai * 128 + m * 16);
#pragma unroll
                for (int bj = 0; bj < 2; ++bj) {
                    const u32x2 ga = *(const u32x2*)(G8 + row * NG + j * 1024 + col0 + bj * 128);
                    float f[8];
#pragma unroll
                    for (int e = 0; e < 4; ++e) { f[e] = g8f((ga.x >> (8 * e)) & 0xffu); f[4 + e] = g8f((ga.y >> (8 * e)) & 0xffu); }
                    if (j < 2) {
                        const u32x2 gb = *(const u32x2*)(G8 + row * NG + (j + 1) * 1024 + col0 + bj * 128);
#pragma unroll
                        for (int e = 0; e < 4; ++e) { f[e] *= __builtin_amdgcn_rcpf(g8f((gb.x >> (8 * e)) & 0xffu)); f[4 + e] *= __builtin_amdgcn_rcpf(g8f((gb.y >> (8 * e)) & 0xffu)); }
                    }
#pragma unroll
                    for (int e = 0; e < 4; ++e) { acc[ai][bj][m][0][e] *= f[e]; acc[ai][bj][m][1][e] *= f[4 + e]; }
                    if (j == 2) { const f32x4 v0 = acc[ai][bj][m][0], v1 = acc[ai][bj][m][1]; u32x4 w;
                        w.x = cvt_pk_bf16(v0[0], v0[1]); w.y = cvt_pk_bf16(v0[2], v0[3]); w.z = cvt_pk_bf16(v1[0], v1[1]); w.w = cvt_pk_bf16(v1[2], v1[3]);
                        *(u32x4*)(O + row * DM + col0 + bj * 128) = w; }
                } }
    }
};

struct EpiResid {
    static constexpr bool PERM = false, ACCUM = false;
    const float* xin; float* xout; bf16_t* xb; float* rowss;
    __device__ __forceinline__ void operator()(f32x4 (&acc)[2][2][4][2], const pg8::Unit& u, int wr, int wc, int fr, int fq) const {
        const int row0 = u.pm * 256 + wr * 64 + fr, col0 = u.pn * 256 + wc * 32 + 4 * fq;
#pragma unroll
        for (int ai = 0; ai < 2; ++ai)
#pragma unroll
            for (int m = 0; m < 4; ++m) { const int row = row0 + ai * 128 + m * 16; const size_t off = (size_t)row * DM + col0; float ss = 0.f;
#pragma unroll
                for (int bj = 0; bj < 2; ++bj)
#pragma unroll
                    for (int n = 0; n < 2; ++n) { const size_t o = off + bj * 128 + n * 16; const f32x4 x = *(const f32x4*)(xin + o) + acc[ai][bj][m][n];
                        *(f32x4*)(xout + o) = x;
                        if (xb) { u32x2 w; w.x = cvt_pk_bf16(x[0], x[1]); w.y = cvt_pk_bf16(x[2], x[3]); *(u32x2*)(xb + o) = w; ss += (x[0] * x[0] + x[1] * x[1]) + (x[2] * x[2] + x[3] * x[3]); } }
                if (xb) { ss += __shfl_xor(ss, 16); ss += __shfl_xor(ss, 32); if (fq == 0) atomicAdd(rowss + row, ss); } }
    }
};

struct EpiFF1 {
    static constexpr bool PERM = true, ACCUM = false;
    bf16_t* O; const float* rowss;
    __device__ __forceinline__ void operator()(f32x4 (&acc)[2][2][4][2], const pg8::Unit& u, int wr, int wc, int fr, int fq) const {
        const int row0 = u.pm * 256 + wr * 64 + fr, col0 = u.pn * 256 + wc * 32 + 8 * fq;
#pragma unroll
        for (int ai = 0; ai < 2; ++ai)
#pragma unroll
            for (int m = 0; m < 4; ++m) { const int row = row0 + ai * 128 + m * 16; const float r = rsqrtf(rowss[row] * (1.f / DM) + EPS); bf16_t* rowp = O + (size_t)row * FF + col0;
#pragma unroll
                for (int bj = 0; bj < 2; ++bj) { f32x4 v0 = acc[ai][bj][m][0] * r, v1 = acc[ai][bj][m][1] * r;
#pragma unroll
                    for (int e = 0; e < 4; ++e) { const float a = __builtin_fmaxf(v0[e], 0.f), b = __builtin_fmaxf(v1[e], 0.f); v0[e] = a * a; v1[e] = b * b; }
                    u32x4 w; w.x = cvt_pk_bf16(v0[0], v0[1]); w.y = cvt_pk_bf16(v0[2], v0[3]); w.z = cvt_pk_bf16(v1[0], v1[1]); w.w = cvt_pk_bf16(v1[2], v1[3]);
                    *(u32x4*)(rowp + bj * 128) = w; } }
    }
};

template <bool INPERM>
__device__ __forceinline__ void transpose_item(const float* W, const float* kscale, int K, int N, bf16_t* WT, LAS float* scr, int item, int lane) {
    const int nblk = N / 32, kb = item / nblk, nb = item % nblk, k0 = 64 * kb, n0 = 32 * nb;
#pragma unroll 8
    for (int i = 0; i < 32; ++i) { const int kk = 2 * i + (lane >> 5); float v = W[(size_t)(k0 + kk) * N + n0 + (lane & 31)]; if (kscale) v *= kscale[k0 + kk]; scr[kk * 33 + (lane & 31)] = v; }
    asm volatile("s_waitcnt lgkmcnt(0)" ::: "memory");
    const int c = lane & 7;
    const int r0 = INPERM ? inproj_phys(n0) : n0;
#pragma unroll
    for (int j = 0; j < 4; ++j) { const int n = (lane >> 3) + 8 * j; const LAS float* s = scr + (8 * c) * 33 + n;
        u32x4 o; o.x = cvt_pk_bf16(s[0 * 33], s[1 * 33]); o.y = cvt_pk_bf16(s[2 * 33], s[3 * 33]); o.z = cvt_pk_bf16(s[4 * 33], s[5 * 33]); o.w = cvt_pk_bf16(s[6 * 33], s[7 * 33]);
        *(u32x4*)(WT + (size_t)(r0 + n) * K + k0 + 8 * c) = o; }
    asm volatile("s_waitcnt lgkmcnt(0)" ::: "memory");
}
constexpr int IT_WIN = 16 * 224, IT_BR = 8 * 32, IT_OUT = 16 * 32, IT_F1 = 16 * 128, IT_F2 = 64 * 32;
__device__ __forceinline__ void convert_region_a(const Args& a, int l, LAS unsigned char* lds, int gw, int ngw, int wave, int lane) {
    LAS float* scr = (LAS float*)(lds + wave * 16384);
    unsigned char* ws = a.ws;
    constexpr int NIT = IT_WIN + 3 * IT_BR + IT_OUT;
    for (int it = gw; it < NIT; it += ngw) {
        int r = it;
        if (r < IT_WIN) { transpose_item<true>(a.in[2] + (size_t)l * DM * NIN, a.in[1] + l * DM, DM, NIN, (bf16_t*)(ws + WS_WIN), scr, r, lane); continue; } r -= IT_WIN;
        if (r < 3 * IT_BR) { const int j = r / IT_BR; transpose_item<false>(a.in[12 + j] + (size_t)l * 512 * DM, nullptr, 512, DM, (bf16_t*)(ws + WS_WBR + j * MiB), scr, r % IT_BR, lane); continue; } r -= 3 * IT_BR;
        transpose_item<false>(a.in[15] + (size_t)l * DM * DM, nullptr, DM, DM, (bf16_t*)(ws + WS_WOUT), scr, r, lane);
    }
}
__device__ __forceinline__ void convert_region_b(const Args& a, int l, LAS unsigned char* lds, int gw, int ngw, int wave, int lane) {
    LAS float* scr = (LAS float*)(lds + wave * 16384);
    unsigned char* ws = a.ws;
    constexpr int NIT = IT_F1 + IT_F2;
    for (int it = gw; it < NIT; it += ngw) {
        int r = it;
        if (r < IT_F1) { transpose_item<false>(a.in[17] + (size_t)l * DM * FF, a.in[16] + l * DM, DM, FF, (bf16_t*)(ws + WS_WF1), scr, r, lane); continue; } r -= IT_F1;
        transpose_item<false>(a.in[18] + (size_t)l * FF * DM, nullptr, FF, DM, (bf16_t*)(ws + WS_WF2), scr, r, lane);
    }
}

namespace att {
typedef short bf16x8 __attribute__((ext_vector_type(8)));
typedef short s16x4 __attribute__((ext_vector_type(4)));
typedef short v4i16_t __attribute__((ext_vector_type(4)));
typedef float f32x16 __attribute__((ext_vector_type(16)));
typedef float f32x2_t __attribute__((ext_vector_type(2))); typedef __bf16 bf16x2_t __attribute__((ext_vector_type(2)));
__device__ __forceinline__ unsigned cvtpk_s(float lo, float hi) { f32x2_t v = {lo, hi}; bf16x2_t b = __builtin_convertvector(v, bf16x2_t); return __builtin_bit_cast(unsigned, b); }
__device__ __forceinline__ s16x4 vtr(const LAS unsigned char* p) { return __builtin_bit_cast(s16x4, __builtin_amdgcn_ds_read_tr16_b64_v4i16((LAS v4i16_t*)p)); }
constexpr int KSTR = 144, VSTR = 320, KMAP = 64 * KSTR, V_OFF = 2 * KMAP, BUF = V_OFF + 64 * VSTR;
__device__ __forceinline__ bf16x8 pack8(const f32x16& p, int o) {
    u32x4 w; w.x = cvtpk_s(p[o], p[o + 1]); w.y = cvtpk_s(p[o + 2], p[o + 3]); w.z = cvtpk_s(p[o + 4], p[o + 5]); w.w = cvtpk_s(p[o + 6], p[o + 7]); return __builtin_bit_cast(bf16x8, w); }

__device__ __forceinline__ void attn_unit(bf16_t* PM, bf16_t* obase, int opitch, int b, int h, int qb, float lam, float post, const float* subw, LAS unsigned char* lds, int tid) {
    const int lane = tid & 63, wid = __builtin_amdgcn_readfirstlane(tid >> 6), r32 = lane & 31, hi = lane >> 5, m = wid >> 2, qs = wid & 3;
    const int qpos = 128 * qb + 32 * qs + r32;
    bf16_t* base = PM + (size_t)b * SEQ * NPM;
    bf16_t* qrow = base + (size_t)qpos * NPM + C_Q + h * 128;
    bf16_t* orow = obase + (size_t)(b * SEQ + qpos) * opitch + h * 128;
    bf16x8 qr[4];
#pragma unroll
    for (int d0 = 0; d0 < 4; ++d0) qr[d0] = *(const bf16x8*)(qrow + m * 64 + d0 * 16 + hi * 8);
    const int NT = 2 * (qb + 1), my_nt = (qs < 2) ? NT - 1 : NT;
    const float sl2 = __builtin_amdgcn_exp2f(-2.f * (float)(h + 1)) * LOG2E;
    const bf16_t* gk = base + (size_t)(tid >> 3) * NPM + C_K + h * 128 + (tid & 7) * 8;
    const bf16_t* gv = base + (size_t)(tid >> 4) * NPM + C_V + h * 128 + (tid & 15) * 8;
    const int lk = (tid >> 3) * KSTR + (tid & 7) * 16, lv = V_OFF + (tid >> 4) * VSTR + (tid & 15) * 16;
    u32x4 st0, st1, st2, st3;
#define ATT_LOAD(t) do { const size_t ro = (size_t)(t) * 64 * NPM; st0 = *(const u32x4*)(gk + ro); st1 = *(const u32x4*)(gk + ro + 64); st2 = *(const u32x4*)(gv + ro); st3 = *(const u32x4*)(gv + ro + (size_t)32 * NPM); } while (0)
#define ATT_STORE(bufp) do { *(LAS u32x4*)((bufp) + lk) = st0; *(LAS u32x4*)((bufp) + KMAP + lk) = st1; *(LAS u32x4*)((bufp) + lv) = st2; *(LAS u32x4*)((bufp) + lv + 32 * VSTR) = st3; } while (0)
    __syncthreads();
    ATT_LOAD(0); ATT_STORE(lds);
    __syncthreads();
    f32x16 OT[4];
#pragma unroll
    for (int eb = 0; eb < 4; ++eb)
#pragma unroll
        for (int r = 0; r < 16; ++r) OT[eb][r] = 0.f;
    float mrun = -1e30f, lsum = 0.f;
    for (int t = 0; t < NT; ++t) {
        LAS unsigned char* buf = lds + (t & 1) * BUF;
        if (t + 1 < NT) ATT_LOAD(t + 1);
        if (t < my_nt) {
            const LAS unsigned char* kp = buf + m * KMAP + r32 * KSTR + hi * 16;
            f32x16 p0, p1;
#pragma unroll
            for (int r = 0; r < 16; ++r) { p0[r] = 0.f; p1[r] = 0.f; }
#pragma unroll
            for (int d0 = 0; d0 < 4; ++d0) {
                const bf16x8 ka = *(const LAS bf16x8*)(kp + d0 * 32), kb2 = *(const LAS bf16x8*)(kp + 32 * KSTR + d0 * 32);
                p0 = __builtin_amdgcn_mfma_f32_32x32x16_bf16(ka, qr[d0], p0, 0, 0, 0);
                p1 = __builtin_amdgcn_mfma_f32_32x32x16_bf16(kb2, qr[d0], p1, 0, 0, 0);
            }
            const float dq = (float)(qpos - 64 * t - 4 * hi);
            float mt = -1e30f;
#pragma unroll
            for (int r = 0; r < 16; ++r) { const float c = (float)((r & 3) + 8 * (r >> 2));
                p0[r] = __builtin_fmaf(-sl2, __builtin_fabsf(dq - c), p0[r]); p1[r] = __builtin_fmaf(-sl2, __builtin_fabsf(dq - (c + 32.f)), p1[r]);
                mt = __builtin_fmaxf(mt, __builtin_fmaxf(p0[r], p1[r])); }
            mt = __builtin_fmaxf(mt, __shfl_xor(mt, 32));
            const float mnew = __builtin_fmaxf(mrun, mt);
            if (__any(mnew > mrun)) {
                const float alpha = __builtin_amdgcn_exp2f(mrun - mnew); lsum *= alpha;
#pragma unroll
                for (int eb = 0; eb < 4; ++eb)
#pragma unroll
                    for (int r = 0; r < 16; ++r) OT[eb][r] *= alpha;
                mrun = mnew;
            }
            float sacc = 0.f;
#pragma unroll
            for (int r = 0; r < 16; ++r) { p0[r] = __builtin_amdgcn_exp2f(p0[r] - mrun); p1[r] = __builtin_amdgcn_exp2f(p1[r] - mrun); sacc += p0[r] + p1[r]; }
            lsum += sacc;
            bf16x8 pf[4]; pf[0] = pack8(p0, 0); pf[1] = pack8(p0, 8); pf[2] = pack8(p1, 0); pf[3] = pack8(p1, 8);
            const LAS unsigned char* vp = buf + V_OFF + (4 * hi + ((lane & 15) >> 2)) * VSTR + ((lane >> 4) & 1) * 32 + (lane & 3) * 8;
#pragma unroll
            for (int s4 = 0; s4 < 4; ++s4)
#pragma unroll
                for (int eb = 0; eb < 4; ++eb) {
                    const s16x4 vlo = vtr(vp + (16 * s4) * VSTR + eb * 64), vhi = vtr(vp + (16 * s4 + 8) * VSTR + eb * 64);
                    const bf16x8 vf = (bf16x8){vlo[0], vlo[1], vlo[2], vlo[3], vhi[0], vhi[1], vhi[2], vhi[3]};
                    OT[eb] = __builtin_amdgcn_mfma_f32_32x32x16_bf16(vf, pf[s4], OT[eb], 0, 0, 0);
                }
        }
        if (t + 1 < NT) ATT_STORE(lds + ((t + 1) & 1) * BUF);
        __syncthreads();
    }
#undef ATT_LOAD
#undef ATT_STORE
    lsum += __shfl_xor(lsum, 32);
    const float inv = 1.f / lsum;
#pragma unroll
    for (int eb = 0; eb < 4; ++eb)
#pragma unroll
        for (int r = 0; r < 16; ++r) OT[eb][r] *= inv;
    LAS float* X = (LAS float*)(lds + qs * 16384) + lane;
    if (m == 1) {
#pragma unroll
        for (int eb = 0; eb < 4; ++eb)
#pragma unroll
            for (int r = 0; r < 16; ++r) X[(eb * 16 + r) * 64] = OT[eb][r];
    }
    __syncthreads();
    if (m == 0) {
        float ss = 0.f;
#pragma unroll
        for (int eb = 0; eb < 4; ++eb)
#pragma unroll
            for (int r = 0; r < 16; ++r) { const float o = OT[eb][r] - lam * X[(eb * 16 + r) * 64]; OT[eb][r] = o; ss += o * o; }
        ss += __shfl_xor(ss, 32);
        const float rn = rsqrtf(ss * (1.f / 128.f) + EPS) * post;
#pragma unroll
        for (int eb = 0; eb < 4; ++eb)
#pragma unroll
            for (int rg = 0; rg < 4; ++rg) { const int e = 32 * eb + 8 * rg + 4 * hi; const f32x4 w4 = *(const f32x4*)(subw + e);
                u32x2 w; w.x = cvtpk_s(OT[eb][4 * rg] * rn * w4[0], OT[eb][4 * rg + 1] * rn * w4[1]); w.y = cvtpk_s(OT[eb][4 * rg + 2] * rn * w4[2], OT[eb][4 * rg + 3] * rn * w4[3]);
                *(u32x2*)(orow + e) = w; }
    }
}
}

__device__ __forceinline__ void gmlp_unit(bf16_t* PM, bf16_t* obase, int opitch, const float* vnw, const float* ws_g, const float* bs_g, int rowbase, int g, LAS unsigned char* lds, int tid) {
    LAS float* Vt = (LAS float*)lds; LAS float* Wsl = (LAS float*)(lds + 65536);
    __syncthreads();
    {
        const int row = tid >> 2, part = tid & 3;
        const bf16_t* rp = PM + (size_t)(rowbase + row) * NPM + C_AV;
        float ss = 0.f;
#pragma unroll
        for (int i = 0; i < 16; ++i) { const u32x4 w = *(const u32x4*)(rp + part * 128 + i * 8);
            const float a0 = bf_lo(w.x), a1 = bf_hi(w.x), a2 = bf_lo(w.y), a3 = bf_hi(w.y), a4 = bf_lo(w.z), a5 = bf_hi(w.z), a6 = bf_lo(w.w), a7 = bf_hi(w.w);
            ss += (a0 * a0 + a1 * a1) + (a2 * a2 + a3 * a3) + (a4 * a4 + a5 * a5) + (a6 * a6 + a7 * a7); }
        ss += __shfl_xor(ss, 1); ss += __shfl_xor(ss, 2);
        const float r = rsqrtf(ss * (1.f / 512.f) + EPS);
        const int c0 = part * 32;
#pragma unroll
        for (int i = 0; i < 4; ++i) { const u32x4 w = *(const u32x4*)(rp + g * 128 + c0 + i * 8); const float* nw = vnw + g * 128 + c0 + i * 8;
            f32x4 lo, hi; lo[0] = bf_lo(w.x) * r * nw[0]; lo[1] = bf_hi(w.x) * r * nw[1]; lo[2] = bf_lo(w.y) * r * nw[2]; lo[3] = bf_hi(w.y) * r * nw[3];
            hi[0] = bf_lo(w.z) * r * nw[4]; hi[1] = bf_hi(w.z) * r * nw[5]; hi[2] = bf_lo(w.w) * r * nw[6]; hi[3] = bf_hi(w.w) * r * nw[7];
            *(LAS f32x4*)(Vt + row * 128 + c0 + i * 8) = lo; *(LAS f32x4*)(Vt + row * 128 + c0 + i * 8 + 4) = hi; }
#pragma unroll 4
        for (int i = 0; i < 8; ++i) { const int e4 = (i * 512 + tid) * 4, t = e4 >> 7, s = e4 & 127; f32x4 w = *(const f32x4*)(ws_g + e4);
#pragma unroll
            for (int e = 0; e < 4; ++e) if (s + e > t) w[e] = 0.f;
            *(LAS f32x4*)(Wsl + e4) = w; }
    }
    __syncthreads();
    const int c = tid & 127, tg = tid >> 7;
    float acc[32];
#pragma unroll
    for (int i = 0; i < 32; ++i) acc[i] = 0.f;
    const int smax = 32 * (tg + 1);
    for (int s = 0; s < smax; s += 4) {
        const float v0 = Vt[s * 128 + c], v1 = Vt[(s + 1) * 128 + c], v2 = Vt[(s + 2) * 128 + c], v3 = Vt[(s + 3) * 128 + c];
#pragma unroll
        for (int i = 0; i < 32; ++i) { const f32x4 w = *(const LAS f32x4*)(Wsl + (32 * tg + i) * 128 + s); acc[i] += (w[0] * v0 + w[1] * v1) + (w[2] * v2 + w[3] * v3); }
    }
#pragma unroll
    for (int i = 0; i < 32; ++i) { const int t = 32 * tg + i; bf16_t* p = PM + (size_t)(rowbase + t) * NPM + C_AU + g * 128 + c;
        const float uu = __uint_as_float((unsigned)(*p) << 16); const float y = uu * (acc[i] + bs_g[t]);
        obase[(size_t)(rowbase + t) * opitch + g * 128 + c] = (bf16_t)(cvt_pk_bf16(y, 0.f) & 0xffffu); }
}

__device__ __forceinline__ void conv_items(bf16_t* PM, const float* cw, int gtid, int gthreads) {
    for (int idx = gtid; idx < M * 64; idx += gthreads) {
        const int row = idx >> 6, c0 = (idx & 63) * 8, spos = row & (SEQ - 1);
        bf16_t* rp = PM + (size_t)row * NPM;
        float z[3][8];
#pragma unroll
        for (int j = 0; j < 3; ++j) { const int dt = 2 - j;
            if (spos >= dt) { const u32x4 a = *(const u32x4*)(rp - (size_t)dt * NPM + C_CC + c0), b = *(const u32x4*)(rp - (size_t)dt * NPM + C_CX + c0);
                z[j][0] = bf_lo(a.x) * bf_lo(b.x); z[j][1] = bf_hi(a.x) * bf_hi(b.x); z[j][2] = bf_lo(a.y) * bf_lo(b.y); z[j][3] = bf_hi(a.y) * bf_hi(b.y);
                z[j][4] = bf_lo(a.z) * bf_lo(b.z); z[j][5] = bf_hi(a.z) * bf_hi(b.z); z[j][6] = bf_lo(a.w) * bf_lo(b.w); z[j][7] = bf_hi(a.w) * bf_hi(b.w);
            } else {
#pragma unroll
                for (int e = 0; e < 8; ++e) z[j][e] = 0.f; } }
        const u32x4 cb = *(const u32x4*)(rp + C_CB + c0);
        float y[8];
#pragma unroll
        for (int e = 0; e < 8; ++e) y[e] = cw[c0 + e] * z[0][e] + cw[512 + c0 + e] * z[1][e] + cw[1024 + c0 + e] * z[2][e];
        u32x4 w; w.x = cvt_pk_bf16(bf_lo(cb.x) * y[0], bf_hi(cb.x) * y[1]); w.y = cvt_pk_bf16(bf_lo(cb.y) * y[2], bf_hi(cb.y) * y[3]);
        w.z = cvt_pk_bf16(bf_lo(cb.z) * y[4], bf_hi(cb.z) * y[5]); w.w = cvt_pk_bf16(bf_lo(cb.w) * y[6], bf_hi(cb.w) * y[7]);
        *(u32x4*)(rp + C_CB + c0) = w;
    }
}

constexpr int N_PHASES = 1 + 6 * DEPTH;
__global__ void __launch_bounds__(NWAVES * 64, 2) fwd_kernel(Args args) {
    extern __shared__ __attribute__((aligned(16))) unsigned char lds_raw[];
    LAS unsigned char* lds = (LAS unsigned char*)lds_raw;
    const int G = gridDim.x, bx = blockIdx.x, ngw = G * NWAVES, gthreads = G * NWAVES * 64;
#define TIDS() int tid_ = threadIdx.x; asm volatile("" : "+v"(tid_)); const int tid = tid_, lane = tid & 63, wave = __builtin_amdgcn_readfirstlane(tid >> 6), gw = bx * NWAVES + wave, gtid = bx * (NWAVES * 64) + tid; (void)lane; (void)gw; (void)gtid
    unsigned char* ws = args.ws;
    float* ROWSS = (float*)(ws + WS_CTL);
    bf16_t* XB = (bf16_t*)(ws + WS_XB); bf16_t* PM = (bf16_t*)(ws + WS_PM); bf16_t* XBM = (bf16_t*)(ws + WS_PM); bf16_t* HB = (bf16_t*)(ws + WS_HB);
    unsigned char* G8 = ws + WS_G8;
    const int lo = args.ph_lo, hi = args.ph_hi;
#if !MK_MULTI
    cg::grid_group grid = cg::this_grid();
    volatile LAS unsigned* bst = (volatile LAS unsigned*)(lds + RING_BYTES + 512);
    if (threadIdx.x < 2) bst[threadIdx.x] = 0u;
    __syncthreads();
    const XcdBarrier xbar = xcd_barrier_post((unsigned*)(ws + WS_BAR), bst);
#define SEAM(ph) do { if ((ph) + 1 < hi) { if ((ph) == 0) grid.sync(); else xcd_barrier(xbar); if (PROBE == 6) { xcd_barrier(xbar); xcd_barrier(xbar); } } } while (0)
#else
#define SEAM(ph) do { } while (0)
#endif
#define IN(k) (lo <= (k) && (k) < hi)

    if (IN(0)) {
        TIDS();
        for (int rep = 0; rep < (PROBE == 1 ? 2 : 1); ++rep) {
        convert_region_a(args, 0, lds, gw, ngw, wave, lane);
        convert_region_b(args, 0, lds, gw, ngw, wave, lane); }
        const float* x = args.in[0];
        for (int r = gw; r < M; r += ngw) {
            const f32x4* xr = (const f32x4*)(x + (size_t)r * DM) + lane; u32x2* o = (u32x2*)(XB + (size_t)r * DM) + lane; float s = 0.f;
#pragma unroll
            for (int j = 0; j < 4; ++j) { const f32x4 v = xr[64 * j]; s += (v[0] * v[0] + v[1] * v[1]) + (v[2] * v[2] + v[3] * v[3]); u32x2 w; w.x = cvt_pk_bf16(v[0], v[1]); w.y = cvt_pk_bf16(v[2], v[3]); o[64 * j] = w; }
            s = wave_sum(s); if (lane == 0) ROWSS[r] = s;
        }
        SEAM(0);
    }
    for (int l = 0; l < DEPTH; ++l) {
        const int pb = 1 + 6 * l;
        const float* xres_in = (l == 0) ? args.in[0] : args.out;
        if (IN(pb + 0)) {
            pg8::Gemm g{XB, (const bf16_t*)(ws + WS_WIN), DM, DM, 0, 0, 0}; pg8::StaticOrder S; S.init(M, NIN, G, bx);
            EpiInProj E{PM, G8, ROWSS + (size_t)(2 * l) * M, args.in[3] + l * NG, args.in[7] + l * 128, args.in[8] + l * 128};
            pg8::gemm_phase<EpiInProj, pg8::StaticOrder>(lds, g, S, E);
#if PROBE == 2
            pg8::gemm_phase<EpiInProj, pg8::StaticOrder>(lds, g, S, E);
#endif
            SEAM(pb + 0);
        }
        if (IN(pb + 1)) {
            TIDS();
            if (l == 1) convert_region_b(args, 1, lds, gw, ngw, wave, lane);
            const float* lp = args.in[9] + l * 256;
            const float sa = wave_sum(lp[lane] * lp[64 + lane]), sb = wave_sum(lp[128 + lane] * lp[192 + lane]);
            const float lam_init = 0.8f - 0.6f * expf(-0.3f * (float)l);
            const float lam = expf(sa) - expf(sb) + lam_init;
#if PROBE == 4
            for (int pi = bx; pi < 256; pi += G) { const int bh = pi >> 4, sq = pi & 15;
                att::attn_unit(PM, XB, DM, bh >> 2, bh & 3, 31 - sq, lam, 1.f - lam_init, args.in[10] + l * 128, lds, tid);
                att::attn_unit(PM, XB, DM, bh >> 2, bh & 3, sq, lam, 1.f - lam_init, args.in[10] + l * 128, lds, tid); }
#endif
            for (int pi = bx; pi < 256; pi += G) { const int bh = pi >> 4, sq = pi & 15;
                att::attn_unit(PM, PM + C_Q, NPM, bh >> 2, bh & 3, 31 - sq, lam, 1.f - lam_init, args.in[10] + l * 128, lds, tid);
                att::attn_unit(PM, PM + C_Q, NPM, bh >> 2, bh & 3, sq, lam, 1.f - lam_init, args.in[10] + l * 128, lds, tid); }
#if PROBE == 5
            for (int uu = bx; uu < 512; uu += G) { const int g4 = uu & 3, blk = uu >> 2;
                gmlp_unit(PM, XB, DM, args.in[4] + l * 512, args.in[5] + (size_t)(l * 4 + g4) * 16384, args.in[6] + (l * 4 + g4) * 128, blk * 128, g4, lds, tid); }
#endif
            for (int uu = bx; uu < 512; uu += G) { const int g4 = uu & 3, blk = uu >> 2;
                gmlp_unit(PM, PM + C_AU, NPM, args.in[4] + l * 512, args.in[5] + (size_t)(l * 4 + g4) * 16384, args.in[6] + (l * 4 + g4) * 128, blk * 128, g4, lds, tid); }
            conv_items(PM, args.in[11] + l * 1536, gtid, gthreads);
            SEAM(pb + 1);
        }
        if (IN(pb + 2)) {
            pg8::Gemm g{PM + C_AU, (const bf16_t*)(ws + WS_WBR), NPM, 512, (size_t)(C_Q - C_AU) * 2, (size_t)(C_CB - C_AU) * 2, MiB}; pg8::StaticOrder S; S.init(M, DM, G, bx, 3);
            EpiBranch E{XB, G8};
            pg8::gemm_phase<EpiBranch, pg8::StaticOrder>(lds, g, S, E);
#if PROBE == 7
            pg8::gemm_phase<EpiBranch, pg8::StaticOrder>(lds, g, S, E);
#endif
            SEAM(pb + 2);
        }
        if (IN(pb + 3)) {
            pg8::Gemm g{XB, (const bf16_t*)(ws + WS_WOUT), DM, DM, 0, 0, 0}; pg8::StaticOrder S; S.init(M, DM, G, bx);
            EpiResid E{xres_in, args.out, XBM, ROWSS + (size_t)(2 * l + 1) * M};
            pg8::gemm_phase<EpiResid, pg8::StaticOrder>(lds, g, S, E);
            SEAM(pb + 3);
        }
        if (IN(pb + 4)) {
            if (l == 0) { TIDS(); convert_region_a(args, 1, lds, gw, ngw, wave, lane); }
            __syncthreads();
            pg8::Gemm g{XBM, (const bf16_t*)(ws + WS_WF1), DM, DM, 0, 0, 0}; pg8::StaticOrder S; S.init(M, FF, G, bx);
            EpiFF1 E{HB, ROWSS + (size_t)(2 * l + 1) * M};
            pg8::gemm_phase<EpiFF1, pg8::StaticOrder>(lds, g, S, E);
#if PROBE == 3
            pg8::gemm_phase<EpiFF1, pg8::StaticOrder>(lds, g, S, E);
#endif
            SEAM(pb + 4);
        }
        if (IN(pb + 5)) {
            pg8::Gemm g{HB, (const bf16_t*)(ws + WS_WF2), FF, FF, 0, 0, 0}; pg8::StaticOrder S; S.init(M, DM, G, bx);
            EpiResid E{args.out, args.out, (l + 1 < DEPTH) ? XB : nullptr, ROWSS + (size_t)(2 * l + 2 < 4 ? 2 * l + 2 : 0) * M};
            pg8::gemm_phase<EpiResid, pg8::StaticOrder>(lds, g, S, E);
            SEAM(pb + 5);
        }
    }
#undef IN
#undef SEAM
}

extern "C" void kernel_launch(void* const* d_in, const int* in_sizes, int n_in, void* d_out, int out_size, void* d_ws, size_t ws_size, hipStream_t stream) {
    static int grid = 0;
    if (grid == 0) {
        if (n_in != 19 || in_sizes[0] != M * DM || out_size != M * DM || ws_size < WS_END) { fprintf(stderr, "kernel_launch: unexpected shapes / workspace (%d inputs, ws %zu)\n", n_in, ws_size); grid = -1; return; }
        int dev = 0, cus = 0, per_cu = 0;
        if (hipGetDevice(&dev) != hipSuccess || hipDeviceGetAttribute(&cus, hipDeviceAttributeMultiprocessorCount, dev) != hipSuccess) { grid = -1; return; }
        if (hipFuncSetAttribute((const void*)fwd_kernel, hipFuncAttributeMaxDynamicSharedMemorySize, LDS_BYTES) != hipSuccess) { fprintf(stderr, "kernel_launch: hipFuncSetAttribute failed\n"); grid = -1; return; }
        if (hipOccupancyMaxActiveBlocksPerMultiprocessor(&per_cu, (const void*)fwd_kernel, NWAVES * 64, LDS_BYTES) != hipSuccess || per_cu < 1) { fprintf(stderr, "kernel_launch: occupancy query says %d blocks per CU\n", per_cu); grid = -1; return; }
        grid = cus;
    }
    if (grid < 0) return;
    (void)hipMemsetAsync((char*)d_ws + WS_CTL, 0, CTL_BYTES, stream);
    Args a{};
    for (int i = 0; i < 19; ++i) a.in[i] = (const float*)d_in[i];
    a.out = (float*)d_out; a.ws = (unsigned char*)d_ws;
#if MK_MULTI
    for (int p = 0; p < N_PHASES; ++p) { a.ph_lo = p; a.ph_hi = p + 1; hipLaunchKernelGGL(fwd_kernel, dim3(grid), dim3(NWAVES * 64), LDS_BYTES, stream, a); }
#else
    a.ph_lo = 0; a.ph_hi = N_PHASES;
    void* kargs[] = {&a};
    hipError_t e = hipLaunchCooperativeKernel((const void*)fwd_kernel, dim3(grid), dim3(NWAVES * 64), kargs, LDS_BYTES, stream);
    if (e != hipSuccess) fprintf(stderr, "kernel_launch: cooperative launch failed: %s (grid %d)\n", hipGetErrorString(e), grid);
#endif
}
```

```cpp
#include <hip/hip_runtime.h>
#include <hip/hip_cooperative_groups.h>
#include <cstdio>
#include <cstdint>
namespace cg = cooperative_groups;

#ifndef PROBE
#define PROBE 0
#endif
#ifndef MK_MULTI
#define MK_MULTI 0
#endif

namespace pg8 {
#define PG8_LAS __attribute__((address_space(3)))
typedef unsigned short bf16_t;
typedef short bf16x8 __attribute__((ext_vector_type(8)));
typedef float f32x4 __attribute__((ext_vector_type(4)));
typedef unsigned u32x4 __attribute__((ext_vector_type(4)));
typedef unsigned u32x2 __attribute__((ext_vector_type(2)));
constexpr int BM = 256, BK = 64, HALF = 128, HTB = HALF * BK * 2, STAGE_BYTES = 8 * HTB, NXCD = 8, WGM = 8;

__host__ __device__ __forceinline__ int lds_byte(int r, int c) { const int st = (r >> 4) * 2 + (c >> 5), rr = r & 15, cc = c & 31, ob = rr * 64 + cc * 2; return st * 1024 + (ob ^ (((ob >> 9) & 1) << 5)); }
__host__ __device__ __forceinline__ void stage_rc(int b, int& R, int& C) { const int st = b / 1024, sb = b % 1024, swz = sb ^ (((sb >> 9) & 1) << 5); R = (st >> 1) * 16 + swz / 64; C = (st & 1) * 32 + (swz % 64) / 2; }
__host__ __device__ __forceinline__ int perm32(int rho) { const int n = rho >> 4, i = rho & 15; return 8 * (i >> 2) + 4 * n + (i & 3); }

struct Unit { int pm, pn, j; };
struct Gemm { const bf16_t* A; const bf16_t* Bt; int lda, K; size_t a_j1, a_j2, b_j;
    __device__ __forceinline__ size_t aoff(int j) const { return j == 0 ? (size_t)0 : (j == 1 ? a_j1 : a_j2); } };

struct StaticOrder {
    int nM, nN, nwg, G, c, NJ;
    __host__ __device__ void init(int M, int N, int G_, int c_, int NJ_ = 1) { nM = M / BM; nN = N / BM; nwg = nM * nN; G = G_; c = c_; NJ = NJ_; }
    __host__ __device__ bool next(int i, Unit& u) const {
        const int ti = i / NJ; u.j = i - ti * NJ;
        const long L = (long)ti * G + c; if (L >= nwg) return false;
        int wgid = (int)L; { const int q = nwg / NXCD, r = nwg % NXCD, xcd = wgid % NXCD, off = wgid / NXCD; wgid = (xcd < r ? xcd * (q + 1) : r * (q + 1) + (xcd - r) * q) + off; }
        const int nig = WGM * nN, gid = wgid / nig, fm = gid * WGM, gsz = (nM - fm) < WGM ? (nM - fm) : WGM;
        u.pm = fm + ((wgid % nig) % gsz); u.pn = (wgid % nig) / gsz; return true;
    }
};

__device__ __forceinline__ unsigned cvt_pk_bf16(float lo, float hi) { unsigned r; asm volatile("v_cvt_pk_bf16_f32 %0, %1, %2" : "=v"(r) : "v"(lo), "v"(hi)); return r; }

template <class Epi, class Sched>
__device__ __forceinline__ void gemm_phase(PG8_LAS unsigned char* lds, const Gemm g, const Sched& S, const Epi& E) {
    int tid_ = threadIdx.x; asm volatile("" : "+v"(tid_));
    const int tid = tid_, wid = __builtin_amdgcn_readfirstlane(tid >> 6), lane = tid & 63, wr = wid >> 2, wc = wid & 3, fr = lane & 15, fq = lane >> 4;
    const int K = g.K, nt = K / BK, lda = g.lda;
    unsigned voffA[2], voffB[2];
#pragma unroll
    for (int i = 0; i < 2; ++i) { int R, C; stage_rc(tid * 16 + i * 8192, R, C); const int Rb = Epi::PERM ? ((R & ~31) + perm32(R & 31)) : R;
        voffA[i] = (unsigned)(R * lda + C) * 2u; voffB[i] = (unsigned)(Rb * K + C) * 2u; }
    const size_t kstep = (size_t)(BK * 2);
    const size_t hstepA = (size_t)HALF * lda * 2, hstepB = (size_t)HALF * K * 2;
    const size_t tstepA = 2 * hstepA, tstepB = 2 * hstepB;
    const unsigned ldsw = (unsigned)wid * 1024u;
    const int aoff = lds_byte(wr * 64 + fr, fq * 8), boff = lds_byte(wc * 32 + fr, fq * 8);
#define PG8_SA(b, h) (((b) * 2 + (h)) * HTB)
#define PG8_SB(b, h) ((4 + (b) * 2 + (h)) * HTB)
#define PG8_STAGE(bufoff, gbase, voff) do { _Pragma("unroll") for (int _i = 0; _i < 2; ++_i) \
        __builtin_amdgcn_global_load_lds((const unsigned*)((const char*)(gbase) + (voff)[_i]), (PG8_LAS unsigned*)(lds + (bufoff) + ldsw + _i * 8192), 16, 0, 0); } while (0)
#define PG8_LDA(dst, b, h) do { _Pragma("unroll") for (int m = 0; m < 4; ++m) _Pragma("unroll") for (int k = 0; k < 2; ++k) dst[m][k] = *(const PG8_LAS bf16x8*)(lds + PG8_SA(b, h) + aoff + m * 2048 + k * 1024); } while (0)
#define PG8_LDB(dst, b, h) do { _Pragma("unroll") for (int n = 0; n < 2; ++n) _Pragma("unroll") for (int k = 0; k < 2; ++k) dst[n][k] = *(const PG8_LAS bf16x8*)(lds + PG8_SB(b, h) + boff + n * 2048 + k * 1024); } while (0)
#define PG8_MMA(ai, bj, At, Bt) do { __builtin_amdgcn_s_setprio(1); _Pragma("unroll") for (int m = 0; m < 4; ++m) _Pragma("unroll") for (int n = 0; n < 2; ++n) _Pragma("unroll") for (int k = 0; k < 2; ++k) \
        acc[ai][bj][m][n] = __builtin_amdgcn_mfma_f32_16x16x32_bf16(Bt[n][k], At[m][k], acc[ai][bj][m][n], 0, 0, 0); __builtin_amdgcn_s_setprio(0); } while (0)
#define PG8_WAIT_V(n) asm volatile("s_waitcnt vmcnt(" #n ")" ::: "memory")
#define PG8_WAIT_L(n) asm volatile("s_waitcnt lgkmcnt(" #n ")" ::: "memory")
#define PG8_BAR __builtin_amdgcn_s_barrier()
#define PG8_SCHED __builtin_amdgcn_sched_barrier(0)
    Unit cur, nxt; int ui = 0;
    if (!S.next(0, cur)) return;
    f32x4 acc[2][2][4][2];
#pragma unroll
    for (int a = 0; a < 2; ++a)
#pragma unroll
        for (int b = 0; b < 2; ++b)
#pragma unroll
            for (int m = 0; m < 4; ++m)
#pragma unroll
                for (int n = 0; n < 2; ++n) acc[a][b][m][n] = (f32x4){0.f, 0.f, 0.f, 0.f};
    bf16x8 At[4][2], B0[2][2], B1[2][2];
    const char* cA = (const char*)g.A + (size_t)cur.pm * tstepA + g.aoff(cur.j); const char* cB = (const char*)g.Bt + (size_t)cur.pn * tstepB + (size_t)cur.j * g.b_j;
    {
        PG8_STAGE(PG8_SB(0, 0), cB, voffB); PG8_STAGE(PG8_SB(0, 1), cB + hstepB, voffB); PG8_STAGE(PG8_SA(0, 0), cA, voffA); PG8_STAGE(PG8_SA(0, 1), cA + hstepA, voffA);
        if (wr == 1) PG8_BAR;
        PG8_WAIT_V(2); PG8_BAR;
        PG8_STAGE(PG8_SB(1, 0), cB + kstep, voffB); PG8_STAGE(PG8_SA(1, 0), cA + kstep, voffA); PG8_STAGE(PG8_SB(1, 1), cB + hstepB + kstep, voffB);
        PG8_WAIT_V(6); PG8_BAR;
    }
    for (;;) {
        const bool has_next = S.next(ui + 1, nxt);
        const char* nA = has_next ? (const char*)g.A + (size_t)nxt.pm * tstepA + g.aoff(nxt.j) : cA; const char* nB = has_next ? (const char*)g.Bt + (size_t)nxt.pn * tstepB + (size_t)nxt.j * g.b_j : cB;
        for (int t = 0; t < nt; t += 2) {
            const bool last = (t == nt - 2);
            const char* a1 = cA + (size_t)(t + 1) * kstep;
            const char* a2 = last ? nA : cA + (size_t)(t + 2) * kstep; const char* b2 = last ? nB : cB + (size_t)(t + 2) * kstep;
            const char* a3 = a2 + kstep; const char* b3 = b2 + kstep;
            PG8_LDB(B0, 0, 0); PG8_LDB(B1, 0, 1); PG8_SCHED; PG8_LDA(At, 0, 0); PG8_STAGE(PG8_SA(1, 1), a1 + hstepA, voffA);
            PG8_WAIT_V(8); PG8_WAIT_L(0); PG8_BAR; PG8_MMA(0, 0, At, B0); PG8_MMA(0, 1, At, B1); PG8_BAR; PG8_SCHED;
            PG8_LDA(At, 0, 1); PG8_STAGE(PG8_SB(0, 0), b2, voffB); PG8_STAGE(PG8_SB(0, 1), b2 + hstepB, voffB); PG8_STAGE(PG8_SA(0, 0), a2, voffA);
            PG8_WAIT_V(8); PG8_WAIT_L(0); PG8_BAR; PG8_MMA(1, 0, At, B0); PG8_MMA(1, 1, At, B1); PG8_BAR; PG8_SCHED;
            PG8_LDB(B0, 1, 0); PG8_LDB(B1, 1, 1); PG8_SCHED; PG8_LDA(At, 1, 0); PG8_STAGE(PG8_SA(0, 1), a2 + hstepA, voffA);
            PG8_WAIT_V(8); PG8_WAIT_L(0); PG8_BAR; PG8_MMA(0, 0, At, B0); PG8_MMA(0, 1, At, B1); PG8_BAR; PG8_SCHED;
            PG8_LDA(At, 1, 1); PG8_STAGE(PG8_SB(1, 0), b3, voffB); PG8_STAGE(PG8_SB(1, 1), b3 + hstepB, voffB); PG8_STAGE(PG8_SA(1, 0), a3, voffA);
            PG8_WAIT_V(8); PG8_WAIT_L(0); PG8_BAR; PG8_MMA(1, 0, At, B0); PG8_MMA(1, 1, At, B1); PG8_BAR; PG8_SCHED;
        }
        if (wr == 0) PG8_BAR;
        E(acc, cur, wr, wc, fr, fq);
        if (!has_next) break;
        if (!(Epi::ACCUM && nxt.j != 0)) {
#pragma unroll
        for (int a = 0; a < 2; ++a)
#pragma unroll
            for (int b = 0; b < 2; ++b)
#pragma unroll
                for (int m = 0; m < 4; ++m)
#pragma unroll
                    for (int n = 0; n < 2; ++n) acc[a][b][m][n] = (f32x4){0.f, 0.f, 0.f, 0.f};
        }
        cur = nxt; cA = nA; cB = nB; ++ui;
        if (wr == 1) PG8_BAR;
    }
    PG8_WAIT_V(0);
    PG8_BAR;
#undef PG8_SA
#undef PG8_SB
#undef PG8_STAGE
#undef PG8_LDA
#undef PG8_LDB
#undef PG8_MMA
#undef PG8_WAIT_V
#undef PG8_WAIT_L
#undef PG8_BAR
#undef PG8_SCHED
}
}

using pg8::bf16_t; using pg8::f32x4; using pg8::u32x4; using pg8::u32x2; using pg8::cvt_pk_bf16;
#define LAS __attribute__((address_space(3)))

constexpr int DM = 1024, NB = 4, SEQ = 4096, M = NB * SEQ, DEPTH = 2;
constexpr int NIN = 7168, NPM = 4096, NG = 3072, FF = 4096;
constexpr int C_AU = 0, C_AV = 512, C_Q = 1024, C_K = 1536, C_V = 2048, C_CB = 2560, C_CC = 3072, C_CX = 3584;
constexpr float EPS = 1e-6f;
constexpr float LOG2E = 1.4426950408889634f;

constexpr size_t MiB = 1u << 20;
constexpr size_t WS_CTL = 0, CTL_BYTES = 1 * MiB, WS_BAR = 512 * 1024;
constexpr size_t WS_WIN = 1 * MiB, WS_WBR = 15 * MiB, WS_WOUT = 18 * MiB;
constexpr size_t WS_WF1 = 20 * MiB, WS_WF2 = 28 * MiB;
constexpr size_t WS_XB = 36 * MiB;
constexpr size_t WS_PM = 68 * MiB;
constexpr size_t WS_G8 = 196 * MiB;
constexpr size_t WS_HB = 100 * MiB;
constexpr size_t WS_END = 244 * MiB;

constexpr int NWAVES = 8;
constexpr int RING_BYTES = 131072, LDS_BYTES = 139264;

struct Args { const float* in[19]; float* out; unsigned char* ws; int ph_lo, ph_hi; };

#define GAS __attribute__((address_space(1)))
#define XB_TMO      128
#define XB_XCNT(j)  (256  + 64 * (j))
#define XB_XSUB(j)  (1280 + 64 * (j))
#define XB_XGEN(j)  (2304 + 64 * (j))
#define XB_TOP      3328
#define XB_TOPGEN   3392
#define XCD_BAR_WORDS 3456
#define XB_SPIN_CAP (1u << 18)

__device__ __forceinline__ unsigned xb_ld(unsigned* p)              { return __hip_atomic_load(p, __ATOMIC_RELAXED, __HIP_MEMORY_SCOPE_AGENT); }
__device__ __forceinline__ unsigned xb_add(unsigned* p, unsigned v) { return __hip_atomic_fetch_add(p, v, __ATOMIC_RELAXED, __HIP_MEMORY_SCOPE_AGENT); }
__device__ __forceinline__ unsigned xb_xcc_id() { return (unsigned)__builtin_amdgcn_s_getreg((3 << 11) | 20) & 0xFu; }
#define XB_SPIN(cond, bar) do { unsigned _sp = 0; while (cond) { __builtin_amdgcn_s_sleep(1); \
    if ((++_sp & 255u) == 0u) { if (xb_ld(&(bar)[XB_TMO])) break; if (_sp > XB_SPIN_CAP) { atomicAdd(&(bar)[XB_TMO], 1u); break; } } } } while (0)

struct XcdBarrier {
    unsigned* bar; unsigned x;
    volatile LAS unsigned* st;
};

__device__ __forceinline__ XcdBarrier xcd_barrier_post(unsigned* bar, volatile LAS unsigned* st) {
    XcdBarrier b; b.bar = bar; b.x = xb_xcc_id(); b.st = st;
    if (threadIdx.x == 0) (void)xb_add(&bar[XB_XCNT(b.x)], 1u);
    return b;
}
__device__ __forceinline__ void xcd_barrier_complete(unsigned* bar, unsigned x, unsigned& nloc, unsigned& nx) {
    const unsigned G = gridDim.x * gridDim.y * gridDim.z;
    unsigned sum, cnt, mine, sp = 0u;
    for (;;) {
        sum = 0u; cnt = 0u; mine = 0u;
#pragma unroll
        for (unsigned j = 0; j < 16; ++j) { const unsigned c = xb_ld(&bar[XB_XCNT(j)]); sum += c; cnt += (c > 0u) ? 1u : 0u; mine = (j == x) ? c : mine; }
        if (sum == G) break;
        __builtin_amdgcn_s_sleep(1);
        if ((++sp & 255u) == 0u) { if (xb_ld(&bar[XB_TMO])) break; if (sp > XB_SPIN_CAP) { atomicAdd(&bar[XB_TMO], 1u); break; } }
    }
    nloc = mine > 0u ? mine : 1u; nx = cnt > 0u ? cnt : 1u;
}

__device__ __forceinline__ void xcd_barrier(const XcdBarrier& b) {
    asm volatile("s_waitcnt vmcnt(0)" ::: "memory");
    __syncthreads();
    if (threadIdx.x == 0) {
        unsigned* bar = b.bar;
        __builtin_amdgcn_s_waitcnt(0);
        unsigned nloc = b.st[0], nx = b.st[1];
        if (nloc == 0u) { xcd_barrier_complete(bar, b.x, nloc, nx); b.st[0] = nloc; b.st[1] = nx; }
        const unsigned old = xb_add(&bar[XB_XSUB(b.x)], 1u);
        const unsigned gen = old / nloc;
        if (old + 1u == (gen + 1u) * nloc) {
            __builtin_amdgcn_fence(__ATOMIC_RELEASE, "agent");
            asm volatile("s_waitcnt vmcnt(0)" ::: "memory");
            const unsigned og = xb_add(&bar[XB_TOP], 1u);
            const unsigned tg = og / nx;
            if (og + 1u == (tg + 1u) * nx) xb_add(&bar[XB_TOPGEN], 1u);
            else XB_SPIN(xb_ld(&bar[XB_TOPGEN]) == tg, bar);
            __builtin_amdgcn_fence(__ATOMIC_ACQUIRE, "agent");
            xb_add(&bar[XB_XGEN(b.x)], 1u);
            asm volatile("s_waitcnt vmcnt(0)" ::: "memory");
        } else {
            XB_SPIN(xb_ld(&bar[XB_XGEN(b.x)]) == gen, bar);
            __builtin_amdgcn_fence(__ATOMIC_ACQUIRE, "agent");
            asm volatile("s_waitcnt vmcnt(0)" ::: "memory");
        }
    }
    __syncthreads();
}

__device__ __forceinline__ float bf_lo(unsigned w) { return __uint_as_float(w << 16); }
__device__ __forceinline__ float bf_hi(unsigned w) { return __uint_as_float(w & 0xffff0000u); }
__device__ __forceinline__ float wave_sum(float v) {
#pragma unroll
    for (int o = 1; o < 64; o <<= 1) v += __shfl_xor(v, o);
    return v;
}
__device__ __forceinline__ float gelu_tanh(float x) {
    const float u = 0.7978845608028654f * (x + 0.044715f * x * x * x);
    return x * __builtin_amdgcn_rcpf(1.f + __builtin_amdgcn_exp2f(-2.f * LOG2E * u));
}
__device__ __forceinline__ float sigmoidf(float x) { return __builtin_amdgcn_rcpf(1.f + __builtin_amdgcn_exp2f(-LOG2E * x)); }
__device__ __forceinline__ float g8f(unsigned b) { return ((float)b + 0.5f) * (1.f / 256.f); }

__device__ __forceinline__ int inproj_phys(int n) {
    if (n < C_Q || n >= C_V) return n;
    const int t = n & ~255, g = (n & 255) >> 6, d = n & 63;
    return t + ((d >> 5) << 7) + (g << 5) + (d & 31);
}

struct EpiInProj {
    static constexpr bool PERM = true, ACCUM = false;
    bf16_t* PM; unsigned char* G8; const float* rowss; const float* gate_b; const float* qnw; const float* knw;
    __device__ __forceinline__ void operator()(f32x4 (&acc)[2][2][4][2], const pg8::Unit& u, int wr, int wc, int fr, int fq) const {
        const int row0 = u.pm * 256 + wr * 64 + fr;
        float rs[2][4];
#pragma unroll
        for (int ai = 0; ai < 2; ++ai)
#pragma unroll
            for (int m = 0; m < 4; ++m) rs[ai][m] = rsqrtf(rowss[row0 + ai * 128 + m * 16] * (1.f / DM) + EPS);
        const int pn = u.pn;
        if (pn < 4) {
            const int col0 = pn * 256 + wc * 32 + 8 * fq;
#pragma unroll
            for (int ai = 0; ai < 2; ++ai)
#pragma unroll
                for (int m = 0; m < 4; ++m) { bf16_t* rowp = PM + (size_t)(row0 + ai * 128 + m * 16) * NPM + col0; const float r = rs[ai][m];
#pragma unroll
                    for (int bj = 0; bj < 2; ++bj) { const f32x4 v0 = acc[ai][bj][m][0] * r, v1 = acc[ai][bj][m][1] * r; u32x4 w;
                        w.x = cvt_pk_bf16(gelu_tanh(v0[0]), gelu_tanh(v0[1])); w.y = cvt_pk_bf16(gelu_tanh(v0[2]), gelu_tanh(v0[3]));
                        w.z = cvt_pk_bf16(gelu_tanh(v1[0]), gelu_tanh(v1[1])); w.w = cvt_pk_bf16(gelu_tanh(v1[2]), gelu_tanh(v1[3]));
                        *(u32x4*)(rowp + bj * 128) = w; } }
        } else if (pn < 8) {
            const bool isq = pn < 6;
            const float* nw = (isq ? qnw : knw) + (wc & 1) * 64 + 8 * fq;
            const float extra = isq ? 0.125f * LOG2E : 1.f;
            float wv[2][8];
#pragma unroll
            for (int bj = 0; bj < 2; ++bj)
#pragma unroll
                for (int i = 0; i < 8; ++i) wv[bj][i] = nw[32 * bj + i] * extra;
            const int col0 = pn * 256 + 64 * wc + 8 * fq;
#pragma unroll
            for (int ai = 0; ai < 2; ++ai)
#pragma unroll
                for (int m = 0; m < 4; ++m) { bf16_t* rowp = PM + (size_t)(row0 + ai * 128 + m * 16) * NPM + col0; const float r = rs[ai][m];
                    f32x4 v[2][2]; float ss = 0.f;
#pragma unroll
                    for (int bj = 0; bj < 2; ++bj)
#pragma unroll
                        for (int n = 0; n < 2; ++n) { v[bj][n] = acc[ai][bj][m][n] * r; const f32x4 x = v[bj][n]; ss += (x[0] * x[0] + x[1] * x[1]) + (x[2] * x[2] + x[3] * x[3]); }
                    ss += __shfl_xor(ss, 16); ss += __shfl_xor(ss, 32);
                    const float rn = rsqrtf(ss * (1.f / 64.f) + EPS);
#pragma unroll
                    for (int bj = 0; bj < 2; ++bj) { const f32x4 v0 = v[bj][0] * rn, v1 = v[bj][1] * rn; u32x4 w;
                        w.x = cvt_pk_bf16(v0[0] * wv[bj][0], v0[1] * wv[bj][1]); w.y = cvt_pk_bf16(v0[2] * wv[bj][2], v0[3] * wv[bj][3]);
                        w.z = cvt_pk_bf16(v1[0] * wv[bj][4], v1[1] * wv[bj][5]); w.w = cvt_pk_bf16(v1[2] * wv[bj][6], v1[3] * wv[bj][7]);
                        *(u32x4*)(rowp + bj * 32) = w; } }
        } else if (pn < 16) {
            const int col0 = pn * 256 + wc * 32 + 8 * fq;
#pragma unroll
            for (int ai = 0; ai < 2; ++ai)
#pragma unroll
                for (int m = 0; m < 4; ++m) { bf16_t* rowp = PM + (size_t)(row0 + ai * 128 + m * 16) * NPM + col0; const float r = rs[ai][m];
#pragma unroll
                    for (int bj = 0; bj < 2; ++bj) { const f32x4 v0 = acc[ai][bj][m][0] * r, v1 = acc[ai][bj][m][1] * r; u32x4 w;
                        w.x = cvt_pk_bf16(v0[0], v0[1]); w.y = cvt_pk_bf16(v0[2], v0[3]); w.z = cvt_pk_bf16(v1[0], v1[1]); w.w = cvt_pk_bf16(v1[2], v1[3]);
                        *(u32x4*)(rowp + bj * 128) = w; } }
        } else {
            const int col0 = (pn - 16) * 256 + wc * 32 + 8 * fq;
            f32x4 bv[2][2];
#pragma unroll
            for (int bj = 0; bj < 2; ++bj)
#pragma unroll
                for (int n = 0; n < 2; ++n) bv[bj][n] = *(const f32x4*)(gate_b + col0 + bj * 128 + 4 * n);
#pragma unroll
            for (int ai = 0; ai < 2; ++ai)
#pragma unroll
                for (int m = 0; m < 4; ++m) { unsigned char* rowp = G8 + (size_t)(row0 + ai * 128 + m * 16) * NG + col0; const float r = rs[ai][m];
#pragma unroll
                    for (int bj = 0; bj < 2; ++bj) { unsigned q[8];
#pragma unroll
                        for (int n = 0; n < 2; ++n)
#pragma unroll
                            for (int e = 0; e < 4; ++e) { const float gx = sigmoidf(acc[ai][bj][m][n][e] * r + bv[bj][n][e]); q[4 * n + e] = (unsigned)__builtin_fminf(gx * 256.f, 255.f); }
                        u32x2 w; w.x = q[0] | (q[1] << 8) | (q[2] << 16) | (q[3] << 24); w.y = q[4] | (q[5] << 8) | (q[6] << 16) | (q[7] << 24);
                        *(u32x2*)(rowp + bj * 128) = w; } }
        }
    }
};

struct EpiBranch {
    static constexpr bool PERM = true, ACCUM = true;
    bf16_t* O; const unsigned char* G8;
    __device__ __forceinline__ void operator()(f32x4 (&acc)[2][2][4][2], const pg8::Unit& u, int wr, int wc, int fr, int fq) const {
        const int row0 = u.pm * 256 + wr * 64 + fr, col0 = u.pn * 256 + wc * 32 + 8 * fq, j = u.j;
#pragma unroll
        for (int ai = 0; ai < 2; ++ai)
#pragma unroll
            for (int m = 0; m < 4; ++m) { const size_t row = (size_t)(row0 + ai * 128 + m * 16);
#pragma unroll
                for (int bj = 0; bj < 2; ++bj) {
                    const u32x2 ga = *(const u32x2*)(G8 + row * NG + j * 1024 + col0 + bj * 128);
                    float f[8];
#pragma unroll
                    for (int e = 0; e < 4; ++e) { f[e] = g8f((ga.x >> (8 * e)) & 0xffu); f[4 + e] = g8f((ga.y >> (8 * e)) & 0xffu); }
                    if (j < 2) {
                        const u32x2 gb = *(const u32x2*)(G8 + row * NG + (j + 1) * 1024 + col0 + bj * 128);
#pragma unroll
                        for (int e = 0; e < 4; ++e) { f[e] *= __builtin_amdgcn_rcpf(g8f((gb.x >> (8 * e)) & 0xffu)); f[4 + e] *= __builtin_amdgcn_rcpf(g8f((gb.y >> (8 * e)) & 0xffu)); }
                    }
#pragma unroll
                    for (int e = 0; e < 4; ++e) { acc[ai][bj][m][0][e] *= f[e]; acc[ai][bj][m][1][e] *= f[4 + e]; }
                    if (j == 2) { const f32x4 v0 = acc[ai][bj][m][0], v1 = acc[ai][bj][m][1]; u32x4 w;
                        w.x = cvt_pk_bf16(v0[0], v0[1]); w.y = cvt_pk_bf16(v0[2], v0[3]); w.z = cvt_pk_bf16(v1[0], v1[1]); w.w = cvt_pk_bf16(v1[2], v1[3]);
                        *(u32x4*)(O + row * DM + col0 + bj * 128) = w; }
                } }
    }
};

struct EpiResid {
    static constexpr bool PERM = false, ACCUM = false;
    const float* xin; float* xout; bf16_t* xb; float* rowss;
    __device__ __forceinline__ void operator()(f32x4 (&acc)[2][2][4][2], const pg8::Unit& u, int wr, int wc, int fr, int fq) const {
        const int row0 = u.pm * 256 + wr * 64 + fr, col0 = u.pn * 256 + wc * 32 + 4 * fq;
#pragma unroll
        for (int ai = 0; ai < 2; ++ai)
#pragma unroll
            for (int m = 0; m < 4; ++m) { const int row = row0 + ai * 128 + m * 16; const size_t off = (size_t)row * DM + col0; float ss = 0.f;
#pragma unroll
                for (int bj = 0; bj < 2; ++bj)
#pragma unroll
                    for (int n = 0; n < 2; ++n) { const size_t o = off + bj * 128 + n * 16; const f32x4 x = *(const f32x4*)(xin + o) + acc[ai][bj][m][n];
                        *(f32x4*)(xout + o) = x;
                        if (xb) { u32x2 w; w.x = cvt_pk_bf16(x[0], x[1]); w.y = cvt_pk_bf16(x[2], x[3]); *(u32x2*)(xb + o) = w; ss += (x[0] * x[0] + x[1] * x[1]) + (x[2] * x[2] + x[3] * x[3]); } }
                if (xb) { ss += __shfl_xor(ss, 16); ss += __shfl_xor(ss, 32); if (fq == 0) atomicAdd(rowss + row, ss); } }
    }
};

struct EpiFF1 {
    static constexpr bool PERM = true, ACCUM = false;
    bf16_t* O; const float* rowss;
    __device__ __forceinline__ void operator()(f32x4 (&acc)[2][2][4][2], const pg8::Unit& u, int wr, int wc, int fr, int fq) const {
        const int row0 = u.pm * 256 + wr * 64 + fr, col0 = u.pn * 256 + wc * 32 + 8 * fq;
#pragma unroll
        for (int ai = 0; ai < 2; ++ai)
#pragma unroll
            for (int m = 0; m < 4; ++m) { const int row = row0 + ai * 128 + m * 16; const float r = rsqrtf(rowss[row] * (1.f / DM) + EPS); bf16_t* rowp = O + (size_t)row * FF + col0;
#pragma unroll
                for (int bj = 0; bj < 2; ++bj) { f32x4 v0 = acc[ai][bj][m][0] * r, v1 = acc[ai][bj][m][1] * r;
#pragma unroll
                    for (int e = 0; e < 4; ++e) { const float a = __builtin_fmaxf(v0[e], 0.f), b = __builtin_fmaxf(v1[e], 0.f); v0[e] = a * a; v1[e] = b * b; }
                    u32x4 w; w.x = cvt_pk_bf16(v0[0], v0[1]); w.y = cvt_pk_bf16(v0[2], v0[3]); w.z = cvt_pk_bf16(v1[0], v1[1]); w.w = cvt_pk_bf16(v1[2], v1[3]);
                    *(u32x4*)(rowp + bj * 128) = w; } }
    }
};

template <bool INPERM>
__device__ __forceinline__ void transpose_item(const float* W, const float* kscale, int K, int N, bf16_t* WT, LAS float* scr, int item, int lane) {
    const int nblk = N / 32, kb = item / nblk, nb = item % nblk, k0 = 64 * kb, n0 = 32 * nb;
#pragma unroll 8
    for (int i = 0; i < 32; ++i) { const int kk = 2 * i + (lane >> 5); float v = W[(size_t)(k0 + kk) * N + n0 + (lane & 31)]; if (kscale) v *= kscale[k0 + kk]; scr[kk * 33 + (lane & 31)] = v; }
    asm volatile("s_waitcnt lgkmcnt(0)" ::: "memory");
    const int c = lane & 7;
    const int r0 = INPERM ? inproj_phys(n0) : n0;
#pragma unroll
    for (int j = 0; j < 4; ++j) { const int n = (lane >> 3) + 8 * j; const LAS float* s = scr + (8 * c) * 33 + n;
        u32x4 o; o.x = cvt_pk_bf16(s[0 * 33], s[1 * 33]); o.y = cvt_pk_bf16(s[2 * 33], s[3 * 33]); o.z = cvt_pk_bf16(s[4 * 33], s[5 * 33]); o.w = cvt_pk_bf16(s[6 * 33], s[7 * 33]);
        *(u32x4*)(WT + (size_t)(r0 + n) * K + k0 + 8 * c) = o; }
    asm volatile("s_waitcnt lgkmcnt(0)" ::: "memory");
}
constexpr int IT_WIN = 16 * 224, IT_BR = 8 * 32, IT_OUT = 16 * 32, IT_F1 = 16 * 128, IT_F2 = 64 * 32;
__device__ __forceinline__ void convert_region_a(const Args& a, int l, LAS unsigned char* lds, int gw, int ngw, int wave, int lane) {
    LAS float* scr = (LAS float*)(lds + wave * 16384);
    unsigned char* ws = a.ws;
    constexpr int NIT = IT_WIN + 3 * IT_BR + IT_OUT;
    for (int it = gw; it < NIT; it += ngw) {
        int r = it;
        if (r < IT_WIN) { transpose_item<true>(a.in[2] + (size_t)l * DM * NIN, a.in[1] + l * DM, DM, NIN, (bf16_t*)(ws + WS_WIN), scr, r, lane); continue; } r -= IT_WIN;
        if (r < 3 * IT_BR) { const int j = r / IT_BR; transpose_item<false>(a.in[12 + j] + (size_t)l * 512 * DM, nullptr, 512, DM, (bf16_t*)(ws + WS_WBR + j * MiB), scr, r % IT_BR, lane); continue; } r -= 3 * IT_BR;
        transpose_item<false>(a.in[15] + (size_t)l * DM * DM, nullptr, DM, DM, (bf16_t*)(ws + WS_WOUT), scr, r, lane);
    }
}
__device__ __forceinline__ void convert_region_b(const Args& a, int l, LAS unsigned char* lds, int gw, int ngw, int wave, int lane) {
    LAS float* scr = (LAS float*)(lds + wave * 16384);
    unsigned char* ws = a.ws;
    constexpr int NIT = IT_F1 + IT_F2;
    for (int it = gw; it < NIT; it += ngw) {
        int r = it;
        if (r < IT_F1) { transpose_item<false>(a.in[17] + (size_t)l * DM * FF, a.in[16] + l * DM, DM, FF, (bf16_t*)(ws + WS_WF1), scr, r, lane); continue; } r -= IT_F1;
        transpose_item<false>(a.in[18] + (size_t)l * FF * DM, nullptr, FF, DM, (bf16_t*)(ws + WS_WF2), scr, r, lane);
    }
}

namespace att {
typedef short bf16x8 __attribute__((ext_vector_type(8)));
typedef short s16x4 __attribute__((ext_vector_type(4)));
typedef short v4i16_t __attribute__((ext_vector_type(4)));
typedef float f32x16 __attribute__((ext_vector_type(16)));
typedef float f32x2_t __attribute__((ext_vector_type(2))); typedef __bf16 bf16x2_t __attribute__((ext_vector_type(2)));
__device__ __forceinline__ unsigned cvtpk_s(float lo, float hi) { f32x2_t v = {lo, hi}; bf16x2_t b = __builtin_convertvector(v, bf16x2_t); return __builtin_bit_cast(unsigned, b); }
__device__ __forceinline__ s16x4 vtr(const LAS unsigned char* p) { return __builtin_bit_cast(s16x4, __builtin_amdgcn_ds_read_tr16_b64_v4i16((LAS v4i16_t*)p)); }
constexpr int KSTR = 144, VSTR = 320, KMAP = 64 * KSTR, V_OFF = 2 * KMAP, BUF = V_OFF + 64 * VSTR;
__device__ __forceinline__ bf16x8 pack8(const f32x16& p, int o) {
    u32x4 w; w.x = cvtpk_s(p[o], p[o + 1]); w.y = cvtpk_s(p[o + 2], p[o + 3]); w.z = cvtpk_s(p[o + 4], p[o + 5]); w.w = cvtpk_s(p[o + 6], p[o + 7]); return __builtin_bit_cast(bf16x8, w); }

__device__ __forceinline__ void attn_unit(bf16_t* PM, bf16_t* obase, int opitch, int b, int h, int qb, float lam, float post, const float* subw, LAS unsigned char* lds, int tid) {
    const int lane = tid & 63, wid = __builtin_amdgcn_readfirstlane(tid >> 6), r32 = lane & 31, hi = lane >> 5, m = wid >> 2, qs = wid & 3;
    const int qpos = 128 * qb + 32 * qs + r32;
    bf16_t* base = PM + (size_t)b * SEQ * NPM;
    bf16_t* qrow = base + (size_t)qpos * NPM + C_Q + h * 128;
    bf16_t* orow = obase + (size_t)(b * SEQ + qpos) * opitch + h * 128;
    bf16x8 qr[4];
#pragma unroll
    for (int d0 = 0; d0 < 4; ++d0) qr[d0] = *(const bf16x8*)(qrow + m * 64 + d0 * 16 + hi * 8);
    const int NT = 2 * (qb + 1), my_nt = (qs < 2) ? NT - 1 : NT;
    const float sl2 = __builtin_amdgcn_exp2f(-2.f * (float)(h + 1)) * LOG2E;
    const bf16_t* gk = base + (size_t)(tid >> 3) * NPM + C_K + h * 128 + (tid & 7) * 8;
    const bf16_t* gv = base + (size_t)(tid >> 4) * NPM + C_V + h * 128 + (tid & 15) * 8;
    const int lk = (tid >> 3) * KSTR + (tid & 7) * 16, lv = V_OFF + (tid >> 4) * VSTR + (tid & 15) * 16;
    u32x4 st0, st1, st2, st3;
#define ATT_LOAD(t) do { const size_t ro = (size_t)(t) * 64 * NPM; st0 = *(const u32x4*)(gk + ro); st1 = *(const u32x4*)(gk + ro + 64); st2 = *(const u32x4*)(gv + ro); st3 = *(const u32x4*)(gv + ro + (size_t)32 * NPM); } while (0)
#define ATT_STORE(bufp) do { *(LAS u32x4*)((bufp) + lk) = st0; *(LAS u32x4*)((bufp) + KMAP + lk) = st1; *(LAS u32x4*)((bufp) + lv) = st2; *(LAS u32x4*)((bufp) + lv + 32 * VSTR) = st3; } while (0)
    __syncthreads();
    ATT_LOAD(0); ATT_STORE(lds);
    __syncthreads();
    f32x16 OT[4];
#pragma unroll
    for (int eb = 0; eb < 4; ++eb)
#pragma unroll
        for (int r = 0; r < 16; ++r) OT[eb][r] = 0.f;
    float mrun = -1e30f, lsum = 0.f;
    for (int t = 0; t < NT; ++t) {
        LAS unsigned char* buf = lds + (t & 1) * BUF;
        if (t + 1 < NT) ATT_LOAD(t + 1);
        if (t < my_nt) {
            const LAS unsigned char* kp = buf + m * KMAP + r32 * KSTR + hi * 16;
            f32x16 p0, p1;
#pragma unroll
            for (int r = 0; r < 16; ++r) { p0[r] = 0.f; p1[r] = 0.f; }
#pragma unroll
            for (int d0 = 0; d0 < 4; ++d0) {
                const bf16x8 ka = *(const LAS bf16x8*)(kp + d0 * 32), kb2 = *(const LAS bf16x8*)(kp + 32 * KSTR + d0 * 32);
                p0 = __builtin_amdgcn_mfma_f32_32x32x16_bf16(ka, qr[d0], p0, 0, 0, 0);
                p1 = __builtin_amdgcn_mfma_f32_32x32x16_bf16(kb2, qr[d0], p1, 0, 0, 0);
            }
            const float dq = (float)(qpos - 64 * t - 4 * hi);
            float mt = -1e30f;
#pragma unroll
            for (int r = 0; r < 16; ++r) { const float c = (float)((r & 3) + 8 * (r >> 2));
                p0[r] = __builtin_fmaf(-sl2, __builtin_fabsf(dq - c), p0[r]); p1[r] = __builtin_fmaf(-sl2, __builtin_fabsf(dq - (c + 32.f)), p1[r]);
                mt = __builtin_fmaxf(mt, __builtin_fmaxf(p0[r], p1[r])); }
            mt = __builtin_fmaxf(mt, __shfl_xor(mt, 32));
            const float mnew = __builtin_fmaxf(mrun, mt);
            if (__any(mnew > mrun)) {
                const float alpha = __builtin_amdgcn_exp2f(mrun - mnew); lsum *= alpha;
#pragma unroll
                for (int eb = 0; eb < 4; ++eb)
#pragma unroll
                    for (int r = 0; r < 16; ++r) OT[eb][r] *= alpha;
                mrun = mnew;
            }
            float sacc = 0.f;
#pragma unroll
            for (int r = 0; r < 16; ++r) { p0[r] = __builtin_amdgcn_exp2f(p0[r] - mrun); p1[r] = __builtin_amdgcn_exp2f(p1[r] - mrun); sacc += p0[r] + p1[r]; }
            lsum += sacc;
            bf16x8 pf[4]; pf[0] = pack8(p0, 0); pf[1] = pack8(p0, 8); pf[2] = pack8(p1, 0); pf[3] = pack8(p1, 8);
            const LAS unsigned char* vp = buf + V_OFF + (4 * hi + ((lane & 15) >> 2)) * VSTR + ((lane >> 4) & 1) * 32 + (lane & 3) * 8;
#pragma unroll
            for (int s4 = 0; s4 < 4; ++s4)
#pragma unroll
                for (int eb = 0; eb < 4; ++eb) {
                    const s16x4 vlo = vtr(vp + (16 * s4) * VSTR + eb * 64), vhi = vtr(vp + (16 * s4 + 8) * VSTR + eb * 64);
                    const bf16x8 vf = (bf16x8){vlo[0], vlo[1], vlo[2], vlo[3], vhi[0], vhi[1], vhi[2], vhi[3]};
                    OT[eb] = __builtin_amdgcn_mfma_f32_32x32x16_bf16(vf, pf[s4], OT[eb], 0, 0, 0);
                }
        }
        if (t + 1 < NT) ATT_STORE(lds + ((t + 1) & 1) * BUF);
        __syncthreads();
    }
#undef ATT_LOAD
#undef ATT_STORE
    lsum += __shfl_xor(lsum, 32);
    const float inv = 1.f / lsum;
#pragma unroll
    for (int eb = 0; eb < 4; ++eb)
#pragma unroll
        for (int r = 0; r < 16; ++r) OT[eb][r] *= inv;
    LAS float* X = (LAS float*)(lds + qs * 16384) + lane;
    if (m == 1) {
#pragma unroll
        for (int eb = 0; eb < 4; ++eb)
#pragma unroll
            for (int r = 0; r < 16; ++r) X[(eb * 16 + r) * 64] = OT[eb][r];
    }
    __syncthreads();
    if (m == 0) {
        float ss = 0.f;
#pragma unroll
        for (int eb = 0; eb < 4; ++eb)
#pragma unroll
            for (int r = 0; r < 16; ++r) { const float o = OT[eb][r] - lam * X[(eb * 16 + r) * 64]; OT[eb][r] = o; ss += o * o; }
        ss += __shfl_xor(ss, 32);
        const float rn = rsqrtf(ss * (1.f / 128.f) + EPS) * post;
#pragma unroll
        for (int eb = 0; eb < 4; ++eb)
#pragma unroll
            for (int rg = 0; rg < 4; ++rg) { const int e = 32 * eb + 8 * rg + 4 * hi; const f32x4 w4 = *(const f32x4*)(subw + e);
                u32x2 w; w.x = cvtpk_s(OT[eb][4 * rg] * rn * w4[0], OT[eb][4 * rg + 1] * rn * w4[1]); w.y = cvtpk_s(OT[eb][4 * rg + 2] * rn * w4[2], OT[eb][4 * rg + 3] * rn * w4[3]);
                *(u32x2*)(orow + e) = w; }
    }
}
}

__device__ __forceinline__ void gmlp_unit(bf16_t* PM, bf16_t* obase, int opitch, const float* vnw, const float* ws_g, const float* bs_g, int rowbase, int g, LAS unsigned char* lds, int tid) {
    constexpr int VSTR = 320, WSTR = 272, W_OFF = 128 * VSTR;
    const int lane = tid & 63, wid = __builtin_amdgcn_readfirstlane(tid >> 6), r32 = lane & 31, hi = lane >> 5;
    __syncthreads();
    {
        const int row = tid >> 2, part = tid & 3;
        const bf16_t* rp = PM + (size_t)(rowbase + row) * NPM + C_AV;
        float ss = 0.f;
#pragma unroll
        for (int i = 0; i < 16; ++i) { const u32x4 w = *(const u32x4*)(rp + part * 128 + i * 8);
            const float a0 = bf_lo(w.x), a1 = bf_hi(w.x), a2 = bf_lo(w.y), a3 = bf_hi(w.y), a4 = bf_lo(w.z), a5 = bf_hi(w.z), a6 = bf_lo(w.w), a7 = bf_hi(w.w);
            ss += (a0 * a0 + a1 * a1) + (a2 * a2 + a3 * a3) + (a4 * a4 + a5 * a5) + (a6 * a6 + a7 * a7); }
        ss += __shfl_xor(ss, 1); ss += __shfl_xor(ss, 2);
        const float r = rsqrtf(ss * (1.f / 512.f) + EPS);
        const int c0 = part * 32;
#pragma unroll
        for (int i = 0; i < 4; ++i) { const u32x4 w = *(const u32x4*)(rp + g * 128 + c0 + i * 8); const float* nw = vnw + g * 128 + c0 + i * 8;
            const f32x4 n0 = *(const f32x4*)nw, n1 = *(const f32x4*)(nw + 4); u32x4 o;
            o.x = att::cvtpk_s(bf_lo(w.x) * r * n0[0], bf_hi(w.x) * r * n0[1]); o.y = att::cvtpk_s(bf_lo(w.y) * r * n0[2], bf_hi(w.y) * r * n0[3]);
            o.z = att::cvtpk_s(bf_lo(w.z) * r * n1[0], bf_hi(w.z) * r * n1[1]); o.w = att::cvtpk_s(bf_lo(w.w) * r * n1[2], bf_hi(w.w) * r * n1[3]);
            *(LAS u32x4*)(lds + row * VSTR + (c0 + i * 8) * 2) = o; }
#pragma unroll
        for (int i = 0; i < 4; ++i) { const int e8 = (i * 512 + tid) * 8, t = e8 >> 7, s0 = e8 & 127; f32x4 a = *(const f32x4*)(ws_g + e8), b = *(const f32x4*)(ws_g + e8 + 4);
#pragma unroll
            for (int e = 0; e < 4; ++e) { if (s0 + e > t) a[e] = 0.f; if (s0 + 4 + e > t) b[e] = 0.f; }
            u32x4 o; o.x = att::cvtpk_s(a[0], a[1]); o.y = att::cvtpk_s(a[2], a[3]); o.z = att::cvtpk_s(b[0], b[1]); o.w = att::cvtpk_s(b[2], b[3]);
            *(LAS u32x4*)(lds + W_OFF + t * WSTR + s0 * 2) = o; }
    }
    __syncthreads();
    const int cb = wid & 3;
    const LAS unsigned char* vp = lds + (8 * hi + ((lane & 15) >> 2)) * VSTR + (32 * cb + 16 * ((lane >> 4) & 1) + 4 * (lane & 3)) * 2;
#pragma unroll
    for (int pass = 0; pass < 2; ++pass) {
        const int tb = pass == 0 ? (wid >> 2) : 3 - (wid >> 2);
        att::f32x16 acc;
#pragma unroll
        for (int r = 0; r < 16; ++r) acc[r] = 0.f;
        const LAS unsigned char* wp = lds + W_OFF + (32 * tb + r32) * WSTR + hi * 16;
        const int nk = 2 * (tb + 1);
        for (int kk = 0; kk < nk; ++kk) {
            const att::s16x4 vlo = att::vtr(vp + (16 * kk) * VSTR), vhi = att::vtr(vp + (16 * kk + 4) * VSTR);
            const att::bf16x8 A = (att::bf16x8){vlo[0], vlo[1], vlo[2], vlo[3], vhi[0], vhi[1], vhi[2], vhi[3]};
            const att::bf16x8 B = *(const LAS att::bf16x8*)(wp + kk * 32);
            acc = __builtin_amdgcn_mfma_f32_32x32x16_bf16(A, B, acc, 0, 0, 0);
        }
        const int t = 32 * tb + r32; const float bsv = bs_g[t];
#pragma unroll
        for (int rg = 0; rg < 4; ++rg) { const int c = 32 * cb + 8 * rg + 4 * hi;
            const u32x2 uu = *(const u32x2*)(PM + (size_t)(rowbase + t) * NPM + C_AU + g * 128 + c);
            u32x2 o; o.x = att::cvtpk_s(bf_lo(uu.x) * (acc[4 * rg] + bsv), bf_hi(uu.x) * (acc[4 * rg + 1] + bsv)); o.y = att::cvtpk_s(bf_lo(uu.y) * (acc[4 * rg + 2] + bsv), bf_hi(uu.y) * (acc[4 * rg + 3] + bsv));
            *(u32x2*)(obase + (size_t)(rowbase + t) * opitch + g * 128 + c) = o; }
    }
}

__device__ __forceinline__ void conv_items(bf16_t* PM, const float* cw, int gtid, int gthreads) {
    for (int idx = gtid; idx < M * 64; idx += gthreads) {
        const int row = idx >> 6, c0 = (idx & 63) * 8, spos = row & (SEQ - 1);
        bf16_t* rp = PM + (size_t)row * NPM;
        float z[3][8];
#pragma unroll
        for (int j = 0; j < 3; ++j) { const int dt = 2 - j;
            if (spos >= dt) { const u32x4 a = *(const u32x4*)(rp - (size_t)dt * NPM + C_CC + c0), b = *(const u32x4*)(rp - (size_t)dt * NPM + C_CX + c0);
                z[j][0] = bf_lo(a.x) * bf_lo(b.x); z[j][1] = bf_hi(a.x) * bf_hi(b.x); z[j][2] = bf_lo(a.y) * bf_lo(b.y); z[j][3] = bf_hi(a.y) * bf_hi(b.y);
                z[j][4] = bf_lo(a.z) * bf_lo(b.z); z[j][5] = bf_hi(a.z) * bf_hi(b.z); z[j][6] = bf_lo(a.w) * bf_lo(b.w); z[j][7] = bf_hi(a.w) * bf_hi(b.w);
            } else {
#pragma unroll
                for (int e = 0; e < 8; ++e) z[j][e] = 0.f; } }
        const u32x4 cb = *(const u32x4*)(rp + C_CB + c0);
        float y[8];
#pragma unroll
        for (int e = 0; e < 8; ++e) y[e] = cw[c0 + e] * z[0][e] + cw[512 + c0 + e] * z[1][e] + cw[1024 + c0 + e] * z[2][e];
        u32x4 w; w.x = cvt_pk_bf16(bf_lo(cb.x) * y[0], bf_hi(cb.x) * y[1]); w.y = cvt_pk_bf16(bf_lo(cb.y) * y[2], bf_hi(cb.y) * y[3]);
        w.z = cvt_pk_bf16(bf_lo(cb.z) * y[4], bf_hi(cb.z) * y[5]); w.w = cvt_pk_bf16(bf_lo(cb.w) * y[6], bf_hi(cb.w) * y[7]);
        *(u32x4*)(rp + C_CB + c0) = w;
    }
}

constexpr int N_PHASES = 1 + 6 * DEPTH;
__global__ void __launch_bounds__(NWAVES * 64, 2) fwd_kernel(Args args) {
    extern __shared__ __attribute__((aligned(16))) unsigned char lds_raw[];
    LAS unsigned char* lds = (LAS unsigned char*)lds_raw;
    const int G = gridDim.x, bx = blockIdx.x, ngw = G * NWAVES, gthreads = G * NWAVES * 64;
#define TIDS() int tid_ = threadIdx.x; asm volatile("" : "+v"(tid_)); const int tid = tid_, lane = tid & 63, wave = __builtin_amdgcn_readfirstlane(tid >> 6), gw = bx * NWAVES + wave, gtid = bx * (NWAVES * 64) + tid; (void)lane; (void)gw; (void)gtid
    unsigned char* ws = args.ws;
    float* ROWSS = (float*)(ws + WS_CTL);
    bf16_t* XB = (bf16_t*)(ws + WS_XB); bf16_t* PM = (bf16_t*)(ws + WS_PM); bf16_t* XBM = (bf16_t*)(ws + WS_PM); bf16_t* HB = (bf16_t*)(ws + WS_HB);
    unsigned char* G8 = ws + WS_G8;
    const int lo = args.ph_lo, hi = args.ph_hi;
#if !MK_MULTI
    cg::grid_group grid = cg::this_grid();
    volatile LAS unsigned* bst = (volatile LAS unsigned*)(lds + RING_BYTES + 512);
    if (threadIdx.x < 2) bst[threadIdx.x] = 0u;
    __syncthreads();
    const XcdBarrier xbar = xcd_barrier_post((unsigned*)(ws + WS_BAR), bst);
#define SEAM(ph) do { if ((ph) + 1 < hi) { if ((ph) == 0) grid.sync(); else xcd_barrier(xbar); if (PROBE == 6) { xcd_barrier(xbar); xcd_barrier(xbar); } } } while (0)
#else
#define SEAM(ph) do { } while (0)
#endif
#define IN(k) (lo <= (k) && (k) < hi)

    if (IN(0)) {
        TIDS();
        for (int rep = 0; rep < (PROBE == 1 ? 2 : 1); ++rep) {
        convert_region_a(args, 0, lds, gw, ngw, wave, lane);
        convert_region_b(args, 0, lds, gw, ngw, wave, lane); }
        const float* x = args.in[0];
        for (int r = gw; r < M; r += ngw) {
            const f32x4* xr = (const f32x4*)(x + (size_t)r * DM) + lane; u32x2* o = (u32x2*)(XB + (size_t)r * DM) + lane; float s = 0.f;
#pragma unroll
            for (int j = 0; j < 4; ++j) { const f32x4 v = xr[64 * j]; s += (v[0] * v[0] + v[1] * v[1]) + (v[2] * v[2] + v[3] * v[3]); u32x2 w; w.x = cvt_pk_bf16(v[0], v[1]); w.y = cvt_pk_bf16(v[2], v[3]); o[64 * j] = w; }
            s = wave_sum(s); if (lane == 0) ROWSS[r] = s;
        }
        SEAM(0);
    }
    for (int l = 0; l < DEPTH; ++l) {
        const int pb = 1 + 6 * l;
        const float* xres_in = (l == 0) ? args.in[0] : args.out;
        if (IN(pb + 0)) {
            pg8::Gemm g{XB, (const bf16_t*)(ws + WS_WIN), DM, DM, 0, 0, 0}; pg8::StaticOrder S; S.init(M, NIN, G, bx);
            EpiInProj E{PM, G8, ROWSS + (size_t)(2 * l) * M, args.in[3] + l * NG, args.in[7] + l * 128, args.in[8] + l * 128};
            pg8::gemm_phase<EpiInProj, pg8::StaticOrder>(lds, g, S, E);
#if PROBE == 2
            pg8::gemm_phase<EpiInProj, pg8::StaticOrder>(lds, g, S, E);
#endif
            SEAM(pb + 0);
        }
        if (IN(pb + 1)) {
            TIDS();
            if (l == 1) convert_region_b(args, 1, lds, gw, ngw, wave, lane);
            const float* lp = args.in[9] + l * 256;
            const float sa = wave_sum(lp[lane] * lp[64 + lane]), sb = wave_sum(lp[128 + lane] * lp[192 + lane]);
            const float lam_init = 0.8f - 0.6f * expf(-0.3f * (float)l);
            const float lam = expf(sa) - expf(sb) + lam_init;
#if PROBE == 4
            for (int pi = bx; pi < 256; pi += G) { const int bh = pi >> 4, sq = pi & 15;
                att::attn_unit(PM, XB, DM, bh >> 2, bh & 3, 31 - sq, lam, 1.f - lam_init, args.in[10] + l * 128, lds, tid);
                att::attn_unit(PM, XB, DM, bh >> 2, bh & 3, sq, lam, 1.f - lam_init, args.in[10] + l * 128, lds, tid); }
#endif
            for (int pi = bx; pi < 256; pi += G) { const int bh = pi >> 4, sq = pi & 15;
                att::attn_unit(PM, PM + C_Q, NPM, bh >> 2, bh & 3, 31 - sq, lam, 1.f - lam_init, args.in[10] + l * 128, lds, tid);
                att::attn_unit(PM, PM + C_Q, NPM, bh >> 2, bh & 3, sq, lam, 1.f - lam_init, args.in[10] + l * 128, lds, tid); }
#if PROBE == 5
            for (int uu = bx; uu < 512; uu += G) { const int g4 = uu & 3, blk = uu >> 2;
                gmlp_unit(PM, XB, DM, args.in[4] + l * 512, args.in[5] + (size_t)(l * 4 + g4) * 16384, args.in[6] + (l * 4 + g4) * 128, blk * 128, g4, lds, tid); }
#endif
            for (int uu = bx; uu < 512; uu += G) { const int g4 = uu & 3, blk = uu >> 2;
                gmlp_unit(PM, PM + C_AU, NPM, args.in[4] + l * 512, args.in[5] + (size_t)(l * 4 + g4) * 16384, args.in[6] + (l * 4 + g4) * 128, blk * 128, g4, lds, tid); }
            conv_items(PM, args.in[11] + l * 1536, gtid, gthreads);
            SEAM(pb + 1);
        }
        if (IN(pb + 2)) {
            pg8::Gemm g{PM + C_AU, (const bf16_t*)(ws + WS_WBR), NPM, 512, (size_t)(C_Q - C_AU) * 2, (size_t)(C_CB - C_AU) * 2, MiB}; pg8::StaticOrder S; S.init(M, DM, G, bx, 3);
            EpiBranch E{XB, G8};
            pg8::gemm_phase<EpiBranch, pg8::StaticOrder>(lds, g, S, E);
#if PROBE == 7
            pg8::gemm_phase<EpiBranch, pg8::StaticOrder>(lds, g, S, E);
#endif
            SEAM(pb + 2);
        }
        if (IN(pb + 3)) {
            pg8::Gemm g{XB, (const bf16_t*)(ws + WS_WOUT), DM, DM, 0, 0, 0}; pg8::StaticOrder S; S.init(M, DM, G, bx);
            EpiResid E{xres_in, args.out, XBM, ROWSS + (size_t)(2 * l + 1) * M};
            pg8::gemm_phase<EpiResid, pg8::StaticOrder>(lds, g, S, E);
            SEAM(pb + 3);
        }
        if (IN(pb + 4)) {
            if (l == 0) { TIDS(); convert_region_a(args, 1, lds, gw, ngw, wave, lane); }
            __syncthreads();
            pg8::Gemm g{XBM, (const bf16_t*)(ws + WS_WF1), DM, DM, 0, 0, 0}; pg8::StaticOrder S; S.init(M, FF, G, bx);
            EpiFF1 E{HB, ROWSS + (size_t)(2 * l + 1) * M};
            pg8::gemm_phase<EpiFF1, pg8::StaticOrder>(lds, g, S, E);
#if PROBE == 3
            pg8::gemm_phase<EpiFF1, pg8::StaticOrder>(lds, g, S, E);
#endif
            SEAM(pb + 4);
        }
        if (IN(pb + 5)) {
            pg8::Gemm g{HB, (const bf16_t*)(ws + WS_WF2), FF, FF, 0, 0, 0}; pg8::StaticOrder S; S.init(M, DM, G, bx);
            EpiResid E{args.out, args.out, (l + 1 < DEPTH) ? XB : nullptr, ROWSS + (size_t)(2 * l + 2 < 4 ? 2 * l + 2 : 0) * M};
            pg8::gemm_phase<EpiResid, pg8::StaticOrder>(lds, g, S, E);
            SEAM(pb + 5);
        }
    }
#undef IN
#undef SEAM
}

extern "C" void kernel_launch(void* const* d_in, const int* in_sizes, int n_in, void* d_out, int out_size, void* d_ws, size_t ws_size, hipStream_t stream) {
    static int grid = 0;
    if (grid == 0) {
        if (n_in != 19 || in_sizes[0] != M * DM || out_size != M * DM || ws_size < WS_END) { fprintf(stderr, "kernel_launch: unexpected shapes / workspace (%d inputs, ws %zu)\n", n_in, ws_size); grid = -1; return; }
        int dev = 0, cus = 0, per_cu = 0;
        if (hipGetDevice(&dev) != hipSuccess || hipDeviceGetAttribute(&cus, hipDeviceAttributeMultiprocessorCount, dev) != hipSuccess) { grid = -1; return; }
        if (hipFuncSetAttribute((const void*)fwd_kernel, hipFuncAttributeMaxDynamicSharedMemorySize, LDS_BYTES) != hipSuccess) { fprintf(stderr, "kernel_launch: hipFuncSetAttribute failed\n"); grid = -1; return; }
        if (hipOccupancyMaxActiveBlocksPerMultiprocessor(&per_cu, (const void*)fwd_kernel, NWAVES * 64, LDS_BYTES) != hipSuccess || per_cu < 1) { fprintf(stderr, "kernel_launch: occupancy query says %d blocks per CU\n", per_cu); grid = -1; return; }
        grid = cus;
    }
    if (grid < 0) return;
    (void)hipMemsetAsync((char*)d_ws + WS_CTL, 0, CTL_BYTES, stream);
    Args a{};
    for (int i = 0; i < 19; ++i) a.in[i] = (const float*)d_in[i];
    a.out = (float*)d_out; a.ws = (unsigned char*)d_ws;
#if MK_MULTI
    for (int p = 0; p < N_PHASES; ++p) { a.ph_lo = p; a.ph_hi = p + 1; hipLaunchKernelGGL(fwd_kernel, dim3(grid), dim3(NWAVES * 64), LDS_BYTES, stream, a); }
#else
    a.ph_lo = 0; a.ph_hi = N_PHASES;
    void* kargs[] = {&a};
    hipError_t e = hipLaunchCooperativeKernel((const void*)fwd_kernel, dim3(grid), dim3(NWAVES * 64), kargs, LDS_BYTES, stream);
    if (e != hipSuccess) fprintf(stderr, "kernel_launch: cooperative launch failed: %s (grid %d)\n", hipGetErrorString(e), grid);
#endif
}
```

```cpp
#include <hip/hip_runtime.h>
#include <hip/hip_cooperative_groups.h>
#include <cstdio>
#include <cstdint>
namespace cg = cooperative_groups;

#ifndef PROBE
#define PROBE 0
#endif
#ifndef MK_MULTI
#define MK_MULTI 0
#endif

namespace pg8 {
#define PG8_LAS __attribute__((address_space(3)))
typedef unsigned short bf16_t;
typedef short bf16x8 __attribute__((ext_vector_type(8)));
typedef float f32x4 __attribute__((ext_vector_type(4)));
typedef unsigned u32x4 __attribute__((ext_vector_type(4)));
typedef unsigned u32x2 __attribute__((ext_vector_type(2)));
constexpr int BM = 256, BK = 64, HALF = 128, HTB = HALF * BK * 2, STAGE_BYTES = 8 * HTB, NXCD = 8, WGM = 8;

__host__ __device__ __forceinline__ int lds_byte(int r, int c) { const int st = (r >> 4) * 2 + (c >> 5), rr = r & 15, cc = c & 31, ob = rr * 64 + cc * 2; return st * 1024 + (ob ^ (((ob >> 9) & 1) << 5)); }
__host__ __device__ __forceinline__ void stage_rc(int b, int& R, int& C) { const int st = b / 1024, sb = b % 1024, swz = sb ^ (((sb >> 9) & 1) << 5); R = (st >> 1) * 16 + swz / 64; C = (st & 1) * 32 + (swz % 64) / 2; }
__host__ __device__ __forceinline__ int perm32(int rho) { const int n = rho >> 4, i = rho & 15; return 8 * (i >> 2) + 4 * n + (i & 3); }

struct Unit { int pm, pn, j; };
struct Gemm { const bf16_t* A; const bf16_t* Bt; int lda, K; size_t a_j1, a_j2, b_j;
    __device__ __forceinline__ size_t aoff(int j) const { return j == 0 ? (size_t)0 : (j == 1 ? a_j1 : a_j2); } };

struct StaticOrder {
    int nM, nN, nwg, G, c, NJ;
    __host__ __device__ void init(int M, int N, int G_, int c_, int NJ_ = 1) { nM = M / BM; nN = N / BM; nwg = nM * nN; G = G_; c = c_; NJ = NJ_; }
    __host__ __device__ bool next(int i, Unit& u) const {
        const int ti = i / NJ; u.j = i - ti * NJ;
        const long L = (long)ti * G + c; if (L >= nwg) return false;
        int wgid = (int)L; { const int q = nwg / NXCD, r = nwg % NXCD, xcd = wgid % NXCD, off = wgid / NXCD; wgid = (xcd < r ? xcd * (q + 1) : r * (q + 1) + (xcd - r) * q) + off; }
        const int nig = WGM * nN, gid = wgid / nig, fm = gid * WGM, gsz = (nM - fm) < WGM ? (nM - fm) : WGM;
        u.pm = fm + ((wgid % nig) % gsz); u.pn = (wgid % nig) / gsz; return true;
    }
};

__device__ __forceinline__ unsigned cvt_pk_bf16(float lo, float hi) { unsigned r; asm volatile("v_cvt_pk_bf16_f32 %0, %1, %2" : "=v"(r) : "v"(lo), "v"(hi)); return r; }

template <class Epi, class Sched>
__device__ __forceinline__ void gemm_phase(PG8_LAS unsigned char* lds, const Gemm g, const Sched& S, const Epi& E) {
    int tid_ = threadIdx.x; asm volatile("" : "+v"(tid_));
    const int tid = tid_, wid = __builtin_amdgcn_readfirstlane(tid >> 6), lane = tid & 63, wr = wid >> 2, wc = wid & 3, fr = lane & 15, fq = lane >> 4;
    const int K = g.K, nt = K / BK, lda = g.lda;
    unsigned voffA[2], voffB[2];
#pragma unroll
    for (int i = 0; i < 2; ++i) { int R, C; stage_rc(tid * 16 + i * 8192, R, C); const int Rb = Epi::PERM ? ((R & ~31) + perm32(R & 31)) : R;
        voffA[i] = (unsigned)(R * lda + C) * 2u; voffB[i] = (unsigned)(Rb * K + C) * 2u; }
    const size_t kstep = (size_t)(BK * 2);
    const size_t hstepA = (size_t)HALF * lda * 2, hstepB = (size_t)HALF * K * 2;
    const size_t tstepA = 2 * hstepA, tstepB = 2 * hstepB;
    const unsigned ldsw = (unsigned)wid * 1024u;
    const int aoff = lds_byte(wr * 64 + fr, fq * 8), boff = lds_byte(wc * 32 + fr, fq * 8);
#define PG8_SA(b, h) (((b) * 2 + (h)) * HTB)
#define PG8_SB(b, h) ((4 + (b) * 2 + (h)) * HTB)
#define PG8_STAGE(bufoff, gbase, voff) do { _Pragma("unroll") for (int _i = 0; _i < 2; ++_i) \
        __builtin_amdgcn_global_load_lds((const unsigned*)((const char*)(gbase) + (voff)[_i]), (PG8_LAS unsigned*)(lds + (bufoff) + ldsw + _i * 8192), 16, 0, 0); } while (0)
#define PG8_LDA(dst, b, h) do { _Pragma("unroll") for (int m = 0; m < 4; ++m) _Pragma("unroll") for (int k = 0; k < 2; ++k) dst[m][k] = *(const PG8_LAS bf16x8*)(lds + PG8_SA(b, h) + aoff + m * 2048 + k * 1024); } while (0)
#define PG8_LDB(dst, b, h) do { _Pragma("unroll") for (int n = 0; n < 2; ++n) _Pragma("unroll") for (int k = 0; k < 2; ++k) dst[n][k] = *(const PG8_LAS bf16x8*)(lds + PG8_SB(b, h) + boff + n * 2048 + k * 1024); } while (0)
#define PG8_MMA(ai, bj, At, Bt) do { __builtin_amdgcn_s_setprio(1); _Pragma("unroll") for (int m = 0; m < 4; ++m) _Pragma("unroll") for (int n = 0; n < 2; ++n) _Pragma("unroll") for (int k = 0; k < 2; ++k) \
        acc[ai][bj][m][n] = __builtin_amdgcn_mfma_f32_16x16x32_bf16(Bt[n][k], At[m][k], acc[ai][bj][m][n], 0, 0, 0); __builtin_amdgcn_s_setprio(0); } while (0)
#define PG8_WAIT_V(n) asm volatile("s_waitcnt vmcnt(" #n ")" ::: "memory")
#define PG8_WAIT_L(n) asm volatile("s_waitcnt lgkmcnt(" #n ")" ::: "memory")
#define PG8_BAR __builtin_amdgcn_s_barrier()
#define PG8_SCHED __builtin_amdgcn_sched_barrier(0)
    Unit cur, nxt; int ui = 0;
    if (!S.next(0, cur)) return;
    f32x4 acc[2][2][4][2];
#pragma unroll
    for (int a = 0; a < 2; ++a)
#pragma unroll
        for (int b = 0; b < 2; ++b)
#pragma unroll
            for (int m = 0; m < 4; ++m)
#pragma unroll
                for (int n = 0; n < 2; ++n) acc[a][b][m][n] = (f32x4){0.f, 0.f, 0.f, 0.f};
    bf16x8 At[4][2], B0[2][2], B1[2][2];
    const char* cA = (const char*)g.A + (size_t)cur.pm * tstepA + g.aoff(cur.j); const char* cB = (const char*)g.Bt + (size_t)cur.pn * tstepB + (size_t)cur.j * g.b_j;
    {
        PG8_STAGE(PG8_SB(0, 0), cB, voffB); PG8_STAGE(PG8_SB(0, 1), cB + hstepB, voffB); PG8_STAGE(PG8_SA(0, 0), cA, voffA); PG8_STAGE(PG8_SA(0, 1), cA + hstepA, voffA);
        if (wr == 1) PG8_BAR;
        PG8_WAIT_V(2); PG8_BAR;
        PG8_STAGE(PG8_SB(1, 0), cB + kstep, voffB); PG8_STAGE(PG8_SA(1, 0), cA + kstep, voffA); PG8_STAGE(PG8_SB(1, 1), cB + hstepB + kstep, voffB);
        PG8_WAIT_V(6); PG8_BAR;
    }
    for (;;) {
        const bool has_next = S.next(ui + 1, nxt);
        const char* nA = has_next ? (const char*)g.A + (size_t)nxt.pm * tstepA + g.aoff(nxt.j) : cA; const char* nB = has_next ? (const char*)g.Bt + (size_t)nxt.pn * tstepB + (size_t)nxt.j * g.b_j : cB;
        for (int t = 0; t < nt; t += 2) {
            const bool last = (t == nt - 2);
            const char* a1 = cA + (size_t)(t + 1) * kstep;
            const char* a2 = last ? nA : cA + (size_t)(t + 2) * kstep; const char* b2 = last ? nB : cB + (size_t)(t + 2) * kstep;
            const char* a3 = a2 + kstep; const char* b3 = b2 + kstep;
            PG8_LDB(B0, 0, 0); PG8_LDB(B1, 0, 1); PG8_SCHED; PG8_LDA(At, 0, 0); PG8_STAGE(PG8_SA(1, 1), a1 + hstepA, voffA);
            PG8_WAIT_V(8); PG8_WAIT_L(0); PG8_BAR; PG8_MMA(0, 0, At, B0); PG8_MMA(0, 1, At, B1); PG8_BAR; PG8_SCHED;
            PG8_LDA(At, 0, 1); PG8_STAGE(PG8_SB(0, 0), b2, voffB); PG8_STAGE(PG8_SB(0, 1), b2 + hstepB, voffB); PG8_STAGE(PG8_SA(0, 0), a2, voffA);
            PG8_WAIT_V(8); PG8_WAIT_L(0); PG8_BAR; PG8_MMA(1, 0, At, B0); PG8_MMA(1, 1, At, B1); PG8_BAR; PG8_SCHED;
            PG8_LDB(B0, 1, 0); PG8_LDB(B1, 1, 1); PG8_SCHED; PG8_LDA(At, 1, 0); PG8_STAGE(PG8_SA(0, 1), a2 + hstepA, voffA);
            PG8_WAIT_V(8); PG8_WAIT_L(0); PG8_BAR; PG8_MMA(0, 0, At, B0); PG8_MMA(0, 1, At, B1); PG8_BAR; PG8_SCHED;
            PG8_LDA(At, 1, 1); PG8_STAGE(PG8_SB(1, 0), b3, voffB); PG8_STAGE(PG8_SB(1, 1), b3 + hstepB, voffB); PG8_STAGE(PG8_SA(1, 0), a3, voffA);
            PG8_WAIT_V(8); PG8_WAIT_L(0); PG8_BAR; PG8_MMA(1, 0, At, B0); PG8_MMA(1, 1, At, B1); PG8_BAR; PG8_SCHED;
        }
        if (wr == 0) PG8_BAR;
        E(acc, cur, wr, wc, fr, fq);
        if (!has_next) break;
        if (!(Epi::ACCUM && nxt.j != 0)) {
#pragma unroll
        for (int a = 0; a < 2; ++a)
#pragma unroll
            for (int b = 0; b < 2; ++b)
#pragma unroll
                for (int m = 0; m < 4; ++m)
#pragma unroll
                    for (int n = 0; n < 2; ++n) acc[a][b][m][n] = (f32x4){0.f, 0.f, 0.f, 0.f};
        }
        cur = nxt; cA = nA; cB = nB; ++ui;
        if (wr == 1) PG8_BAR;
    }
    PG8_WAIT_V(0);
    PG8_BAR;
#undef PG8_SA
#undef PG8_SB
#undef PG8_STAGE
#undef PG8_LDA
#undef PG8_LDB
#undef PG8_MMA
#undef PG8_WAIT_V
#undef PG8_WAIT_L
#undef PG8_BAR
#undef PG8_SCHED
}
}

using pg8::bf16_t; using pg8::f32x4; using pg8::u32x4; using pg8::u32x2; using pg8::cvt_pk_bf16;
#define LAS __attribute__((address_space(3)))

constexpr int DM = 1024, NB = 4, SEQ = 4096, M = NB * SEQ, DEPTH = 2;
constexpr int NIN = 7168, NPM = 4096, NG = 3072, FF = 4096;
constexpr int C_AU = 0, C_AV = 512, C_Q = 1024, C_K = 1536, C_V = 2048, C_CB = 2560, C_CC = 3072, C_CX = 3584;
constexpr float EPS = 1e-6f;
constexpr float LOG2E = 1.4426950408889634f;

constexpr size_t MiB = 1u << 20;
constexpr size_t WS_CTL = 0, CTL_BYTES = 1 * MiB, WS_BAR = 512 * 1024;
constexpr size_t WS_WIN = 1 * MiB, WS_WBR = 15 * MiB, WS_WOUT = 18 * MiB;
constexpr size_t WS_WF1 = 20 * MiB, WS_WF2 = 28 * MiB;
constexpr size_t WS_XB = 36 * MiB;
constexpr size_t WS_PM = 68 * MiB;
constexpr size_t WS_G8 = 196 * MiB;
constexpr size_t WS_HB = 100 * MiB;
constexpr size_t WS_END = 244 * MiB;

constexpr int NWAVES = 8;
constexpr int RING_BYTES = 131072, LDS_BYTES = 139264;

struct Args { const float* in[19]; float* out; unsigned char* ws; int ph_lo, ph_hi; };

#define GAS __attribute__((address_space(1)))
#define XB_TMO      128
#define XB_XCNT(j)  (256  + 64 * (j))
#define XB_XSUB(j)  (1280 + 64 * (j))
#define XB_XGEN(j)  (2304 + 64 * (j))
#define XB_TOP      3328
#define XB_TOPGEN   3392
#define XCD_BAR_WORDS 3456
#define XB_SPIN_CAP (1u << 18)

__device__ __forceinline__ unsigned xb_ld(unsigned* p)              { return __hip_atomic_load(p, __ATOMIC_RELAXED, __HIP_MEMORY_SCOPE_AGENT); }
__device__ __forceinline__ unsigned xb_add(unsigned* p, unsigned v) { return __hip_atomic_fetch_add(p, v, __ATOMIC_RELAXED, __HIP_MEMORY_SCOPE_AGENT); }
__device__ __forceinline__ unsigned xb_xcc_id() { return (unsigned)__builtin_amdgcn_s_getreg((3 << 11) | 20) & 0xFu; }
#define XB_SPIN(cond, bar) do { unsigned _sp = 0; while (cond) { __builtin_amdgcn_s_sleep(1); \
    if ((++_sp & 255u) == 0u) { if (xb_ld(&(bar)[XB_TMO])) break; if (_sp > XB_SPIN_CAP) { atomicAdd(&(bar)[XB_TMO], 1u); break; } } } } while (0)

struct XcdBarrier {
    unsigned* bar; unsigned x;
    volatile LAS unsigned* st;
};

__device__ __forceinline__ XcdBarrier xcd_barrier_post(unsigned* bar, volatile LAS unsigned* st) {
    XcdBarrier b; b.bar = bar; b.x = xb_xcc_id(); b.st = st;
    if (threadIdx.x == 0) (void)xb_add(&bar[XB_XCNT(b.x)], 1u);
    return b;
}
__device__ __forceinline__ void xcd_barrier_complete(unsigned* bar, unsigned x, unsigned& nloc, unsigned& nx) {
    const unsigned G = gridDim.x * gridDim.y * gridDim.z;
    unsigned sum, cnt, mine, sp = 0u;
    for (;;) {
        sum = 0u; cnt = 0u; mine = 0u;
#pragma unroll
        for (unsigned j = 0; j < 16; ++j) { const unsigned c = xb_ld(&bar[XB_XCNT(j)]); sum += c; cnt += (c > 0u) ? 1u : 0u; mine = (j == x) ? c : mine; }
        if (sum == G) break;
        __builtin_amdgcn_s_sleep(1);
        if ((++sp & 255u) == 0u) { if (xb_ld(&bar[XB_TMO])) break; if (sp > XB_SPIN_CAP) { atomicAdd(&bar[XB_TMO], 1u); break; } }
    }
    nloc = mine > 0u ? mine : 1u; nx = cnt > 0u ? cnt : 1u;
}

__device__ __forceinline__ void xcd_barrier(const XcdBarrier& b) {
    asm volatile("s_waitcnt vmcnt(0)" ::: "memory");
    __syncthreads();
    if (threadIdx.x == 0) {
        unsigned* bar = b.bar;
        __builtin_amdgcn_s_waitcnt(0);
        unsigned nloc = b.st[0], nx = b.st[1];
        if (nloc == 0u) { xcd_barrier_complete(bar, b.x, nloc, nx); b.st[0] = nloc; b.st[1] = nx; }
        const unsigned old = xb_add(&bar[XB_XSUB(b.x)], 1u);
        const unsigned gen = old / nloc;
        if (old + 1u == (gen + 1u) * nloc) {
            __builtin_amdgcn_fence(__ATOMIC_RELEASE, "agent");
            asm volatile("s_waitcnt vmcnt(0)" ::: "memory");
            const unsigned og = xb_add(&bar[XB_TOP], 1u);
            const unsigned tg = og / nx;
            if (og + 1u == (tg + 1u) * nx) xb_add(&bar[XB_TOPGEN], 1u);
            else XB_SPIN(xb_ld(&bar[XB_TOPGEN]) == tg, bar);
            __builtin_amdgcn_fence(__ATOMIC_ACQUIRE, "agent");
            xb_add(&bar[XB_XGEN(b.x)], 1u);
            asm volatile("s_waitcnt vmcnt(0)" ::: "memory");
        } else {
            XB_SPIN(xb_ld(&bar[XB_XGEN(b.x)]) == gen, bar);
            __builtin_amdgcn_fence(__ATOMIC_ACQUIRE, "agent");
            asm volatile("s_waitcnt vmcnt(0)" ::: "memory");
        }
    }
    __syncthreads();
}

__device__ __forceinline__ float bf_lo(unsigned w) { return __uint_as_float(w << 16); }
__device__ __forceinline__ float bf_hi(unsigned w) { return __uint_as_float(w & 0xffff0000u); }
__device__ __forceinline__ float wave_sum(float v) {
#pragma unroll
    for (int o = 1; o < 64; o <<= 1) v += __shfl_xor(v, o);
    return v;
}
__device__ __forceinline__ float gelu_tanh(float x) {
    const float u = 0.7978845608028654f * (x + 0.044715f * x * x * x);
    return x * __builtin_amdgcn_rcpf(1.f + __builtin_amdgcn_exp2f(-2.f * LOG2E * u));
}
__device__ __forceinline__ float sigmoidf(float x) { return __builtin_amdgcn_rcpf(1.f + __builtin_amdgcn_exp2f(-LOG2E * x)); }
__device__ __forceinline__ float g8f(unsigned b) { return ((float)b + 0.5f) * (1.f / 256.f); }

__device__ __forceinline__ int inproj_phys(int n) {
    if (n < C_Q || n >= C_V) return n;
    const int t = n & ~255, g = (n & 255) >> 6, d = n & 63;
    return t + ((d >> 5) << 7) + (g << 5) + (d & 31);
}

struct EpiInProj {
    static constexpr bool PERM = true, ACCUM = false;
    bf16_t* PM; unsigned char* G8; const float* rowss; const float* gate_b; const float* qnw; const float* knw;
    __device__ __forceinline__ void operator()(f32x4 (&acc)[2][2][4][2], const pg8::Unit& u, int wr, int wc, int fr, int fq) const {
        const int row0 = u.pm * 256 + wr * 64 + fr;
        float rs[2][4];
#pragma unroll
        for (int ai = 0; ai < 2; ++ai)
#pragma unroll
            for (int m = 0; m < 4; ++m) rs[ai][m] = rsqrtf(rowss[row0 + ai * 128 + m * 16] * (1.f / DM) + EPS);
        const int pn = u.pn;
        if (pn < 4) {
            const int col0 = pn * 256 + wc * 32 + 8 * fq;
#pragma unroll
            for (int ai = 0; ai < 2; ++ai)
#pragma unroll
                for (int m = 0; m < 4; ++m) { bf16_t* rowp = PM + (size_t)(row0 + ai * 128 + m * 16) * NPM + col0; const float r = rs[ai][m];
#pragma unroll
                    for (int bj = 0; bj < 2; ++bj) { const f32x4 v0 = acc[ai][bj][m][0] * r, v1 = acc[ai][bj][m][1] * r; u32x4 w;
                        w.x = cvt_pk_bf16(gelu_tanh(v0[0]), gelu_tanh(v0[1])); w.y = cvt_pk_bf16(gelu_tanh(v0[2]), gelu_tanh(v0[3]));
                        w.z = cvt_pk_bf16(gelu_tanh(v1[0]), gelu_tanh(v1[1])); w.w = cvt_pk_bf16(gelu_tanh(v1[2]), gelu_tanh(v1[3]));
                        *(u32x4*)(rowp + bj * 128) = w; } }
        } else if (pn < 8) {
            const bool isq = pn < 6;
            const float* nw = (isq ? qnw : knw) + (wc & 1) * 64 + 8 * fq;
            const float extra = isq ? 0.125f * LOG2E : 1.f;
            float wv[2][8];
#pragma unroll
            for (int bj = 0; bj < 2; ++bj)
#pragma unroll
                for (int i = 0; i < 8; ++i) wv[bj][i] = nw[32 * bj + i] * extra;
            const int col0 = pn * 256 + 64 * wc + 8 * fq;
#pragma unroll
            for (int ai = 0; ai < 2; ++ai)
#pragma unroll
                for (int m = 0; m < 4; ++m) { bf16_t* rowp = PM + (size_t)(row0 + ai * 128 + m * 16) * NPM + col0; const float r = rs[ai][m];
                    f32x4 v[2][2]; float ss = 0.f;
#pragma unroll
                    for (int bj = 0; bj < 2; ++bj)
#pragma unroll
                        for (int n = 0; n < 2; ++n) { v[bj][n] = acc[ai][bj][m][n] * r; const f32x4 x = v[bj][n]; ss += (x[0] * x[0] + x[1] * x[1]) + (x[2] * x[2] + x[3] * x[3]); }
                    ss += __shfl_xor(ss, 16); ss += __shfl_xor(ss, 32);
                    const float rn = rsqrtf(ss * (1.f / 64.f) + EPS);
#pragma unroll
                    for (int bj = 0; bj < 2; ++bj) { const f32x4 v0 = v[bj][0] * rn, v1 = v[bj][1] * rn; u32x4 w;
                        w.x = cvt_pk_bf16(v0[0] * wv[bj][0], v0[1] * wv[bj][1]); w.y = cvt_pk_bf16(v0[2] * wv[bj][2], v0[3] * wv[bj][3]);
                        w.z = cvt_pk_bf16(v1[0] * wv[bj][4], v1[1] * wv[bj][5]); w.w = cvt_pk_bf16(v1[2] * wv[bj][6], v1[3] * wv[bj][7]);
                        *(u32x4*)(rowp + bj * 32) = w; } }
        } else if (pn < 16) {
            const int col0 = pn * 256 + wc * 32 + 8 * fq;
#pragma unroll
            for (int ai = 0; ai < 2; ++ai)
#pragma unroll
                for (int m = 0; m < 4; ++m) { bf16_t* rowp = PM + (size_t)(row0 + ai * 128 + m * 16) * NPM + col0; const float r = rs[ai][m];
#pragma unroll
                    for (int bj = 0; bj < 2; ++bj) { const f32x4 v0 = acc[ai][bj][m][0] * r, v1 = acc[ai][bj][m][1] * r; u32x4 w;
                        w.x = cvt_pk_bf16(v0[0], v0[1]); w.y = cvt_pk_bf16(v0[2], v0[3]); w.z = cvt_pk_bf16(v1[0], v1[1]); w.w = cvt_pk_bf16(v1[2], v1[3]);
                        *(u32x4*)(rowp + bj * 128) = w; } }
        } else {
            const int col0 = (pn - 16) * 256 + wc * 32 + 8 * fq;
            f32x4 bv[2][2];
#pragma unroll
            for (int bj = 0; bj < 2; ++bj)
#pragma unroll
                for (int n = 0; n < 2; ++n) bv[bj][n] = *(const f32x4*)(gate_b + col0 + bj * 128 + 4 * n);
#pragma unroll
            for (int ai = 0; ai < 2; ++ai)
#pragma unroll
                for (int m = 0; m < 4; ++m) { unsigned char* rowp = G8 + (size_t)(row0 + ai * 128 + m * 16) * NG + col0; const float r = rs[ai][m];
#pragma unroll
                    for (int bj = 0; bj < 2; ++bj) { unsigned q[8];
#pragma unroll
                        for (int n = 0; n < 2; ++n)
#pragma unroll
                            for (int e = 0; e < 4; ++e) { const float gx = sigmoidf(acc[ai][bj][m][n][e] * r + bv[bj][n][e]); q[4 * n + e] = (unsigned)__builtin_fminf(gx * 256.f, 255.f); }
                        u32x2 w; w.x = q[0] | (q[1] << 8) | (q[2] << 16) | (q[3] << 24); w.y = q[4] | (q[5] << 8) | (q[6] << 16) | (q[7] << 24);
                        *(u32x2*)(rowp + bj * 128) = w; } }
        }
    }
};

struct EpiBranch {
    static constexpr bool PERM = true, ACCUM = true;
    bf16_t* O; const unsigned char* G8;
    __device__ __forceinline__ void operator()(f32x4 (&acc)[2][2][4][2], const pg8::Unit& u, int wr, int wc, int fr, int fq) const {
        const int row0 = u.pm * 256 + wr * 64 + fr, col0 = u.pn * 256 + wc * 32 + 8 * fq, j = u.j;
#pragma unroll
        for (int ai = 0; ai < 2; ++ai)
#pragma unroll
            for (int m = 0; m < 4; ++m) { const size_t row = (size_t)(row0 + ai * 128 + m * 16);
#pragma unroll
                for (int bj = 0; bj < 2; ++bj) {
                    const u32x2 ga = *(const u32x2*)(G8 + row * NG + j * 1024 + col0 + bj * 128);
                    float f[8];
#pragma unroll
                    for (int e = 0; e < 4; ++e) { f[e] = g8f((ga.x >> (8 * e)) & 0xffu); f[4 + e] = g8f((ga.y >> (8 * e)) & 0xffu); }
                    if (j < 2) {
                        const u32x2 gb = *(const u32x2*)(G8 + row * NG + (j + 1) * 1024 + col0 + bj * 128);
#pragma unroll
                        for (int e = 0; e < 4; ++e) { f[e] *= __builtin_amdgcn_rcpf(g8f((gb.x >> (8 * e)) & 0xffu)); f[4 + e] *= __builtin_amdgcn_rcpf(g8f((gb.y >> (8 * e)) & 0xffu)); }
                    }
#pragma unroll
                    for (int e = 0; e < 4; ++e) { acc[ai][bj][m][0][e] *= f[e]; acc[ai][bj][m][1][e] *= f[4 + e]; }
                    if (j == 2) { const f32x4 v0 = acc[ai][bj][m][0], v1 = acc[ai][bj][m][1]; u32x4 w;
                        w.x = cvt_pk_bf16(v0[0], v0[1]); w.y = cvt_pk_bf16(v0[2], v0[3]); w.z = cvt_pk_bf16(v1[0], v1[1]); w.w = cvt_pk_bf16(v1[2], v1[3]);
                        *(u32x4*)(O + row * DM + col0 + bj * 128) = w; }
                } }
    }
};

struct EpiResid {
    static constexpr bool PERM = false, ACCUM = false;
    const float* xin; float* xout; bf16_t* xb; float* rowss;
    __device__ __forceinline__ void operator()(f32x4 (&acc)[2][2][4][2], const pg8::Unit& u, int wr, int wc, int fr, int fq) const {
        const int row0 = u.pm * 256 + wr * 64 + fr, col0 = u.pn * 256 + wc * 32 + 4 * fq;
#pragma unroll
        for (int ai = 0; ai < 2; ++ai)
#pragma unroll
            for (int m = 0; m < 4; ++m) { const int row = row0 + ai * 128 + m * 16; const size_t off = (size_t)row * DM + col0; float ss = 0.f;
#pragma unroll
                for (int bj = 0; bj < 2; ++bj)
#pragma unroll
                    for (int n = 0; n < 2; ++n) { const size_t o = off + bj * 128 + n * 16; const f32x4 x = *(const f32x4*)(xin + o) + acc[ai][bj][m][n];
                        *(f32x4*)(xout + o) = x;
                        if (xb) { u32x2 w; w.x = cvt_pk_bf16(x[0], x[1]); w.y = cvt_pk_bf16(x[2], x[3]); *(u32x2*)(xb + o) = w; ss += (x[0] * x[0] + x[1] * x[1]) + (x[2] * x[2] + x[3] * x[3]); } }
                if (xb) { ss += __shfl_xor(ss, 16); ss += __shfl_xor(ss, 32); if (fq == 0) atomicAdd(rowss + row, ss); } }
    }
};

struct EpiFF1 {
    static constexpr bool PERM = true, ACCUM = false;
    bf16_t* O; const float* rowss;
    __device__ __forceinline__ void operator()(f32x4 (&acc)[2][2][4][2], const pg8::Unit& u, int wr, int wc, int fr, int fq) const {
        const int row0 = u.pm * 256 + wr * 64 + fr, col0 = u.pn * 256 + wc * 32 + 8 * fq;
#pragma unroll
        for (int ai = 0; ai < 2; ++ai)
#pragma unroll
            for (int m = 0; m < 4; ++m) { const int row = row0 + ai * 128 + m * 16; const float r = rsqrtf(rowss[row] * (1.f / DM) + EPS); bf16_t* rowp = O + (size_t)row * FF + col0;
#pragma unroll
                for (int bj = 0; bj < 2; ++bj) { f32x4 v0 = acc[ai][bj][m][0] * r, v1 = acc[ai][bj][m][1] * r;
#pragma unroll
                    for (int e = 0; e < 4; ++e) { const float a = __builtin_fmaxf(v0[e], 0.f), b = __builtin_fmaxf(v1[e], 0.f); v0[e] = a * a; v1[e] = b * b; }
                    u32x4 w; w.x = cvt_pk_bf16(v0[0], v0[1]); w.y = cvt_pk_bf16(v0[2], v0[3]); w.z = cvt_pk_bf16(v1[0], v1[1]); w.w = cvt_pk_bf16(v1[2], v1[3]);
                    *(u32x4*)(rowp + bj * 128) = w; } }
    }
};

template <bool INPERM>
__device__ __forceinline__ void transpose_item(const float* W, const float* kscale, int K, int N, bf16_t* WT, LAS float* scr, int item, int lane) {
    const int nblk = N / 32, kb = item / nblk, nb = item % nblk, k0 = 64 * kb, n0 = 32 * nb;
    float v[32];
#pragma unroll
    for (int i = 0; i < 32; ++i) { const int kk = 2 * i + (lane >> 5); v[i] = W[(size_t)(k0 + kk) * N + n0 + (lane & 31)]; }
    if (kscale) {
#pragma unroll
        for (int i = 0; i < 32; ++i) v[i] *= kscale[k0 + 2 * i + (lane >> 5)]; }
#pragma unroll
    for (int i = 0; i < 32; ++i) { const int kk = 2 * i + (lane >> 5); scr[kk * 33 + (lane & 31)] = v[i]; }
    asm volatile("s_waitcnt lgkmcnt(0)" ::: "memory");
    const int c = lane & 7;
    const int r0 = INPERM ? inproj_phys(n0) : n0;
#pragma unroll
    for (int j = 0; j < 4; ++j) { const int n = (lane >> 3) + 8 * j; const LAS float* s = scr + (8 * c) * 33 + n;
        u32x4 o; o.x = cvt_pk_bf16(s[0 * 33], s[1 * 33]); o.y = cvt_pk_bf16(s[2 * 33], s[3 * 33]); o.z = cvt_pk_bf16(s[4 * 33], s[5 * 33]); o.w = cvt_pk_bf16(s[6 * 33], s[7 * 33]);
        *(u32x4*)(WT + (size_t)(r0 + n) * K + k0 + 8 * c) = o; }
    asm volatile("s_waitcnt lgkmcnt(0)" ::: "memory");
}
constexpr int IT_WIN = 16 * 224, IT_BR = 8 * 32, IT_OUT = 16 * 32, IT_F1 = 16 * 128, IT_F2 = 64 * 32;
__device__ __forceinline__ void convert_region_a(const Args& a, int l, LAS unsigned char* lds, int gw, int ngw, int wave, int lane) {
    LAS float* scr = (LAS float*)(lds + wave * 16384);
    unsigned char* ws = a.ws;
    constexpr int NIT = IT_WIN + 3 * IT_BR + IT_OUT;
    for (int it = gw; it < NIT; it += ngw) {
        int r = it;
        if (r < IT_WIN) { transpose_item<true>(a.in[2] + (size_t)l * DM * NIN, a.in[1] + l * DM, DM, NIN, (bf16_t*)(ws + WS_WIN), scr, r, lane); continue; } r -= IT_WIN;
        if (r < 3 * IT_BR) { const int j = r / IT_BR; transpose_item<false>(a.in[12 + j] + (size_t)l * 512 * DM, nullptr, 512, DM, (bf16_t*)(ws + WS_WBR + j * MiB), scr, r % IT_BR, lane); continue; } r -= 3 * IT_BR;
        transpose_item<false>(a.in[15] + (size_t)l * DM * DM, nullptr, DM, DM, (bf16_t*)(ws + WS_WOUT), scr, r, lane);
    }
}
__device__ __forceinline__ void convert_region_b(const Args& a, int l, LAS unsigned char* lds, int gw, int ngw, int wave, int lane) {
    LAS float* scr = (LAS float*)(lds + wave * 16384);
    unsigned char* ws = a.ws;
    constexpr int NIT = IT_F1 + IT_F2;
    for (int it = gw; it < NIT; it += ngw) {
        int r = it;
        if (r < IT_F1) { transpose_item<false>(a.in[17] + (size_t)l * DM * FF, a.in[16] + l * DM, DM, FF, (bf16_t*)(ws + WS_WF1), scr, r, lane); continue; } r -= IT_F1;
        transpose_item<false>(a.in[18] + (size_t)l * FF * DM, nullptr, FF, DM, (bf16_t*)(ws + WS_WF2), scr, r, lane);
    }
}

namespace att {
typedef short bf16x8 __attribute__((ext_vector_type(8)));
typedef short s16x4 __attribute__((ext_vector_type(4)));
typedef short v4i16_t __attribute__((ext_vector_type(4)));
typedef float f32x16 __attribute__((ext_vector_type(16)));
typedef float f32x2_t __attribute__((ext_vector_type(2))); typedef __bf16 bf16x2_t __attribute__((ext_vector_type(2)));
__device__ __forceinline__ unsigned cvtpk_s(float lo, float hi) { f32x2_t v = {lo, hi}; bf16x2_t b = __builtin_convertvector(v, bf16x2_t); return __builtin_bit_cast(unsigned, b); }
__device__ __forceinline__ s16x4 vtr(const LAS unsigned char* p) { return __builtin_bit_cast(s16x4, __builtin_amdgcn_ds_read_tr16_b64_v4i16((LAS v4i16_t*)p)); }
constexpr int KSTR = 144, VSTR = 320, KMAP = 64 * KSTR, V_OFF = 2 * KMAP, BUF = V_OFF + 64 * VSTR;
__device__ __forceinline__ bf16x8 pack8(const f32x16& p, int o) {
    u32x4 w; w.x = cvtpk_s(p[o], p[o + 1]); w.y = cvtpk_s(p[o + 2], p[o + 3]); w.z = cvtpk_s(p[o + 4], p[o + 5]); w.w = cvtpk_s(p[o + 6], p[o + 7]); return __builtin_bit_cast(bf16x8, w); }

__device__ __forceinline__ void attn_unit(bf16_t* PM, bf16_t* obase, int opitch, int b, int h, int qb, float lam, float post, const float* subw, LAS unsigned char* lds, int tid_in) {
    int tid = tid_in; asm volatile("" : "+v"(tid));
    const int lane = tid & 63, wid = __builtin_amdgcn_readfirstlane(tid >> 6), r32 = lane & 31, hi = lane >> 5, m = wid >> 2, qs = wid & 3;
    const int qpos = 128 * qb + 32 * qs + r32;
    bf16_t* base = PM + (size_t)b * SEQ * NPM;
    bf16_t* qrow = base + (size_t)qpos * NPM + C_Q + h * 128;
    bf16_t* orow = obase + (size_t)(b * SEQ + qpos) * opitch + h * 128;
    bf16x8 qr[4];
#pragma unroll
    for (int d0 = 0; d0 < 4; ++d0) qr[d0] = *(const bf16x8*)(qrow + m * 64 + d0 * 16 + hi * 8);
    const int NT = 2 * (qb + 1), my_nt = (qs < 2) ? NT - 1 : NT;
    const float sl2 = __builtin_amdgcn_exp2f(-2.f * (float)(h + 1)) * LOG2E;
    const bf16_t* gk = base + (size_t)(tid >> 3) * NPM + C_K + h * 128 + (tid & 7) * 8;
    const bf16_t* gv = base + (size_t)(tid >> 4) * NPM + C_V + h * 128 + (tid & 15) * 8;
    const int lk = (tid >> 3) * KSTR + (tid & 7) * 16, lv = V_OFF + (tid >> 4) * VSTR + (tid & 15) * 16;
    u32x4 st0, st1, st2, st3;
#define ATT_LOAD(t) do { const size_t ro = (size_t)(t) * 64 * NPM; st0 = *(const u32x4*)(gk + ro); st1 = *(const u32x4*)(gk + ro + 64); st2 = *(const u32x4*)(gv + ro); st3 = *(const u32x4*)(gv + ro + (size_t)32 * NPM); } while (0)
#define ATT_STORE(bufp) do { *(LAS u32x4*)((bufp) + lk) = st0; *(LAS u32x4*)((bufp) + KMAP + lk) = st1; *(LAS u32x4*)((bufp) + lv) = st2; *(LAS u32x4*)((bufp) + lv + 32 * VSTR) = st3; } while (0)
    __syncthreads();
    ATT_LOAD(0); ATT_STORE(lds);
    __syncthreads();
    f32x16 OT[4];
#pragma unroll
    for (int eb = 0; eb < 4; ++eb)
#pragma unroll
        for (int r = 0; r < 16; ++r) OT[eb][r] = 0.f;
    float mref = 0.f, lsum = 0.f;
    const float s64 = 64.f * sl2;
    const float s32 = 32.f * sl2;
    f32x16 ci0;
#pragma unroll
    for (int r = 0; r < 16; ++r) ci0[r] = sl2 * (float)(4 * hi + (r & 3) + 8 * (r >> 2));
    for (int t = 0; t < NT; ++t) {
        LAS unsigned char* buf = lds + (t & 1) * BUF;
        if (t + 1 < NT) ATT_LOAD(t + 1);
        if (t < my_nt) {
            const LAS unsigned char* kp = buf + m * KMAP + r32 * KSTR + hi * 16;
            f32x16 p0 = ci0, p1 = ci0 + s32;
            if (t == my_nt - 1) {
                int hid = hi; asm volatile("" : "+v"(hid));
                const float qf = (float)qpos, k0 = (float)(64 * t + 4 * hid), cadd = sl2 * qf - mref;
#pragma unroll
                for (int r = 0; r < 16; ++r) { const float kf = k0 + (float)((r & 3) + 8 * (r >> 2));
                    p0[r] = __builtin_fmaf(-sl2, __builtin_fabsf(qf - kf), cadd); p1[r] = __builtin_fmaf(-sl2, __builtin_fabsf(qf - (kf + 32.f)), cadd); }
            }
            bf16x8 ka[4], kb2[4];
#pragma unroll
            for (int d0 = 0; d0 < 4; ++d0) { ka[d0] = *(const LAS bf16x8*)(kp + d0 * 32); kb2[d0] = *(const LAS bf16x8*)(kp + 32 * KSTR + d0 * 32); }
#pragma unroll
            for (int d0 = 0; d0 < 4; ++d0) {
                p0 = __builtin_amdgcn_mfma_f32_32x32x16_bf16(ka[d0], qr[d0], p0, 0, 0, 0);
                p1 = __builtin_amdgcn_mfma_f32_32x32x16_bf16(kb2[d0], qr[d0], p1, 0, 0, 0);
            }
            const LAS unsigned char* vp = buf + V_OFF + (4 * hi + ((lane & 15) >> 2)) * VSTR + ((lane >> 4) & 1) * 32 + (lane & 3) * 8;
            s16x4 vlo[2][4], vhi[2][4];
#pragma unroll
            for (int eb = 0; eb < 4; ++eb) { vlo[0][eb] = vtr(vp + eb * 64); vhi[0][eb] = vtr(vp + 8 * VSTR + eb * 64); }
            float mt = __builtin_fmaxf(p0[0], p1[0]);
#pragma unroll
            for (int r = 1; r < 16; ++r) mt = __builtin_fmaxf(__builtin_fmaxf(mt, p0[r]), p1[r]);
            mt = __builtin_fmaxf(mt, __shfl_xor(mt, 32));
            if (__any(mt > 8.f)) {
                const float dl = __builtin_fmaxf(mt, 0.f), f = __builtin_amdgcn_exp2f(-dl);
                mref += dl; lsum *= f; p0 -= dl; p1 -= dl; ci0 -= dl;
#pragma unroll
                for (int eb = 0; eb < 4; ++eb) OT[eb] *= f;
            }
            float sacc = 0.f;
#pragma unroll
            for (int r = 0; r < 16; ++r) { p0[r] = __builtin_amdgcn_exp2f(p0[r]); p1[r] = __builtin_amdgcn_exp2f(p1[r]); sacc += p0[r] + p1[r]; }
            lsum += sacc;
            ci0 += s64;
            bf16x8 pf[4]; pf[0] = pack8(p0, 0); pf[1] = pack8(p0, 8); pf[2] = pack8(p1, 0); pf[3] = pack8(p1, 8);
#pragma unroll
            for (int s4 = 0; s4 < 4; ++s4) {
                if (s4 < 3) {
#pragma unroll
                    for (int eb = 0; eb < 4; ++eb) { vlo[(s4 + 1) & 1][eb] = vtr(vp + (16 * (s4 + 1)) * VSTR + eb * 64); vhi[(s4 + 1) & 1][eb] = vtr(vp + (16 * (s4 + 1) + 8) * VSTR + eb * 64); }
                }
#pragma unroll
                for (int eb = 0; eb < 4; ++eb) {
                    const s16x4 a = vlo[s4 & 1][eb], c = vhi[s4 & 1][eb];
                    const bf16x8 vf = (bf16x8){a[0], a[1], a[2], a[3], c[0], c[1], c[2], c[3]};
                    OT[eb] = __builtin_amdgcn_mfma_f32_32x32x16_bf16(vf, pf[s4], OT[eb], 0, 0, 0);
                }
            }
        }
        if (t + 1 < NT) ATT_STORE(lds + ((t + 1) & 1) * BUF);
        __syncthreads();
    }
#undef ATT_LOAD
#undef ATT_STORE
    lsum += __shfl_xor(lsum, 32);
    const float inv = 1.f / lsum;
#pragma unroll
    for (int eb = 0; eb < 4; ++eb)
#pragma unroll
        for (int r = 0; r < 16; ++r) OT[eb][r] *= inv;
    int hif = hi, lanef = lane; asm volatile("" : "+v"(hif), "+v"(lanef));
    LAS float* X = (LAS float*)(lds + qs * 16384) + lanef;
    if (m == 1) {
#pragma unroll
        for (int eb = 0; eb < 4; ++eb)
#pragma unroll
            for (int r = 0; r < 16; ++r) X[(eb * 16 + r) * 64] = OT[eb][r];
    }
    __syncthreads();
    if (m == 0) {
        float ss = 0.f;
#pragma unroll
        for (int eb = 0; eb < 4; ++eb) {
            __builtin_amdgcn_sched_barrier(0);
#pragma unroll
            for (int r = 0; r < 16; ++r) { const float o = OT[eb][r] - lam * X[(eb * 16 + r) * 64]; OT[eb][r] = o; ss += o * o; } }
        __builtin_amdgcn_sched_barrier(0);
        ss += __shfl_xor(ss, 32);
        const float rn = rsqrtf(ss * (1.f / 128.f) + EPS) * post;
#pragma unroll
        for (int eb = 0; eb < 4; ++eb)
#pragma unroll
            for (int rg = 0; rg < 4; ++rg) { const int e = 32 * eb + 8 * rg + 4 * hif; const f32x4 w4 = *(const f32x4*)(subw + e);
                u32x2 w; w.x = cvtpk_s(OT[eb][4 * rg] * rn * w4[0], OT[eb][4 * rg + 1] * rn * w4[1]); w.y = cvtpk_s(OT[eb][4 * rg + 2] * rn * w4[2], OT[eb][4 * rg + 3] * rn * w4[3]);
                *(u32x2*)(orow + e) = w; }
    }
}
}

__device__ __forceinline__ void gmlp_unit(bf16_t* PM, bf16_t* obase, int opitch, const float* vnw, const float* ws_g, const float* bs_g, int rowbase, int g, LAS unsigned char* lds, int tid) {
    constexpr int VSTR = 320, WSTR = 272, W_OFF = 128 * VSTR;
    const int lane = tid & 63, wid = __builtin_amdgcn_readfirstlane(tid >> 6), r32 = lane & 31, hi = lane >> 5;
    __syncthreads();
    {
        const int row = tid >> 2, part = tid & 3;
        const bf16_t* rp = PM + (size_t)(rowbase + row) * NPM + C_AV;
        float ss = 0.f;
#pragma unroll
        for (int i = 0; i < 16; ++i) { const u32x4 w = *(const u32x4*)(rp + part * 128 + i * 8);
            const float a0 = bf_lo(w.x), a1 = bf_hi(w.x), a2 = bf_lo(w.y), a3 = bf_hi(w.y), a4 = bf_lo(w.z), a5 = bf_hi(w.z), a6 = bf_lo(w.w), a7 = bf_hi(w.w);
            ss += (a0 * a0 + a1 * a1) + (a2 * a2 + a3 * a3) + (a4 * a4 + a5 * a5) + (a6 * a6 + a7 * a7); }
        ss += __shfl_xor(ss, 1); ss += __shfl_xor(ss, 2);
        const float r = rsqrtf(ss * (1.f / 512.f) + EPS);
        const int c0 = part * 32;
#pragma unroll
        for (int i = 0; i < 4; ++i) { const u32x4 w = *(const u32x4*)(rp + g * 128 + c0 + i * 8); const float* nw = vnw + g * 128 + c0 + i * 8;
            const f32x4 n0 = *(const f32x4*)nw, n1 = *(const f32x4*)(nw + 4); u32x4 o;
            o.x = att::cvtpk_s(bf_lo(w.x) * r * n0[0], bf_hi(w.x) * r * n0[1]); o.y = att::cvtpk_s(bf_lo(w.y) * r * n0[2], bf_hi(w.y) * r * n0[3]);
            o.z = att::cvtpk_s(bf_lo(w.z) * r * n1[0], bf_hi(w.z) * r * n1[1]); o.w = att::cvtpk_s(bf_lo(w.w) * r * n1[2], bf_hi(w.w) * r * n1[3]);
            *(LAS u32x4*)(lds + row * VSTR + (c0 + i * 8) * 2) = o; }
#pragma unroll
        for (int i = 0; i < 4; ++i) { const int e8 = (i * 512 + tid) * 8, t = e8 >> 7, s0 = e8 & 127; f32x4 a = *(const f32x4*)(ws_g + e8), b = *(const f32x4*)(ws_g + e8 + 4);
#pragma unroll
            for (int e = 0; e < 4; ++e) { if (s0 + e > t) a[e] = 0.f; if (s0 + 4 + e > t) b[e] = 0.f; }
            u32x4 o; o.x = att::cvtpk_s(a[0], a[1]); o.y = att::cvtpk_s(a[2], a[3]); o.z = att::cvtpk_s(b[0], b[1]); o.w = att::cvtpk_s(b[2], b[3]);
            *(LAS u32x4*)(lds + W_OFF + t * WSTR + s0 * 2) = o; }
    }
    __syncthreads();
    const int cb = wid & 3;
    const LAS unsigned char* vp = lds + (8 * hi + ((lane & 15) >> 2)) * VSTR + (32 * cb + 16 * ((lane >> 4) & 1) + 4 * (lane & 3)) * 2;
#pragma unroll
    for (int pass = 0; pass < 2; ++pass) {
        const int tb = pass == 0 ? (wid >> 2) : 3 - (wid >> 2);
        att::f32x16 acc;
#pragma unroll
        for (int r = 0; r < 16; ++r) acc[r] = 0.f;
        const LAS unsigned char* wp = lds + W_OFF + (32 * tb + r32) * WSTR + hi * 16;
        const int nk = 2 * (tb + 1);
        for (int kk = 0; kk < nk; ++kk) {
            const att::s16x4 vlo = att::vtr(vp + (16 * kk) * VSTR), vhi = att::vtr(vp + (16 * kk + 4) * VSTR);
            const att::bf16x8 A = (att::bf16x8){vlo[0], vlo[1], vlo[2], vlo[3], vhi[0], vhi[1], vhi[2], vhi[3]};
            const att::bf16x8 B = *(const LAS att::bf16x8*)(wp + kk * 32);
            acc = __builtin_amdgcn_mfma_f32_32x32x16_bf16(A, B, acc, 0, 0, 0);
        }
        const int t = 32 * tb + r32; const float bsv = bs_g[t];
#pragma unroll
        for (int rg = 0; rg < 4; ++rg) { const int c = 32 * cb + 8 * rg + 4 * hi;
            const u32x2 uu = *(const u32x2*)(PM + (size_t)(rowbase + t) * NPM + C_AU + g * 128 + c);
            u32x2 o; o.x = att::cvtpk_s(bf_lo(uu.x) * (acc[4 * rg] + bsv), bf_hi(uu.x) * (acc[4 * rg + 1] + bsv)); o.y = att::cvtpk_s(bf_lo(uu.y) * (acc[4 * rg + 2] + bsv), bf_hi(uu.y) * (acc[4 * rg + 3] + bsv));
            *(u32x2*)(obase + (size_t)(rowbase + t) * opitch + g * 128 + c) = o; }
    }
}

__device__ __forceinline__ void conv_items(bf16_t* PM, bf16_t* obase, int opitch, const float* cw, int gtid, int gthreads) {
    for (int idx = gtid; idx < M * 64; idx += gthreads) {
        const int row = idx >> 6, c0 = (idx & 63) * 8, spos = row & (SEQ - 1);
        bf16_t* rp = PM + (size_t)row * NPM;
        float z[3][8];
#pragma unroll
        for (int j = 0; j < 3; ++j) { const int dt = 2 - j;
            if (spos >= dt) { const u32x4 a = *(const u32x4*)(rp - (size_t)dt * NPM + C_CC + c0), b = *(const u32x4*)(rp - (size_t)dt * NPM + C_CX + c0);
                z[j][0] = bf_lo(a.x) * bf_lo(b.x); z[j][1] = bf_hi(a.x) * bf_hi(b.x); z[j][2] = bf_lo(a.y) * bf_lo(b.y); z[j][3] = bf_hi(a.y) * bf_hi(b.y);
                z[j][4] = bf_lo(a.z) * bf_lo(b.z); z[j][5] = bf_hi(a.z) * bf_hi(b.z); z[j][6] = bf_lo(a.w) * bf_lo(b.w); z[j][7] = bf_hi(a.w) * bf_hi(b.w);
            } else {
#pragma unroll
                for (int e = 0; e < 8; ++e) z[j][e] = 0.f; } }
        const u32x4 cb = *(const u32x4*)(rp + C_CB + c0);
        float y[8];
#pragma unroll
        for (int e = 0; e < 8; ++e) y[e] = cw[c0 + e] * z[0][e] + cw[512 + c0 + e] * z[1][e] + cw[1024 + c0 + e] * z[2][e];
        u32x4 w; w.x = cvt_pk_bf16(bf_lo(cb.x) * y[0], bf_hi(cb.x) * y[1]); w.y = cvt_pk_bf16(bf_lo(cb.y) * y[2], bf_hi(cb.y) * y[3]);
        w.z = cvt_pk_bf16(bf_lo(cb.z) * y[4], bf_hi(cb.z) * y[5]); w.w = cvt_pk_bf16(bf_lo(cb.w) * y[6], bf_hi(cb.w) * y[7]);
        *(u32x4*)(obase + (size_t)row * opitch + c0) = w;
    }
}

constexpr int N_PHASES = 1 + 6 * DEPTH;
__global__ void __launch_bounds__(NWAVES * 64, 2) fwd_kernel(Args args) {
    extern __shared__ __attribute__((aligned(16))) unsigned char lds_raw[];
    LAS unsigned char* lds = (LAS unsigned char*)lds_raw;
    const int G = gridDim.x, bx = blockIdx.x, ngw = G * NWAVES, gthreads = G * NWAVES * 64;
#define TIDS() int tid_ = threadIdx.x; asm volatile("" : "+v"(tid_)); const int tid = tid_, lane = tid & 63, wave = __builtin_amdgcn_readfirstlane(tid >> 6), gw = bx * NWAVES + wave, gtid = bx * (NWAVES * 64) + tid; (void)lane; (void)gw; (void)gtid
    unsigned char* ws = args.ws;
    float* ROWSS = (float*)(ws + WS_CTL);
    bf16_t* XB = (bf16_t*)(ws + WS_XB); bf16_t* PM = (bf16_t*)(ws + WS_PM); bf16_t* XBM = (bf16_t*)(ws + WS_PM); bf16_t* HB = (bf16_t*)(ws + WS_HB);
    unsigned char* G8 = ws + WS_G8;
    const int lo = args.ph_lo, hi = args.ph_hi;
#if !MK_MULTI
    cg::grid_group grid = cg::this_grid();
    volatile LAS unsigned* bst = (volatile LAS unsigned*)(lds + RING_BYTES + 512);
    if (threadIdx.x < 2) bst[threadIdx.x] = 0u;
    __syncthreads();
    const XcdBarrier xbar = xcd_barrier_post((unsigned*)(ws + WS_BAR), bst);
#define SEAM(ph) do { if ((ph) + 1 < hi) { if (hi > 1000) grid.sync();   xcd_barrier(xbar); if (PROBE == 6) { xcd_barrier(xbar); xcd_barrier(xbar); } } } while (0)
#else
#define SEAM(ph) do { } while (0)
#endif
#define IN(k) (lo <= (k) && (k) < hi)

    if (IN(0)) {
        TIDS();
        for (int rep = 0; rep < (PROBE == 1 ? 2 : 1); ++rep) {
        convert_region_a(args, 0, lds, gw, ngw, wave, lane);
        convert_region_b(args, 0, lds, gw, ngw, wave, lane); }
        const float* x = args.in[0];
        for (int r = gw; r < M; r += ngw) {
            const f32x4* xr = (const f32x4*)(x + (size_t)r * DM) + lane; u32x2* o = (u32x2*)(XB + (size_t)r * DM) + lane; float s = 0.f;
#pragma unroll
            for (int j = 0; j < 4; ++j) { const f32x4 v = xr[64 * j]; s += (v[0] * v[0] + v[1] * v[1]) + (v[2] * v[2] + v[3] * v[3]); u32x2 w; w.x = cvt_pk_bf16(v[0], v[1]); w.y = cvt_pk_bf16(v[2], v[3]); o[64 * j] = w; }
            s = wave_sum(s); if (lane == 0) ROWSS[r] = s;
        }
        SEAM(0);
    }
    for (int l = 0; l < DEPTH; ++l) {
        const int pb = 1 + 6 * l;
        const float* xres_in = (l == 0) ? args.in[0] : args.out;
        if (IN(pb + 0)) {
            pg8::Gemm g{XB, (const bf16_t*)(ws + WS_WIN), DM, DM, 0, 0, 0}; pg8::StaticOrder S; S.init(M, NIN, G, bx);
            EpiInProj E{PM, G8, ROWSS + (size_t)(2 * l) * M, args.in[3] + l * NG, args.in[7] + l * 128, args.in[8] + l * 128};
            pg8::gemm_phase<EpiInProj, pg8::StaticOrder>(lds, g, S, E);
#if PROBE == 2
            pg8::gemm_phase<EpiInProj, pg8::StaticOrder>(lds, g, S, E);
#endif
            SEAM(pb + 0);
        }
        if (IN(pb + 1)) {
            TIDS();
            if (l == 1) convert_region_b(args, 1, lds, gw, ngw, wave, lane);
            const float* lp = args.in[9] + l * 256;
            const float sa = wave_sum(lp[lane] * lp[64 + lane]), sb = wave_sum(lp[128 + lane] * lp[192 + lane]);
            const float lam_init = 0.8f - 0.6f * expf(-0.3f * (float)l);
            const float lam = expf(sa) - expf(sb) + lam_init;
#if PROBE == 4
            for (int pi = bx; pi < 256; pi += G) { const int bh = pi >> 4, sq = pi & 15;
                att::attn_unit(PM, XB, DM, bh >> 2, bh & 3, 31 - sq, lam, 1.f - lam_init, args.in[10] + l * 128, lds, tid);
                att::attn_unit(PM, XB, DM, bh >> 2, bh & 3, sq, lam, 1.f - lam_init, args.in[10] + l * 128, lds, tid); }
#endif
            for (int pi = bx; pi < 256; pi += G) { const int bh = pi >> 4, sq = pi & 15;
                att::attn_unit(PM, PM + C_Q, NPM, bh >> 2, bh & 3, 31 - sq, lam, 1.f - lam_init, args.in[10] + l * 128, lds, tid);
                att::attn_unit(PM, PM + C_Q, NPM, bh >> 2, bh & 3, sq, lam, 1.f - lam_init, args.in[10] + l * 128, lds, tid); }
#if PROBE == 5
            for (int uu = bx; uu < 512; uu += G) { const int g4 = uu & 3, blk = uu >> 2;
                gmlp_unit(PM, XB, DM, args.in[4] + l * 512, args.in[5] + (size_t)(l * 4 + g4) * 16384, args.in[6] + (l * 4 + g4) * 128, blk * 128, g4, lds, tid); }
#endif
            for (int uu = bx; uu < 512; uu += G) { const int g4 = uu & 3, blk = uu >> 2;
                gmlp_unit(PM, PM + C_AU, NPM, args.in[4] + l * 512, args.in[5] + (size_t)(l * 4 + g4) * 16384, args.in[6] + (l * 4 + g4) * 128, blk * 128, g4, lds, tid); }
#if PROBE == 8
            conv_items(PM, XB, DM, args.in[11] + l * 1536, gtid, gthreads);
#endif
            conv_items(PM, PM + C_CB, NPM, args.in[11] + l * 1536, gtid, gthreads);
            SEAM(pb + 1);
        }
        if (IN(pb + 2)) {
            pg8::Gemm g{PM + C_AU, (const bf16_t*)(ws + WS_WBR), NPM, 512, (size_t)(C_Q - C_AU) * 2, (size_t)(C_CB - C_AU) * 2, MiB}; pg8::StaticOrder S; S.init(M, DM, G, bx, 3);
            EpiBranch E{XB, G8};
            pg8::gemm_phase<EpiBranch, pg8::StaticOrder>(lds, g, S, E);
#if PROBE == 7
            pg8::gemm_phase<EpiBranch, pg8::StaticOrder>(lds, g, S, E);
#endif
            SEAM(pb + 2);
        }
        if (IN(pb + 3)) {
            pg8::Gemm g{XB, (const bf16_t*)(ws + WS_WOUT), DM, DM, 0, 0, 0}; pg8::StaticOrder S; S.init(M, DM, G, bx);
            EpiResid E{xres_in, args.out, XBM, ROWSS + (size_t)(2 * l + 1) * M};
#if PROBE == 9
            { EpiResid E2{args.in[0], (float*)(ws + WS_HB), nullptr, nullptr}; pg8::gemm_phase<EpiResid, pg8::StaticOrder>(lds, g, S, E2); }
#endif
            pg8::gemm_phase<EpiResid, pg8::StaticOrder>(lds, g, S, E);
            SEAM(pb + 3);
        }
        if (IN(pb + 4)) {
            if (l == 0) { TIDS(); convert_region_a(args, 1, lds, gw, ngw, wave, lane); }
            __syncthreads();
            pg8::Gemm g{XBM, (const bf16_t*)(ws + WS_WF1), DM, DM, 0, 0, 0}; pg8::StaticOrder S; S.init(M, FF, G, bx);
            EpiFF1 E{HB, ROWSS + (size_t)(2 * l + 1) * M};
            pg8::gemm_phase<EpiFF1, pg8::StaticOrder>(lds, g, S, E);
#if PROBE == 3
            pg8::gemm_phase<EpiFF1, pg8::StaticOrder>(lds, g, S, E);
#endif
            SEAM(pb + 4);
        }
        if (IN(pb + 5)) {
            pg8::Gemm g{HB, (const bf16_t*)(ws + WS_WF2), FF, FF, 0, 0, 0}; pg8::StaticOrder S; S.init(M, DM, G, bx);
            EpiResid E{args.out, args.out, (l + 1 < DEPTH) ? XB : nullptr, ROWSS + (size_t)(2 * l + 2 < 4 ? 2 * l + 2 : 0) * M};
            pg8::gemm_phase<EpiResid, pg8::StaticOrder>(lds, g, S, E);
            SEAM(pb + 5);
        }
    }
#undef IN
#undef SEAM
}

extern "C" void kernel_launch(void* const* d_in, const int* in_sizes, int n_in, void* d_out, int out_size, void* d_ws, size_t ws_size, hipStream_t stream) {
    static int grid = 0;
    if (grid == 0) {
        if (n_in != 19 || in_sizes[0] != M * DM || out_size != M * DM || ws_size < WS_END) { fprintf(stderr, "kernel_launch: unexpected shapes / workspace (%d inputs, ws %zu)\n", n_in, ws_size); grid = -1; return; }
        int dev = 0, cus = 0, per_cu = 0;
        if (hipGetDevice(&dev) != hipSuccess || hipDeviceGetAttribute(&cus, hipDeviceAttributeMultiprocessorCount, dev) != hipSuccess) { grid = -1; return; }
        if (hipFuncSetAttribute((const void*)fwd_kernel, hipFuncAttributeMaxDynamicSharedMemorySize, LDS_BYTES) != hipSuccess) { fprintf(stderr, "kernel_launch: hipFuncSetAttribute failed\n"); grid = -1; return; }
        if (hipOccupancyMaxActiveBlocksPerMultiprocessor(&per_cu, (const void*)fwd_kernel, NWAVES * 64, LDS_BYTES) != hipSuccess || per_cu < 1) { fprintf(stderr, "kernel_launch: occupancy query says %d blocks per CU\n", per_cu); grid = -1; return; }
        grid = cus;
    }
    if (grid < 0) return;
    (void)hipMemsetAsync((char*)d_ws + WS_CTL, 0, CTL_BYTES, stream);
    Args a{};
    for (int i = 0; i < 19; ++i) a.in[i] = (const float*)d_in[i];
    a.out = (float*)d_out; a.ws = (unsigned char*)d_ws;
#if MK_MULTI
    for (int p = 0; p < N_PHASES; ++p) { a.ph_lo = p; a.ph_hi = p + 1; hipLaunchKernelGGL(fwd_kernel, dim3(grid), dim3(NWAVES * 64), LDS_BYTES, stream, a); }
#else
    a.ph_lo = 0; a.ph_hi = N_PHASES;
    void* kargs[] = {&a};
    hipError_t e = hipLaunchCooperativeKernel((const void*)fwd_kernel, dim3(grid), dim3(NWAVES * 64), kargs, LDS_BYTES, stream);
    if (e != hipSuccess) fprintf(stderr, "kernel_launch: cooperative launch failed: %s (grid %d)\n", hipGetErrorString(e), grid);
#endif
}
```

```cpp
#include <hip/hip_runtime.h>
#include <hip/hip_cooperative_groups.h>
#include <cstdio>
#include <cstdint>
namespace cg = cooperative_groups;

#ifndef PROBE
#define PROBE 0
#endif
#ifndef WGM_IN
#define WGM_IN 2
#endif
#ifndef WGM_FF
#define WGM_FF 2
#endif
#ifndef WGM_N1
#define WGM_N1 4
#endif
#ifndef MK_MULTI
#define MK_MULTI 0
#endif

namespace pg8 {
#define PG8_LAS __attribute__((address_space(3)))
typedef unsigned short bf16_t;
typedef short bf16x8 __attribute__((ext_vector_type(8)));
typedef float f32x4 __attribute__((ext_vector_type(4)));
typedef unsigned u32x4 __attribute__((ext_vector_type(4)));
typedef unsigned u32x2 __attribute__((ext_vector_type(2)));
constexpr int BM = 256, BK = 64, HALF = 128, HTB = HALF * BK * 2, STAGE_BYTES = 8 * HTB, NXCD = 8;

__host__ __device__ __forceinline__ int lds_byte(int r, int c) { const int st = (r >> 4) * 2 + (c >> 5), rr = r & 15, cc = c & 31, ob = rr * 64 + cc * 2; return st * 1024 + (ob ^ (((ob >> 9) & 1) << 5)); }
__host__ __device__ __forceinline__ void stage_rc(int b, int& R, int& C) { const int st = b / 1024, sb = b % 1024, swz = sb ^ (((sb >> 9) & 1) << 5); R = (st >> 1) * 16 + swz / 64; C = (st & 1) * 32 + (swz % 64) / 2; }
__host__ __device__ __forceinline__ int perm32(int rho) { const int n = rho >> 4, i = rho & 15; return 8 * (i >> 2) + 4 * n + (i & 3); }

struct Unit { int pm, pn, j; };
struct Gemm { const bf16_t* A; const bf16_t* Bt; int lda, K; size_t a_j1, a_j2, b_j;
    __device__ __forceinline__ size_t aoff(int j) const { return j == 0 ? (size_t)0 : (j == 1 ? a_j1 : a_j2); } };

struct StaticOrder {
    int nM, nN, nwg, G, c, NJ, WGM;
    __host__ __device__ void init(int M, int N, int G_, int c_, int NJ_ = 1, int WGM_ = 4) { nM = M / BM; nN = N / BM; nwg = nM * nN; G = G_; c = c_; NJ = NJ_; WGM = WGM_; }
    __host__ __device__ bool next(int i, Unit& u) const {
        const int ti = i / NJ; u.j = i - ti * NJ;
        const long L = (long)ti * G + c; if (L >= nwg) return false;
        int wgid = (int)L; { const int q = nwg / NXCD, r = nwg % NXCD, xcd = wgid % NXCD, off = wgid / NXCD; wgid = (xcd < r ? xcd * (q + 1) : r * (q + 1) + (xcd - r) * q) + off; }
        const int nig = WGM * nN, gid = wgid / nig, fm = gid * WGM, gsz = (nM - fm) < WGM ? (nM - fm) : WGM;
        u.pm = fm + ((wgid % nig) % gsz); u.pn = (wgid % nig) / gsz; return true;
    }
};

__device__ __forceinline__ unsigned cvt_pk_bf16(float lo, float hi) { unsigned r; asm volatile("v_cvt_pk_bf16_f32 %0, %1, %2" : "=v"(r) : "v"(lo), "v"(hi)); return r; }

template <class Epi, class Sched>
__device__ __forceinline__ void gemm_phase(PG8_LAS unsigned char* lds, const Gemm g, const Sched& S, const Epi& E) {
    int tid_ = threadIdx.x; asm volatile("" : "+v"(tid_));
    const int tid = tid_, wid = __builtin_amdgcn_readfirstlane(tid >> 6), lane = tid & 63, wr = wid >> 2, wc = wid & 3, fr = lane & 15, fq = lane >> 4;
    const int K = g.K, nt = K / BK, lda = g.lda;
    unsigned voffA[2], voffB[2];
#pragma unroll
    for (int i = 0; i < 2; ++i) { int R, C; stage_rc(tid * 16 + i * 8192, R, C); const int Rb = Epi::PERM ? ((R & ~31) + perm32(R & 31)) : R;
        voffA[i] = (unsigned)(R * lda + C) * 2u; voffB[i] = (unsigned)(Rb * K + C) * 2u; }
    const size_t kstep = (size_t)(BK * 2);
    const size_t hstepA = (size_t)HALF * lda * 2, hstepB = (size_t)HALF * K * 2;
    const size_t tstepA = 2 * hstepA, tstepB = 2 * hstepB;
    const unsigned ldsw = (unsigned)wid * 1024u;
    const int aoff = lds_byte(wr * 64 + fr, fq * 8), boff = lds_byte(wc * 32 + fr, fq * 8);
#define PG8_SA(b, h) (((b) * 2 + (h)) * HTB)
#define PG8_SB(b, h) ((4 + (b) * 2 + (h)) * HTB)
#define PG8_STAGE(bufoff, gbase, voff) do { _Pragma("unroll") for (int _i = 0; _i < 2; ++_i) \
        __builtin_amdgcn_global_load_lds((const unsigned*)((const char*)(gbase) + (voff)[_i]), (PG8_LAS unsigned*)(lds + (bufoff) + ldsw + _i * 8192), 16, 0, 0); } while (0)
#define PG8_LDA(dst, b, h) do { _Pragma("unroll") for (int m = 0; m < 4; ++m) _Pragma("unroll") for (int k = 0; k < 2; ++k) dst[m][k] = *(const PG8_LAS bf16x8*)(lds + PG8_SA(b, h) + aoff + m * 2048 + k * 1024); } while (0)
#define PG8_LDB(dst, b, h) do { _Pragma("unroll") for (int n = 0; n < 2; ++n) _Pragma("unroll") for (int k = 0; k < 2; ++k) dst[n][k] = *(const PG8_LAS bf16x8*)(lds + PG8_SB(b, h) + boff + n * 2048 + k * 1024); } while (0)
#define PG8_MMA(ai, bj, At, Bt) do { __builtin_amdgcn_s_setprio(1); _Pragma("unroll") for (int m = 0; m < 4; ++m) _Pragma("unroll") for (int n = 0; n < 2; ++n) _Pragma("unroll") for (int k = 0; k < 2; ++k) \
        acc[ai][bj][m][n] = __builtin_amdgcn_mfma_f32_16x16x32_bf16(Bt[n][k], At[m][k], acc[ai][bj][m][n], 0, 0, 0); __builtin_amdgcn_s_setprio(0); } while (0)
#define PG8_WAIT_V(n) asm volatile("s_waitcnt vmcnt(" #n ")" ::: "memory")
#define PG8_WAIT_L(n) asm volatile("s_waitcnt lgkmcnt(" #n ")" ::: "memory")
#define PG8_BAR __builtin_amdgcn_s_barrier()
#define PG8_SCHED __builtin_amdgcn_sched_barrier(0)
    Unit cur, nxt; int ui = 0;
    if (!S.next(0, cur)) return;
    f32x4 acc[2][2][4][2];
#pragma unroll
    for (int a = 0; a < 2; ++a)
#pragma unroll
        for (int b = 0; b < 2; ++b)
#pragma unroll
            for (int m = 0; m < 4; ++m)
#pragma unroll
                for (int n = 0; n < 2; ++n) acc[a][b][m][n] = (f32x4){0.f, 0.f, 0.f, 0.f};
    bf16x8 At[4][2], B0[2][2], B1[2][2];
    const char* cA = (const char*)g.A + (size_t)cur.pm * tstepA + g.aoff(cur.j); const char* cB = (const char*)g.Bt + (size_t)cur.pn * tstepB + (size_t)cur.j * g.b_j;
    {
        PG8_STAGE(PG8_SB(0, 0), cB, voffB); PG8_STAGE(PG8_SB(0, 1), cB + hstepB, voffB); PG8_STAGE(PG8_SA(0, 0), cA, voffA); PG8_STAGE(PG8_SA(0, 1), cA + hstepA, voffA);
        if (wr == 1) PG8_BAR;
        PG8_WAIT_V(2); PG8_BAR;
        PG8_STAGE(PG8_SB(1, 0), cB + kstep, voffB); PG8_STAGE(PG8_SA(1, 0), cA + kstep, voffA); PG8_STAGE(PG8_SB(1, 1), cB + hstepB + kstep, voffB);
        PG8_WAIT_V(6); PG8_BAR;
    }
    for (;;) {
        const bool has_next = S.next(ui + 1, nxt);
        const char* nA = has_next ? (const char*)g.A + (size_t)nxt.pm * tstepA + g.aoff(nxt.j) : cA; const char* nB = has_next ? (const char*)g.Bt + (size_t)nxt.pn * tstepB + (size_t)nxt.j * g.b_j : cB;
        for (int t = 0; t < nt; t += 2) {
            const bool last = (t == nt - 2);
            const char* a1 = cA + (size_t)(t + 1) * kstep;
            const char* a2 = last ? nA : cA + (size_t)(t + 2) * kstep; const char* b2 = last ? nB : cB + (size_t)(t + 2) * kstep;
            const char* a3 = a2 + kstep; const char* b3 = b2 + kstep;
            PG8_LDB(B0, 0, 0); PG8_LDB(B1, 0, 1); PG8_SCHED; PG8_LDA(At, 0, 0); PG8_STAGE(PG8_SA(1, 1), a1 + hstepA, voffA);
            PG8_WAIT_V(8); PG8_WAIT_L(0); PG8_BAR; PG8_MMA(0, 0, At, B0); PG8_MMA(0, 1, At, B1); PG8_BAR; PG8_SCHED;
            PG8_LDA(At, 0, 1); PG8_STAGE(PG8_SB(0, 0), b2, voffB); PG8_STAGE(PG8_SB(0, 1), b2 + hstepB, voffB); PG8_STAGE(PG8_SA(0, 0), a2, voffA);
            PG8_WAIT_V(8); PG8_WAIT_L(0); PG8_BAR; PG8_MMA(1, 0, At, B0); PG8_MMA(1, 1, At, B1); PG8_BAR; PG8_SCHED;
            PG8_LDB(B0, 1, 0); PG8_LDB(B1, 1, 1); PG8_SCHED; PG8_LDA(At, 1, 0); PG8_STAGE(PG8_SA(0, 1), a2 + hstepA, voffA);
            PG8_WAIT_V(8); PG8_WAIT_L(0); PG8_BAR; PG8_MMA(0, 0, At, B0); PG8_MMA(0, 1, At, B1); PG8_BAR; PG8_SCHED;
            PG8_LDA(At, 1, 1); PG8_STAGE(PG8_SB(1, 0), b3, voffB); PG8_STAGE(PG8_SB(1, 1), b3 + hstepB, voffB); PG8_STAGE(PG8_SA(1, 0), a3, voffA);
            PG8_WAIT_V(8); PG8_WAIT_L(0); PG8_BAR; PG8_MMA(1, 0, At, B0); PG8_MMA(1, 1, At, B1); PG8_BAR; PG8_SCHED;
        }
        if (wr == 0) PG8_BAR;
        E(acc, cur, wr, wc, fr, fq);
        if (!has_next) break;
        if (!(Epi::ACCUM && nxt.j != 0)) {
#pragma unroll
        for (int a = 0; a < 2; ++a)
#pragma unroll
            for (int b = 0; b < 2; ++b)
#pragma unroll
                for (int m = 0; m < 4; ++m)
#pragma unroll
                    for (int n = 0; n < 2; ++n) acc[a][b][m][n] = (f32x4){0.f, 0.f, 0.f, 0.f};
        }
        cur = nxt; cA = nA; cB = nB; ++ui;
        if (wr == 1) PG8_BAR;
    }
    PG8_WAIT_V(0);
    PG8_BAR;
#undef PG8_SA
#undef PG8_SB
#undef PG8_STAGE
#undef PG8_LDA
#undef PG8_LDB
#undef PG8_MMA
#undef PG8_WAIT_V
#undef PG8_WAIT_L
#undef PG8_BAR
#undef PG8_SCHED
}
}

using pg8::bf16_t; using pg8::f32x4; using pg8::u32x4; using pg8::u32x2; using pg8::cvt_pk_bf16;
#define LAS __attribute__((address_space(3)))

constexpr int DM = 1024, NB = 4, SEQ = 4096, M = NB * SEQ, DEPTH = 2;
constexpr int NIN = 7168, NPM = 4096, NG = 3072, FF = 4096;
constexpr int C_AU = 0, C_AV = 512, C_Q = 1024, C_K = 1536, C_V = 2048, C_CB = 2560, C_CC = 3072, C_CX = 3584;
constexpr float EPS = 1e-6f;
constexpr float LOG2E = 1.4426950408889634f;

constexpr size_t MiB = 1u << 20;
constexpr size_t WS_CTL = 0, CTL_BYTES = 1 * MiB, WS_BAR = 512 * 1024;
constexpr size_t WS_WIN = 1 * MiB, WS_WBR = 15 * MiB, WS_WOUT = 18 * MiB;
constexpr size_t WS_WF1 = 20 * MiB, WS_WF2 = 28 * MiB;
constexpr size_t WS_XB = 36 * MiB;
constexpr size_t WS_PM = 68 * MiB;
constexpr size_t WS_G8 = 196 * MiB;
constexpr size_t WS_HB = 100 * MiB;
constexpr size_t WS_END = 244 * MiB;

constexpr int NWAVES = 8;
constexpr int RING_BYTES = 131072, LDS_BYTES = 139264;

struct Args { const float* in[19]; float* out; unsigned char* ws; int ph_lo, ph_hi; };

#define GAS __attribute__((address_space(1)))
#define XB_TMO      128
#define XB_XCNT(j)  (256  + 64 * (j))
#define XB_XSUB(j)  (1280 + 64 * (j))
#define XB_XGEN(j)  (2304 + 64 * (j))
#define XB_TOP      3328
#define XB_TOPGEN   3392
#define XCD_BAR_WORDS 3456
#define XB_SPIN_CAP (1u << 18)

__device__ __forceinline__ unsigned xb_ld(unsigned* p)              { return __hip_atomic_load(p, __ATOMIC_RELAXED, __HIP_MEMORY_SCOPE_AGENT); }
__device__ __forceinline__ unsigned xb_add(unsigned* p, unsigned v) { return __hip_atomic_fetch_add(p, v, __ATOMIC_RELAXED, __HIP_MEMORY_SCOPE_AGENT); }
__device__ __forceinline__ unsigned xb_xcc_id() { return (unsigned)__builtin_amdgcn_s_getreg((3 << 11) | 20) & 0xFu; }
#define XB_SPIN(cond, bar) do { unsigned _sp = 0; while (cond) { __builtin_amdgcn_s_sleep(1); \
    if ((++_sp & 255u) == 0u) { if (xb_ld(&(bar)[XB_TMO])) break; if (_sp > XB_SPIN_CAP) { atomicAdd(&(bar)[XB_TMO], 1u); break; } } } } while (0)

struct XcdBarrier {
    unsigned* bar; unsigned x;
    volatile LAS unsigned* st;
};

__device__ __forceinline__ XcdBarrier xcd_barrier_post(unsigned* bar, volatile LAS unsigned* st) {
    XcdBarrier b; b.bar = bar; b.x = xb_xcc_id(); b.st = st;
    if (threadIdx.x == 0) (void)xb_add(&bar[XB_XCNT(b.x)], 1u);
    return b;
}
__device__ __forceinline__ void xcd_barrier_complete(unsigned* bar, unsigned x, unsigned& nloc, unsigned& nx) {
    const unsigned G = gridDim.x * gridDim.y * gridDim.z;
    unsigned sum, cnt, mine, sp = 0u;
    for (;;) {
        sum = 0u; cnt = 0u; mine = 0u;
#pragma unroll
        for (unsigned j = 0; j < 16; ++j) { const unsigned c = xb_ld(&bar[XB_XCNT(j)]); sum += c; cnt += (c > 0u) ? 1u : 0u; mine = (j == x) ? c : mine; }
        if (sum == G) break;
        __builtin_amdgcn_s_sleep(1);
        if ((++sp & 255u) == 0u) { if (xb_ld(&bar[XB_TMO])) break; if (sp > XB_SPIN_CAP) { atomicAdd(&bar[XB_TMO], 1u); break; } }
    }
    nloc = mine > 0u ? mine : 1u; nx = cnt > 0u ? cnt : 1u;
}

__device__ __forceinline__ void xcd_barrier(const XcdBarrier& b) {
    asm volatile("s_waitcnt vmcnt(0)" ::: "memory");
    __syncthreads();
    if (threadIdx.x == 0) {
        unsigned* bar = b.bar;
        __builtin_amdgcn_s_waitcnt(0);
        unsigned nloc = b.st[0], nx = b.st[1];
        if (nloc == 0u) { xcd_barrier_complete(bar, b.x, nloc, nx); b.st[0] = nloc; b.st[1] = nx; }
        const unsigned old = xb_add(&bar[XB_XSUB(b.x)], 1u);
        const unsigned gen = old / nloc;
        if (old + 1u == (gen + 1u) * nloc) {
            __builtin_amdgcn_fence(__ATOMIC_RELEASE, "agent");
            asm volatile("s_waitcnt vmcnt(0)" ::: "memory");
            const unsigned og = xb_add(&bar[XB_TOP], 1u);
            const unsigned tg = og / nx;
            if (og + 1u == (tg + 1u) * nx) xb_add(&bar[XB_TOPGEN], 1u);
            else XB_SPIN(xb_ld(&bar[XB_TOPGEN]) == tg, bar);
            __builtin_amdgcn_fence(__ATOMIC_ACQUIRE, "agent");
            xb_add(&bar[XB_XGEN(b.x)], 1u);
            asm volatile("s_waitcnt vmcnt(0)" ::: "memory");
        } else {
            XB_SPIN(xb_ld(&bar[XB_TOPGEN]) == gen, bar);
            __builtin_amdgcn_fence(__ATOMIC_ACQUIRE, "agent");
            asm volatile("s_waitcnt vmcnt(0)" ::: "memory");
        }
    }
    __syncthreads();
}

__device__ __forceinline__ float bf_lo(unsigned w) { return __uint_as_float(w << 16); }
__device__ __forceinline__ float bf_hi(unsigned w) { return __uint_as_float(w & 0xffff0000u); }
__device__ __forceinline__ float wave_sum(float v) {
#pragma unroll
    for (int o = 1; o < 64; o <<= 1) v += __shfl_xor(v, o);
    return v;
}
__device__ __forceinline__ float gelu_tanh(float x) {
    const float u = 0.7978845608028654f * (x + 0.044715f * x * x * x);
    return x * __builtin_amdgcn_rcpf(1.f + __builtin_amdgcn_exp2f(-2.f * LOG2E * u));
}
__device__ __forceinline__ float sigmoidf(float x) { return __builtin_amdgcn_rcpf(1.f + __builtin_amdgcn_exp2f(-LOG2E * x)); }
__device__ __forceinline__ float g8f(unsigned b) { return ((float)b + 0.5f) * (1.f / 256.f); }

__device__ __forceinline__ int inproj_phys(int n) {
    if (n < C_Q || n >= C_V) return n;
    const int t = n & ~255, g = (n & 255) >> 6, d = n & 63;
    return t + ((d >> 5) << 7) + (g << 5) + (d & 31);
}

struct EpiInProj {
    static constexpr bool PERM = true, ACCUM = false;
    bf16_t* PM; unsigned char* G8; const float* rowss; const float* gate_b; const float* qnw; const float* knw; float* avss;
    __device__ __forceinline__ void operator()(f32x4 (&acc)[2][2][4][2], const pg8::Unit& u, int wr, int wc, int fr, int fq) const {
        const int row0 = u.pm * 256 + wr * 64 + fr;
        float rs[2][4];
#pragma unroll
        for (int ai = 0; ai < 2; ++ai)
#pragma unroll
            for (int m = 0; m < 4; ++m) rs[ai][m] = rsqrtf(rowss[row0 + ai * 128 + m * 16] * (1.f / DM) + EPS);
        const int pn = u.pn;
        if (pn < 4) {
            const int col0 = pn * 256 + wc * 32 + 8 * fq;
#pragma unroll
            for (int ai = 0; ai < 2; ++ai)
#pragma unroll
                for (int m = 0; m < 4; ++m) { bf16_t* rowp = PM + (size_t)(row0 + ai * 128 + m * 16) * NPM + col0; const float r = rs[ai][m]; float ss = 0.f;
#pragma unroll
                    for (int bj = 0; bj < 2; ++bj) { const f32x4 v0 = acc[ai][bj][m][0] * r, v1 = acc[ai][bj][m][1] * r; u32x4 w; float gl[8];
#pragma unroll
                        for (int e = 0; e < 4; ++e) { gl[e] = gelu_tanh(v0[e]); gl[4 + e] = gelu_tanh(v1[e]); }
#pragma unroll
                        for (int e = 0; e < 8; ++e) ss += gl[e] * gl[e];
                        w.x = cvt_pk_bf16(gl[0], gl[1]); w.y = cvt_pk_bf16(gl[2], gl[3]); w.z = cvt_pk_bf16(gl[4], gl[5]); w.w = cvt_pk_bf16(gl[6], gl[7]);
                        *(u32x4*)(rowp + bj * 128) = w; }
                    if (pn >= 2) { ss += __shfl_xor(ss, 16); ss += __shfl_xor(ss, 32); if (fq == 0) atomicAdd(avss + row0 + ai * 128 + m * 16, ss); } }
        } else if (pn < 8) {
            const bool isq = pn < 6;
            const float* nw = (isq ? qnw : knw) + (wc & 1) * 64 + 8 * fq;
            const float extra = isq ? 0.125f * LOG2E : 1.f;
            float wv[2][8];
#pragma unroll
            for (int bj = 0; bj < 2; ++bj)
#pragma unroll
                for (int i = 0; i < 8; ++i) wv[bj][i] = nw[32 * bj + i] * extra;
            const int col0 = pn * 256 + 64 * wc + 8 * fq;
#pragma unroll
            for (int ai = 0; ai < 2; ++ai)
#pragma unroll
                for (int m = 0; m < 4; ++m) { bf16_t* rowp = PM + (size_t)(row0 + ai * 128 + m * 16) * NPM + col0; const float r = rs[ai][m];
                    f32x4 v[2][2]; float ss = 0.f;
#pragma unroll
                    for (int bj = 0; bj < 2; ++bj)
#pragma unroll
                        for (int n = 0; n < 2; ++n) { v[bj][n] = acc[ai][bj][m][n] * r; const f32x4 x = v[bj][n]; ss += (x[0] * x[0] + x[1] * x[1]) + (x[2] * x[2] + x[3] * x[3]); }
                    ss += __shfl_xor(ss, 16); ss += __shfl_xor(ss, 32);
                    const float rn = rsqrtf(ss * (1.f / 64.f) + EPS);
#pragma unroll
                    for (int bj = 0; bj < 2; ++bj) { const f32x4 v0 = v[bj][0] * rn, v1 = v[bj][1] * rn; u32x4 w;
                        w.x = cvt_pk_bf16(v0[0] * wv[bj][0], v0[1] * wv[bj][1]); w.y = cvt_pk_bf16(v0[2] * wv[bj][2], v0[3] * wv[bj][3]);
                        w.z = cvt_pk_bf16(v1[0] * wv[bj][4], v1[1] * wv[bj][5]); w.w = cvt_pk_bf16(v1[2] * wv[bj][6], v1[3] * wv[bj][7]);
                        *(u32x4*)(rowp + bj * 32) = w; } }
        } else if (pn < 16) {
            const int col0 = pn * 256 + wc * 32 + 8 * fq;
#pragma unroll
            for (int ai = 0; ai < 2; ++ai)
#pragma unroll
                for (int m = 0; m < 4; ++m) { bf16_t* rowp = PM + (size_t)(row0 + ai * 128 + m * 16) * NPM + col0; const float r = rs[ai][m];
#pragma unroll
                    for (int bj = 0; bj < 2; ++bj) { const f32x4 v0 = acc[ai][bj][m][0] * r, v1 = acc[ai][bj][m][1] * r; u32x4 w;
                        w.x = cvt_pk_bf16(v0[0], v0[1]); w.y = cvt_pk_bf16(v0[2], v0[3]); w.z = cvt_pk_bf16(v1[0], v1[1]); w.w = cvt_pk_bf16(v1[2], v1[3]);
                        *(u32x4*)(rowp + bj * 128) = w; } }
        } else {
            const int col0 = (pn - 16) * 256 + wc * 32 + 8 * fq;
            f32x4 bv[2][2];
#pragma unroll
            for (int bj = 0; bj < 2; ++bj)
#pragma unroll
                for (int n = 0; n < 2; ++n) bv[bj][n] = *(const f32x4*)(gate_b + col0 + bj * 128 + 4 * n);
#pragma unroll
            for (int ai = 0; ai < 2; ++ai)
#pragma unroll
                for (int m = 0; m < 4; ++m) { unsigned char* rowp = G8 + (size_t)(row0 + ai * 128 + m * 16) * NG + col0; const float r = rs[ai][m];
#pragma unroll
                    for (int bj = 0; bj < 2; ++bj) { unsigned q[8];
#pragma unroll
                        for (int n = 0; n < 2; ++n)
#pragma unroll
                            for (int e = 0; e < 4; ++e) { const float gx = sigmoidf(acc[ai][bj][m][n][e] * r + bv[bj][n][e]); q[4 * n + e] = (unsigned)__builtin_fminf(gx * 256.f, 255.f); }
                        u32x2 w; w.x = q[0] | (q[1] << 8) | (q[2] << 16) | (q[3] << 24); w.y = q[4] | (q[5] << 8) | (q[6] << 16) | (q[7] << 24);
                        *(u32x2*)(rowp + bj * 128) = w; } }
        }
    }
};

struct EpiBranch {
    static constexpr bool PERM = true, ACCUM = true;
    bf16_t* O; const unsigned char* G8;
    __device__ __forceinline__ void operator()(f32x4 (&acc)[2][2][4][2], const pg8::Unit& u, int wr, int wc, int fr, int fq) const {
        const int row0 = u.pm * 256 + wr * 64 + fr, col0 = u.pn * 256 + wc * 32 + 8 * fq, j = u.j;
#pragma unroll
        for (int ai = 0; ai < 2; ++ai) {
            u32x2 ga[4][2], gb[4][2];
#pragma unroll
            for (int m = 0; m < 4; ++m)
#pragma unroll
                for (int bj = 0; bj < 2; ++bj) { const size_t row = (size_t)(row0 + ai * 128 + m * 16);
                    ga[m][bj] = *(const u32x2*)(G8 + row * NG + j * 1024 + col0 + bj * 128);
                    gb[m][bj] = (j < 2) ? *(const u32x2*)(G8 + row * NG + (j + 1) * 1024 + col0 + bj * 128) : (u32x2){0u, 0u}; }
#pragma unroll
            for (int m = 0; m < 4; ++m) { const size_t row = (size_t)(row0 + ai * 128 + m * 16);
#pragma unroll
                for (int bj = 0; bj < 2; ++bj) {
                    float f[8];
#pragma unroll
                    for (int e = 0; e < 4; ++e) { f[e] = g8f((ga[m][bj].x >> (8 * e)) & 0xffu); f[4 + e] = g8f((ga[m][bj].y >> (8 * e)) & 0xffu); }
                    if (j < 2) {
#pragma unroll
                        for (int e = 0; e < 4; ++e) { f[e] *= __builtin_amdgcn_rcpf(g8f((gb[m][bj].x >> (8 * e)) & 0xffu)); f[4 + e] *= __builtin_amdgcn_rcpf(g8f((gb[m][bj].y >> (8 * e)) & 0xffu)); }
                    }
#pragma unroll
                    for (int e = 0; e < 4; ++e) { acc[ai][bj][m][0][e] *= f[e]; acc[ai][bj][m][1][e] *= f[4 + e]; }
                    if (j == 2) { const f32x4 v0 = acc[ai][bj][m][0], v1 = acc[ai][bj][m][1]; u32x4 w;
                        w.x = cvt_pk_bf16(v0[0], v0[1]); w.y = cvt_pk_bf16(v0[2], v0[3]); w.z = cvt_pk_bf16(v1[0], v1[1]); w.w = cvt_pk_bf16(v1[2], v1[3]);
                        *(u32x4*)(O + row * DM + col0 + bj * 128) = w; }
                } }
        }
    }
};

struct EpiResid {
    static constexpr bool PERM = false, ACCUM = false;
    const float* xin; float* xout; bf16_t* xb; float* rowss;
    __device__ __forceinline__ void operator()(f32x4 (&acc)[2][2][4][2], const pg8::Unit& u, int wr, int wc, int fr, int fq) const {
        const int row0 = u.pm * 256 + wr * 64 + fr, col0 = u.pn * 256 + wc * 32 + 4 * fq;
#pragma unroll
        for (int ai = 0; ai < 2; ++ai) {
            f32x4 xr[4][2][2];
#pragma unroll
            for (int m = 0; m < 4; ++m)
#pragma unroll
                for (int bj = 0; bj < 2; ++bj)
#pragma unroll
                    for (int n = 0; n < 2; ++n) xr[m][bj][n] = *(const f32x4*)(xin + (size_t)(row0 + ai * 128 + m * 16) * DM + col0 + bj * 128 + n * 16);
#pragma unroll
            for (int m = 0; m < 4; ++m) { const int row = row0 + ai * 128 + m * 16; const size_t off = (size_t)row * DM + col0; float ss = 0.f;
#pragma unroll
                for (int bj = 0; bj < 2; ++bj)
#pragma unroll
                    for (int n = 0; n < 2; ++n) { const size_t o = off + bj * 128 + n * 16; const f32x4 x = xr[m][bj][n] + acc[ai][bj][m][n];
                        *(f32x4*)(xout + o) = x;
                        if (xb) { u32x2 w; w.x = cvt_pk_bf16(x[0], x[1]); w.y = cvt_pk_bf16(x[2], x[3]); *(u32x2*)(xb + o) = w; ss += (x[0] * x[0] + x[1] * x[1]) + (x[2] * x[2] + x[3] * x[3]); } }
                if (xb) { ss += __shfl_xor(ss, 16); ss += __shfl_xor(ss, 32); if (fq == 0) atomicAdd(rowss + row, ss); } }
        }
    }
};

struct EpiFF1 {
    static constexpr bool PERM = true, ACCUM = false;
    bf16_t* O; const float* rowss; int ldc;
    __device__ __forceinline__ void operator()(f32x4 (&acc)[2][2][4][2], const pg8::Unit& u, int wr, int wc, int fr, int fq) const {
        const int row0 = u.pm * 256 + wr * 64 + fr, col0 = u.pn * 256 + wc * 32 + 8 * fq;
        float rsv[2][4];
#pragma unroll
        for (int ai = 0; ai < 2; ++ai)
#pragma unroll
            for (int m = 0; m < 4; ++m) rsv[ai][m] = rsqrtf(rowss[row0 + ai * 128 + m * 16] * (1.f / DM) + EPS);
#pragma unroll
        for (int ai = 0; ai < 2; ++ai)
#pragma unroll
            for (int m = 0; m < 4; ++m) { const int row = row0 + ai * 128 + m * 16; const float r = rsv[ai][m]; bf16_t* rowp = O + (size_t)row * ldc + col0;
#pragma unroll
                for (int bj = 0; bj < 2; ++bj) { f32x4 v0 = acc[ai][bj][m][0] * r, v1 = acc[ai][bj][m][1] * r;
#pragma unroll
                    for (int e = 0; e < 4; ++e) { const float a = __builtin_fmaxf(v0[e], 0.f), b = __builtin_fmaxf(v1[e], 0.f); v0[e] = a * a; v1[e] = b * b; }
                    u32x4 w; w.x = cvt_pk_bf16(v0[0], v0[1]); w.y = cvt_pk_bf16(v0[2], v0[3]); w.z = cvt_pk_bf16(v1[0], v1[1]); w.w = cvt_pk_bf16(v1[2], v1[3]);
                    *(u32x4*)(rowp + bj * 128) = w; } }
    }
};

template <bool INPERM>
__device__ __forceinline__ void transpose_item(const float* W, const float* kscale, int K, int N, bf16_t* WT, LAS float* scr, int item, int lane) {
    const int nblk = N / 32, kb = item / nblk, nb = item % nblk, k0 = 64 * kb, n0 = 32 * nb;
    float v[32];
#pragma unroll
    for (int i = 0; i < 32; ++i) { const int kk = 2 * i + (lane >> 5); v[i] = W[(size_t)(k0 + kk) * N + n0 + (lane & 31)]; }
    if (kscale) {
#pragma unroll
        for (int i = 0; i < 32; ++i) v[i] *= kscale[k0 + 2 * i + (lane >> 5)]; }
#pragma unroll
    for (int i = 0; i < 32; ++i) { const int kk = 2 * i + (lane >> 5); scr[kk * 33 + (lane & 31)] = v[i]; }
    asm volatile("s_waitcnt lgkmcnt(0)" ::: "memory");
    const int c = lane & 7;
    const int r0 = INPERM ? inproj_phys(n0) : n0;
#pragma unroll
    for (int j = 0; j < 4; ++j) { const int n = (lane >> 3) + 8 * j; const LAS float* s = scr + (8 * c) * 33 + n;
        u32x4 o; o.x = cvt_pk_bf16(s[0 * 33], s[1 * 33]); o.y = cvt_pk_bf16(s[2 * 33], s[3 * 33]); o.z = cvt_pk_bf16(s[4 * 33], s[5 * 33]); o.w = cvt_pk_bf16(s[6 * 33], s[7 * 33]);
        *(u32x4*)(WT + (size_t)(r0 + n) * K + k0 + 8 * c) = o; }
    asm volatile("s_waitcnt lgkmcnt(0)" ::: "memory");
}
constexpr int IT_WIN = 16 * 224, IT_BR = 8 * 32, IT_OUT = 16 * 32, IT_F1 = 16 * 128, IT_F2 = 64 * 32;
__device__ __forceinline__ void convert_region_a(const Args& a, int l, LAS unsigned char* lds, int gw, int ngw, int wave, int lane) {
    LAS float* scr = (LAS float*)(lds + wave * 16384);
    unsigned char* ws = a.ws;
    constexpr int NIT = IT_WIN + 3 * IT_BR + IT_OUT;
    for (int it = gw; it < NIT; it += ngw) {
        int r = it;
        if (r < IT_WIN) { transpose_item<true>(a.in[2] + (size_t)l * DM * NIN, a.in[1] + l * DM, DM, NIN, (bf16_t*)(ws + WS_WIN), scr, r, lane); continue; } r -= IT_WIN;
        if (r < 3 * IT_BR) { const int j = r / IT_BR; transpose_item<false>(a.in[12 + j] + (size_t)l * 512 * DM, nullptr, 512, DM, (bf16_t*)(ws + WS_WBR + j * MiB), scr, r % IT_BR, lane); continue; } r -= 3 * IT_BR;
        transpose_item<false>(a.in[15] + (size_t)l * DM * DM, nullptr, DM, DM, (bf16_t*)(ws + WS_WOUT), scr, r, lane);
    }
}
__device__ __forceinline__ void convert_region_b(const Args& a, int l, LAS unsigned char* lds, int gw, int ngw, int wave, int lane) {
    LAS float* scr = (LAS float*)(lds + wave * 16384);
    unsigned char* ws = a.ws;
    constexpr int NIT = IT_F1 + IT_F2;
    for (int it = gw; it < NIT; it += ngw) {
        int r = it;
        if (r < IT_F1) { transpose_item<false>(a.in[17] + (size_t)l * DM * FF, a.in[16] + l * DM, DM, FF, (bf16_t*)(ws + WS_WF1), scr, r, lane); continue; } r -= IT_F1;
        transpose_item<false>(a.in[18] + (size_t)l * FF * DM, nullptr, FF, DM, (bf16_t*)(ws + WS_WF2), scr, r, lane);
    }
}

namespace att {
typedef short bf16x8 __attribute__((ext_vector_type(8)));
typedef short s16x4 __attribute__((ext_vector_type(4)));
typedef short v4i16_t __attribute__((ext_vector_type(4)));
typedef float f32x16 __attribute__((ext_vector_type(16)));
typedef float f32x8 __attribute__((ext_vector_type(8)));
typedef float f32x2_t __attribute__((ext_vector_type(2))); typedef __bf16 bf16x2_t __attribute__((ext_vector_type(2)));
__device__ __forceinline__ unsigned cvtpk_s(float lo, float hi) { f32x2_t v = {lo, hi}; bf16x2_t b = __builtin_convertvector(v, bf16x2_t); return __builtin_bit_cast(unsigned, b); }
__device__ __forceinline__ s16x4 vtr(const LAS unsigned char* p) { return __builtin_bit_cast(s16x4, __builtin_amdgcn_ds_read_tr16_b64_v4i16((LAS v4i16_t*)p)); }
constexpr int KSTR = 144, VSTR = 320, KMAP = 64 * KSTR, V_OFF = 2 * KMAP, BUF = V_OFF + 64 * VSTR;
__device__ __forceinline__ bf16x8 pack8(const f32x16& p, int o) {
    u32x4 w; w.x = cvtpk_s(p[o], p[o + 1]); w.y = cvtpk_s(p[o + 2], p[o + 3]); w.z = cvtpk_s(p[o + 4], p[o + 5]); w.w = cvtpk_s(p[o + 6], p[o + 7]); return __builtin_bit_cast(bf16x8, w); }

__device__ __forceinline__ void attn_unit(bf16_t* PM, bf16_t* obase, int opitch, int b, int h, int qb, float lam, float post, const float* subw, const float* knw, LAS unsigned char* lds, int tid_in) {
    int tid = tid_in; asm volatile("" : "+v"(tid));
    const int lane = tid & 63, wid = __builtin_amdgcn_readfirstlane(tid >> 6), r32 = lane & 31, hi = lane >> 5, m = wid >> 2, qs = wid & 3;
    const int qpos = 128 * qb + 32 * qs + r32;
    bf16_t* base = PM + (size_t)b * SEQ * NPM;
    bf16_t* qrow = base + (size_t)qpos * NPM + C_Q + h * 128;
    bf16_t* orow = obase + (size_t)(b * SEQ + qpos) * opitch + h * 128;
    bf16x8 qr[4];
#pragma unroll
    for (int d0 = 0; d0 < 4; ++d0) qr[d0] = *(const bf16x8*)(qrow + m * 64 + d0 * 16 + hi * 8);
    bool need_check;
    { float qn2 = 0.f;
#pragma unroll
      for (int d0 = 0; d0 < 4; ++d0) { const u32x4 w = __builtin_bit_cast(u32x4, qr[d0]);
          const float a0 = bf_lo(w.x), a1 = bf_hi(w.x), a2 = bf_lo(w.y), a3 = bf_hi(w.y), a4 = bf_lo(w.z), a5 = bf_hi(w.z), a6 = bf_lo(w.w), a7 = bf_hi(w.w);
          qn2 += (a0 * a0 + a1 * a1) + (a2 * a2 + a3 * a3) + (a4 * a4 + a5 * a5) + (a6 * a6 + a7 * a7); }
      qn2 += __shfl_xor(qn2, 32);
      float wk = __builtin_fmaxf(__builtin_fabsf(knw[lane]), __builtin_fabsf(knw[64 + lane]));
#pragma unroll
      for (int o = 1; o < 64; o <<= 1) wk = __builtin_fmaxf(wk, __shfl_xor(wk, o));
      need_check = __any(sqrtf(qn2) * 8.f * wk * 1.02f > 40.f); }
    const int NT = 2 * (qb + 1), my_nt = (qs < 2) ? NT - 1 : NT;
    const float sl2 = __builtin_amdgcn_exp2f(-2.f * (float)(h + 1)) * LOG2E;
    const bf16_t* gk = base + (size_t)(tid >> 3) * NPM + C_K + h * 128 + (tid & 7) * 8;
    const bf16_t* gv = base + (size_t)(tid >> 4) * NPM + C_V + h * 128 + (tid & 15) * 8;
    const int lk = (tid >> 3) * KSTR + (tid & 7) * 16, lv = V_OFF + (tid >> 4) * VSTR + (tid & 15) * 16;
    u32x4 st0, st1, st2, st3;
#define ATT_LOAD(t) do { const size_t ro = (size_t)(t) * 64 * NPM; st0 = *(const u32x4*)(gk + ro); st1 = *(const u32x4*)(gk + ro + 64); st2 = *(const u32x4*)(gv + ro); st3 = *(const u32x4*)(gv + ro + (size_t)32 * NPM); } while (0)
#define ATT_STORE(bufp) do { *(LAS u32x4*)((bufp) + lk) = st0; *(LAS u32x4*)((bufp) + KMAP + lk) = st1; *(LAS u32x4*)((bufp) + lv) = st2; *(LAS u32x4*)((bufp) + lv + 32 * VSTR) = st3; } while (0)
    __syncthreads();
    ATT_LOAD(0); ATT_STORE(lds);
    __syncthreads();
    f32x16 OT[4];
#pragma unroll
    for (int eb = 0; eb < 4; ++eb)
#pragma unroll
        for (int r = 0; r < 16; ++r) OT[eb][r] = 0.f;
    float mref = 0.f, lsum = 0.f;
    const float s64 = 64.f * sl2;
    const float s32 = 32.f * sl2;
    f32x16 ci0;
#pragma unroll
    for (int r = 0; r < 16; ++r) ci0[r] = sl2 * (float)(4 * hi + (r & 3) + 8 * (r >> 2) - qpos);
    for (int t = 0; t < NT; ++t) {
        LAS unsigned char* buf = lds + (t & 1) * BUF;
        if (t + 1 < NT) ATT_LOAD(t + 1);
        if (t < my_nt) {
            const LAS unsigned char* kp = buf + m * KMAP + r32 * KSTR + hi * 16;
            f32x16 p0 = ci0, p1 = ci0 + s32;
            if (t == my_nt - 1) {
                int hid = hi; asm volatile("" : "+v"(hid));
                const float qf = (float)qpos, k0 = (float)(64 * t + 4 * hid), cadd = -mref;
#pragma unroll
                for (int r = 0; r < 16; ++r) { const float kf = k0 + (float)((r & 3) + 8 * (r >> 2));
                    p0[r] = __builtin_fmaf(-sl2, __builtin_fabsf(qf - kf), cadd); p1[r] = __builtin_fmaf(-sl2, __builtin_fabsf(qf - (kf + 32.f)), cadd); }
            }
            bf16x8 ka[4], kb2[4];
#pragma unroll
            for (int d0 = 0; d0 < 4; ++d0) { ka[d0] = *(const LAS bf16x8*)(kp + d0 * 32); kb2[d0] = *(const LAS bf16x8*)(kp + 32 * KSTR + d0 * 32); }
#pragma unroll
            for (int d0 = 0; d0 < 4; ++d0) {
                p0 = __builtin_amdgcn_mfma_f32_32x32x16_bf16(ka[d0], qr[d0], p0, 0, 0, 0);
                p1 = __builtin_amdgcn_mfma_f32_32x32x16_bf16(kb2[d0], qr[d0], p1, 0, 0, 0);
            }
            const LAS unsigned char* vp = buf + V_OFF + (4 * hi + ((lane & 15) >> 2)) * VSTR + ((lane >> 4) & 1) * 32 + (lane & 3) * 8;
            s16x4 vlo[2][4], vhi[2][4];
#pragma unroll
            for (int eb = 0; eb < 4; ++eb) { vlo[0][eb] = vtr(vp + eb * 64); vhi[0][eb] = vtr(vp + 8 * VSTR + eb * 64); }
            float mt = 0.f;
            if (need_check) { mt = __builtin_fmaxf(p0[0], p1[0]);
#pragma unroll
                for (int r = 1; r < 16; ++r) mt = __builtin_fmaxf(__builtin_fmaxf(mt, p0[r]), p1[r]);
                mt = __builtin_fmaxf(mt, __shfl_xor(mt, 32)); }
            if (need_check && __any(mt > 40.f)) {
                const float dl = __builtin_fmaxf(mt, 0.f), f = __builtin_amdgcn_exp2f(-dl);
                mref += dl; lsum *= f; p0 -= dl; p1 -= dl; ci0 -= dl;
#pragma unroll
                for (int eb = 0; eb < 4; ++eb) OT[eb] *= f;
            }
#if PROBE == 13
            { float dz = 0.f;
#pragma unroll
              for (int r = 0; r < 16; ++r) { dz += __builtin_amdgcn_exp2f(p0[r] + 1.f) + __builtin_amdgcn_exp2f(p1[r] + 1.f); }
              asm volatile("" :: "v"(dz)); }
#endif
#if PROBE == 14
            { f32x16 dacc = p0;
#pragma unroll
              for (int d0 = 0; d0 < 4; ++d0) { dacc = __builtin_amdgcn_mfma_f32_32x32x16_bf16(ka[d0], qr[d0], dacc, 0, 0, 0); dacc = __builtin_amdgcn_mfma_f32_32x32x16_bf16(kb2[d0], qr[d0], dacc, 0, 0, 0); }
              asm volatile("" :: "v"(dacc)); }
#endif
#pragma unroll
            for (int r = 0; r < 16; ++r) { p0[r] = __builtin_amdgcn_exp2f(p0[r]); p1[r] = __builtin_amdgcn_exp2f(p1[r]); }
            { const f32x16 s16 = p0 + p1; const f32x8 s8 = s16.lo + s16.hi; const f32x4 s4v = s8.lo + s8.hi; const f32x2_t s2 = s4v.lo + s4v.hi; lsum += s2.x + s2.y; }
            ci0 += s64;
            bf16x8 pf[4]; pf[0] = pack8(p0, 0); pf[1] = pack8(p0, 8); pf[2] = pack8(p1, 0); pf[3] = pack8(p1, 8);
#pragma unroll
            for (int s4 = 0; s4 < 4; ++s4) {
                if (s4 < 3) {
#pragma unroll
                    for (int eb = 0; eb < 4; ++eb) { vlo[(s4 + 1) & 1][eb] = vtr(vp + (16 * (s4 + 1)) * VSTR + eb * 64); vhi[(s4 + 1) & 1][eb] = vtr(vp + (16 * (s4 + 1) + 8) * VSTR + eb * 64); }
                }
#pragma unroll
                for (int eb = 0; eb < 4; ++eb) {
                    const s16x4 a = vlo[s4 & 1][eb], c = vhi[s4 & 1][eb];
                    const bf16x8 vf = (bf16x8){a[0], a[1], a[2], a[3], c[0], c[1], c[2], c[3]};
                    OT[eb] = __builtin_amdgcn_mfma_f32_32x32x16_bf16(vf, pf[s4], OT[eb], 0, 0, 0);
                }
            }
        }
        if (t + 1 < NT) ATT_STORE(lds + ((t + 1) & 1) * BUF);
        __syncthreads();
    }
#undef ATT_LOAD
#undef ATT_STORE
    lsum += __shfl_xor(lsum, 32);
    const float inv = 1.f / lsum;
#pragma unroll
    for (int eb = 0; eb < 4; ++eb)
#pragma unroll
        for (int r = 0; r < 16; ++r) OT[eb][r] *= inv;
    int hif = hi, lanef = lane; asm volatile("" : "+v"(hif), "+v"(lanef));
    LAS float* X = (LAS float*)(lds + qs * 16384) + lanef;
    if (m == 1) {
#pragma unroll
        for (int eb = 0; eb < 4; ++eb)
#pragma unroll
            for (int r = 0; r < 16; ++r) X[(eb * 16 + r) * 64] = OT[eb][r];
    }
    __syncthreads();
    if (m == 0) {
        float ss = 0.f;
#pragma unroll
        for (int eb = 0; eb < 4; ++eb) {
            __builtin_amdgcn_sched_barrier(0);
#pragma unroll
            for (int r = 0; r < 16; ++r) { const float o = OT[eb][r] - lam * X[(eb * 16 + r) * 64]; OT[eb][r] = o; ss += o * o; } }
        __builtin_amdgcn_sched_barrier(0);
        ss += __shfl_xor(ss, 32);
        const float rn = rsqrtf(ss * (1.f / 128.f) + EPS) * post;
        f32x4 w4a[4][4];
#pragma unroll
        for (int eb = 0; eb < 4; ++eb)
#pragma unroll
            for (int rg = 0; rg < 4; ++rg) w4a[eb][rg] = *(const f32x4*)(subw + 32 * eb + 8 * rg + 4 * hif);
#pragma unroll
        for (int eb = 0; eb < 4; ++eb)
#pragma unroll
            for (int rg = 0; rg < 4; ++rg) { const int e = 32 * eb + 8 * rg + 4 * hif; const f32x4 w4 = w4a[eb][rg];
                u32x2 w; w.x = cvtpk_s(OT[eb][4 * rg] * rn * w4[0], OT[eb][4 * rg + 1] * rn * w4[1]); w.y = cvtpk_s(OT[eb][4 * rg + 2] * rn * w4[2], OT[eb][4 * rg + 3] * rn * w4[3]);
                *(u32x2*)(orow + e) = w; }
    }
}
}

__device__ __forceinline__ void gmlp_unit(bf16_t* PM, bf16_t* obase, int opitch, const float* avss, const float* vnw, const float* ws_g, const float* bs_g, int rowbase, int g, LAS unsigned char* lds, int tid) {
    constexpr int VSTR = 320, WSTR = 272, W_OFF = 128 * VSTR;
    const int lane = tid & 63, wid = __builtin_amdgcn_readfirstlane(tid >> 6), r32 = lane & 31, hi = lane >> 5;
    __syncthreads();
    {
        const int row = tid >> 2, part = tid & 3;
        const bf16_t* rp = PM + (size_t)(rowbase + row) * NPM + C_AV;
        const float r = rsqrtf(avss[rowbase + row] * (1.f / 512.f) + EPS);
        const int c0 = part * 32;
#pragma unroll
        for (int i = 0; i < 4; ++i) { const u32x4 w = *(const u32x4*)(rp + g * 128 + c0 + i * 8); const float* nw = vnw + g * 128 + c0 + i * 8;
            const f32x4 n0 = *(const f32x4*)nw, n1 = *(const f32x4*)(nw + 4); u32x4 o;
            o.x = att::cvtpk_s(bf_lo(w.x) * r * n0[0], bf_hi(w.x) * r * n0[1]); o.y = att::cvtpk_s(bf_lo(w.y) * r * n0[2], bf_hi(w.y) * r * n0[3]);
            o.z = att::cvtpk_s(bf_lo(w.z) * r * n1[0], bf_hi(w.z) * r * n1[1]); o.w = att::cvtpk_s(bf_lo(w.w) * r * n1[2], bf_hi(w.w) * r * n1[3]);
            *(LAS u32x4*)(lds + row * VSTR + (c0 + i * 8) * 2) = o; }
#pragma unroll
        for (int i = 0; i < 4; ++i) { const int e8 = (i * 512 + tid) * 8, t = e8 >> 7, s0 = e8 & 127; f32x4 a = *(const f32x4*)(ws_g + e8), b = *(const f32x4*)(ws_g + e8 + 4);
#pragma unroll
            for (int e = 0; e < 4; ++e) { if (s0 + e > t) a[e] = 0.f; if (s0 + 4 + e > t) b[e] = 0.f; }
            u32x4 o; o.x = att::cvtpk_s(a[0], a[1]); o.y = att::cvtpk_s(a[2], a[3]); o.z = att::cvtpk_s(b[0], b[1]); o.w = att::cvtpk_s(b[2], b[3]);
            *(LAS u32x4*)(lds + W_OFF + t * WSTR + s0 * 2) = o; }
    }
    __syncthreads();
    const int cb = wid & 3;
    const LAS unsigned char* vp = lds + (8 * hi + ((lane & 15) >> 2)) * VSTR + (32 * cb + 16 * ((lane >> 4) & 1) + 4 * (lane & 3)) * 2;
#pragma unroll
    for (int pass = 0; pass < 2; ++pass) {
        const int tb = pass == 0 ? (wid >> 2) : 3 - (wid >> 2);
        att::f32x16 acc;
#pragma unroll
        for (int r = 0; r < 16; ++r) acc[r] = 0.f;
        const LAS unsigned char* wp = lds + W_OFF + (32 * tb + r32) * WSTR + hi * 16;
        const int nk = 2 * (tb + 1);
        for (int kk = 0; kk < nk; ++kk) {
            const att::s16x4 vlo = att::vtr(vp + (16 * kk) * VSTR), vhi = att::vtr(vp + (16 * kk + 4) * VSTR);
            const att::bf16x8 A = (att::bf16x8){vlo[0], vlo[1], vlo[2], vlo[3], vhi[0], vhi[1], vhi[2], vhi[3]};
            const att::bf16x8 B = *(const LAS att::bf16x8*)(wp + kk * 32);
            acc = __builtin_amdgcn_mfma_f32_32x32x16_bf16(A, B, acc, 0, 0, 0);
        }
        const int t = 32 * tb + r32; const float bsv = bs_g[t];
        u32x2 uua[4];
#pragma unroll
        for (int rg = 0; rg < 4; ++rg) uua[rg] = *(const u32x2*)(PM + (size_t)(rowbase + t) * NPM + C_AU + g * 128 + 32 * cb + 8 * rg + 4 * hi);
#pragma unroll
        for (int rg = 0; rg < 4; ++rg) { const int c = 32 * cb + 8 * rg + 4 * hi;
            const u32x2 uu = uua[rg];
            u32x2 o; o.x = att::cvtpk_s(bf_lo(uu.x) * (acc[4 * rg] + bsv), bf_hi(uu.x) * (acc[4 * rg + 1] + bsv)); o.y = att::cvtpk_s(bf_lo(uu.y) * (acc[4 * rg + 2] + bsv), bf_hi(uu.y) * (acc[4 * rg + 3] + bsv));
            *(u32x2*)(obase + (size_t)(rowbase + t) * opitch + g * 128 + c) = o; }
    }
}

__device__ __forceinline__ void conv_items(bf16_t* PM, bf16_t* obase, int opitch, const float* cw, int gtid, int gthreads) {
    const int c0 = (gtid & 63) * 8;
    float cwv[3][8];
#pragma unroll
    for (int j = 0; j < 3; ++j)
#pragma unroll
        for (int e = 0; e < 8; ++e) cwv[j][e] = cw[j * 512 + c0 + e];
    for (int idx = gtid; idx < M * 64; idx += 4 * gthreads) {
        u32x4 A[4][3], B[4][3], CB[4];
#pragma unroll
        for (int u = 0; u < 4; ++u) { const int i = (idx + u * gthreads < M * 64) ? idx + u * gthreads : idx; const int row = i >> 6, spos = row & (SEQ - 1);
            const bf16_t* rp = PM + (size_t)row * NPM;
#pragma unroll
            for (int j = 0; j < 3; ++j) { const int dt = (spos >= 2 - j) ? 2 - j : 0; A[u][j] = *(const u32x4*)(rp - (size_t)dt * NPM + C_CC + c0); B[u][j] = *(const u32x4*)(rp - (size_t)dt * NPM + C_CX + c0); }
            CB[u] = *(const u32x4*)(rp + C_CB + c0); }
#pragma unroll
        for (int u = 0; u < 4; ++u) { const int i = idx + u * gthreads; if (i < M * 64) { const int row = i >> 6, spos = row & (SEQ - 1);
            float y[8];
#pragma unroll
            for (int e = 0; e < 8; ++e) y[e] = 0.f;
#pragma unroll
            for (int j = 0; j < 3; ++j) { const float mk = (spos >= 2 - j) ? 1.f : 0.f; const u32x4 a = A[u][j], b2 = B[u][j];
                y[0] += mk * cwv[j][0] * (bf_lo(a.x) * bf_lo(b2.x)); y[1] += mk * cwv[j][1] * (bf_hi(a.x) * bf_hi(b2.x)); y[2] += mk * cwv[j][2] * (bf_lo(a.y) * bf_lo(b2.y)); y[3] += mk * cwv[j][3] * (bf_hi(a.y) * bf_hi(b2.y));
                y[4] += mk * cwv[j][4] * (bf_lo(a.z) * bf_lo(b2.z)); y[5] += mk * cwv[j][5] * (bf_hi(a.z) * bf_hi(b2.z)); y[6] += mk * cwv[j][6] * (bf_lo(a.w) * bf_lo(b2.w)); y[7] += mk * cwv[j][7] * (bf_hi(a.w) * bf_hi(b2.w)); }
            const u32x4 cb = CB[u];
            u32x4 w; w.x = cvt_pk_bf16(bf_lo(cb.x) * y[0], bf_hi(cb.x) * y[1]); w.y = cvt_pk_bf16(bf_lo(cb.y) * y[2], bf_hi(cb.y) * y[3]);
            w.z = cvt_pk_bf16(bf_lo(cb.z) * y[4], bf_hi(cb.z) * y[5]); w.w = cvt_pk_bf16(bf_lo(cb.w) * y[6], bf_hi(cb.w) * y[7]);
            *(u32x4*)(obase + (size_t)row * opitch + c0) = w; } }
    }
}

constexpr int N_PHASES = 1 + 6 * DEPTH;
__global__ void __launch_bounds__(NWAVES * 64, 2) fwd_kernel(Args args) {
    extern __shared__ __attribute__((aligned(16))) unsigned char lds_raw[];
    LAS unsigned char* lds = (LAS unsigned char*)lds_raw;
    const int G = gridDim.x, bx = blockIdx.x, ngw = G * NWAVES, gthreads = G * NWAVES * 64;
#define TIDS() int tid_ = threadIdx.x; asm volatile("" : "+v"(tid_)); const int tid = tid_, lane = tid & 63, wave = __builtin_amdgcn_readfirstlane(tid >> 6), gw = bx * NWAVES + wave, gtid = bx * (NWAVES * 64) + tid; (void)lane; (void)gw; (void)gtid
    unsigned char* ws = args.ws;
    float* ROWSS = (float*)(ws + WS_CTL);
    bf16_t* XB = (bf16_t*)(ws + WS_XB); bf16_t* PM = (bf16_t*)(ws + WS_PM); bf16_t* XBM = (bf16_t*)(ws + WS_PM); bf16_t* HB = (bf16_t*)(ws + WS_HB);
    unsigned char* G8 = ws + WS_G8;
    const int lo = args.ph_lo, hi = args.ph_hi;
#if !MK_MULTI
    cg::grid_group grid = cg::this_grid();
    volatile LAS unsigned* bst = (volatile LAS unsigned*)(lds + RING_BYTES + 512);
    if (threadIdx.x < 2) bst[threadIdx.x] = 0u;
    __syncthreads();
    const XcdBarrier xbar = xcd_barrier_post((unsigned*)(ws + WS_BAR), bst);
#define SEAM(ph) do { if ((ph) + 1 < hi) { if (PROBE != 12 && hi > 1000) grid.sync();   xcd_barrier(xbar); if (PROBE == 6) { xcd_barrier(xbar); xcd_barrier(xbar); } } } while (0)
#else
#define SEAM(ph) do { } while (0)
#endif
#define IN(k) (lo <= (k) && (k) < hi)
#if PROBE >= 20
    unsigned long long tp_acc = 0, tp_t0 = 0;
#define TP_BEGIN(type) do { if (PROBE - 20 == (type)) tp_t0 = __builtin_amdgcn_s_memrealtime(); } while (0)
#define TP_END(type) do { if (PROBE - 20 == (type)) tp_acc += __builtin_amdgcn_s_memrealtime() - tp_t0; } while (0)
#else
#define TP_BEGIN(type) do { } while (0)
#define TP_END(type) do { } while (0)
#endif

    TP_BEGIN(0);
    if (IN(0)) {
        TIDS();
        for (int rep = 0; rep < (PROBE == 1 ? 2 : 1); ++rep) {
        convert_region_a(args, 0, lds, gw, ngw, wave, lane);
        convert_region_b(args, 0, lds, gw, ngw, wave, lane); }
        const float* x = args.in[0];
        for (int r = gw; r < M; r += 2 * ngw) {
            const int r2 = (r + ngw < M) ? r + ngw : r;
            const f32x4* xr = (const f32x4*)(x + (size_t)r * DM) + lane; const f32x4* xr2 = (const f32x4*)(x + (size_t)r2 * DM) + lane;
            f32x4 va[4], vb[4];
#pragma unroll
            for (int j = 0; j < 4; ++j) { va[j] = xr[64 * j]; vb[j] = xr2[64 * j]; }
            u32x2* o = (u32x2*)(XB + (size_t)r * DM) + lane; u32x2* o2 = (u32x2*)(XB + (size_t)r2 * DM) + lane; float s = 0.f, s2 = 0.f;
#pragma unroll
            for (int j = 0; j < 4; ++j) { const f32x4 v = va[j]; s += (v[0] * v[0] + v[1] * v[1]) + (v[2] * v[2] + v[3] * v[3]); u32x2 w; w.x = cvt_pk_bf16(v[0], v[1]); w.y = cvt_pk_bf16(v[2], v[3]); o[64 * j] = w;
                const f32x4 q = vb[j]; s2 += (q[0] * q[0] + q[1] * q[1]) + (q[2] * q[2] + q[3] * q[3]); u32x2 w2; w2.x = cvt_pk_bf16(q[0], q[1]); w2.y = cvt_pk_bf16(q[2], q[3]); o2[64 * j] = w2; }
            s = wave_sum(s); s2 = wave_sum(s2); if (lane == 0) { ROWSS[r] = s; ROWSS[r2] = s2; }
        }
        SEAM(0);
    }
    TP_END(0);
    for (int l = 0; l < DEPTH; ++l) {
        const int pb = 1 + 6 * l;
        const float* xres_in = (l == 0) ? args.in[0] : args.out;
        TP_BEGIN(1);
        if (IN(pb + 0)) {
            pg8::Gemm g{XB, (const bf16_t*)(ws + WS_WIN), DM, DM, 0, 0, 0}; pg8::StaticOrder S; S.init(M, NIN, G, bx, 1, WGM_IN);
            EpiInProj E{PM, G8, ROWSS + (size_t)(2 * l) * M, args.in[3] + l * NG, args.in[7] + l * 128, args.in[8] + l * 128, ROWSS + (size_t)(4 + l) * M};
            pg8::gemm_phase<EpiInProj, pg8::StaticOrder>(lds, g, S, E);
#if PROBE == 2
            pg8::gemm_phase<EpiInProj, pg8::StaticOrder>(lds, g, S, E);
#endif
            SEAM(pb + 0);
        }
        TP_END(1);
        TP_BEGIN(2);
        if (IN(pb + 1)) {
            TIDS();
            if (l == 1) convert_region_b(args, 1, lds, gw, ngw, wave, lane);
            const float* lp = args.in[9] + l * 256;
            const float sa = wave_sum(lp[lane] * lp[64 + lane]), sb = wave_sum(lp[128 + lane] * lp[192 + lane]);
            const float lam_init = 0.8f - 0.6f * expf(-0.3f * (float)l);
            const float lam = expf(sa) - expf(sb) + lam_init;
#if PROBE == 4
            for (int pi = bx; pi < 256; pi += G) { const int bh = pi >> 4, sq = pi & 15;
                att::attn_unit(PM, XB, DM, bh >> 2, bh & 3, 31 - sq, lam, 1.f - lam_init, args.in[10] + l * 128, args.in[8] + l * 128, lds, tid);
                att::attn_unit(PM, XB, DM, bh >> 2, bh & 3, sq, lam, 1.f - lam_init, args.in[10] + l * 128, args.in[8] + l * 128, lds, tid); }
#endif
            for (int pi = bx; pi < 256; pi += G) { const int bh = pi >> 4, sq = pi & 15;
                att::attn_unit(PM, PM + C_Q, NPM, bh >> 2, bh & 3, 31 - sq, lam, 1.f - lam_init, args.in[10] + l * 128, args.in[8] + l * 128, lds, tid);
                att::attn_unit(PM, PM + C_Q, NPM, bh >> 2, bh & 3, sq, lam, 1.f - lam_init, args.in[10] + l * 128, args.in[8] + l * 128, lds, tid); }
#if PROBE == 5
            for (int uu = bx; uu < 512; uu += G) { const int g4 = uu & 3, blk = uu >> 2;
                gmlp_unit(PM, XB, DM, ROWSS + (size_t)(4 + l) * M, args.in[4] + l * 512, args.in[5] + (size_t)(l * 4 + g4) * 16384, args.in[6] + (l * 4 + g4) * 128, blk * 128, g4, lds, tid); }
#endif
            for (int uu = bx; uu < 512; uu += G) { const int g4 = uu & 3, blk = uu >> 2;
                gmlp_unit(PM, PM + C_AU, NPM, ROWSS + (size_t)(4 + l) * M, args.in[4] + l * 512, args.in[5] + (size_t)(l * 4 + g4) * 16384, args.in[6] + (l * 4 + g4) * 128, blk * 128, g4, lds, tid); }
#if PROBE == 8
            conv_items(PM, XB, DM, args.in[11] + l * 1536, gtid, gthreads);
#endif
            conv_items(PM, PM + C_CB, NPM, args.in[11] + l * 1536, gtid, gthreads);
            SEAM(pb + 1);
        }
        TP_END(2);
        TP_BEGIN(3);
        if (IN(pb + 2)) {
            pg8::Gemm g{PM + C_AU, (const bf16_t*)(ws + WS_WBR), NPM, 512, (size_t)(C_Q - C_AU) * 2, (size_t)(C_CB - C_AU) * 2, MiB}; pg8::StaticOrder S; S.init(M, DM, G, bx, 3, WGM_N1);
            EpiBranch E{XB, G8};
            pg8::gemm_phase<EpiBranch, pg8::StaticOrder>(lds, g, S, E);
#if PROBE == 7
            pg8::gemm_phase<EpiBranch, pg8::StaticOrder>(lds, g, S, E);
#endif
            SEAM(pb + 2);
        }
        TP_END(3);
        TP_BEGIN(4);
        if (IN(pb + 3)) {
            pg8::Gemm g{XB, (const bf16_t*)(ws + WS_WOUT), DM, DM, 0, 0, 0}; pg8::StaticOrder S; S.init(M, DM, G, bx, 1, WGM_N1);
            EpiResid E{xres_in, args.out, XBM, ROWSS + (size_t)(2 * l + 1) * M};
#if PROBE == 9
            { EpiResid E2{args.in[0], (float*)(ws + WS_HB), nullptr, nullptr}; pg8::gemm_phase<EpiResid, pg8::StaticOrder>(lds, g, S, E2); }
#endif
            pg8::gemm_phase<EpiResid, pg8::StaticOrder>(lds, g, S, E);
            SEAM(pb + 3);
        }
        TP_END(4);
        TP_BEGIN(5);
        if (IN(pb + 4)) {
            if (l == 0) { TIDS(); convert_region_a(args, 1, lds, gw, ngw, wave, lane); }
            __syncthreads();
            pg8::Gemm g{XBM, (const bf16_t*)(ws + WS_WF1), DM, DM, 0, 0, 0}; pg8::StaticOrder S; S.init(M, FF, G, bx, 1, WGM_FF);
            EpiFF1 E{HB, ROWSS + (size_t)(2 * l + 1) * M, FF};
            pg8::gemm_phase<EpiFF1, pg8::StaticOrder>(lds, g, S, E);
#if PROBE == 3
            pg8::gemm_phase<EpiFF1, pg8::StaticOrder>(lds, g, S, E);
#endif
            SEAM(pb + 4);
        }
        TP_END(5);
        TP_BEGIN(6);
        if (IN(pb + 5)) {
            pg8::Gemm g{HB, (const bf16_t*)(ws + WS_WF2), FF, FF, 0, 0, 0}; pg8::StaticOrder S; S.init(M, DM, G, bx, 1, WGM_N1);
            EpiResid E{args.out, args.out, (l + 1 < DEPTH) ? XB : nullptr, ROWSS + (size_t)(2 * l + 2 < 4 ? 2 * l + 2 : 0) * M};
#if PROBE == 10
            { EpiFF1 E2{XBM, ROWSS + (size_t)(2 * l + 1) * M, DM}; pg8::gemm_phase<EpiFF1, pg8::StaticOrder>(lds, g, S, E2); }
#endif
            pg8::gemm_phase<EpiResid, pg8::StaticOrder>(lds, g, S, E);
            SEAM(pb + 5);
        }
        TP_END(6);
    }
#if PROBE >= 20
    if (blockIdx.x == 0 && threadIdx.x == 0) { const unsigned long long tb = __builtin_amdgcn_s_memrealtime(); while (__builtin_amdgcn_s_memrealtime() - tb < 4 * tp_acc) __builtin_amdgcn_s_sleep(8); }
#endif
#undef IN
#undef SEAM
}

extern "C" void kernel_launch(void* const* d_in, const int* in_sizes, int n_in, void* d_out, int out_size, void* d_ws, size_t ws_size, hipStream_t stream) {
    static int grid = 0;
    if (grid == 0) {
        if (n_in != 19 || in_sizes[0] != M * DM || out_size != M * DM || ws_size < WS_END) { fprintf(stderr, "kernel_launch: unexpected shapes / workspace (%d inputs, ws %zu)\n", n_in, ws_size); grid = -1; return; }
        int dev = 0, cus = 0, per_cu = 0;
        if (hipGetDevice(&dev) != hipSuccess || hipDeviceGetAttribute(&cus, hipDeviceAttributeMultiprocessorCount, dev) != hipSuccess) { grid = -1; return; }
        if (hipFuncSetAttribute((const void*)fwd_kernel, hipFuncAttributeMaxDynamicSharedMemorySize, LDS_BYTES) != hipSuccess) { fprintf(stderr, "kernel_launch: hipFuncSetAttribute failed\n"); grid = -1; return; }
        if (hipOccupancyMaxActiveBlocksPerMultiprocessor(&per_cu, (const void*)fwd_kernel, NWAVES * 64, LDS_BYTES) != hipSuccess || per_cu < 1) { fprintf(stderr, "kernel_launch: occupancy query says %d blocks per CU\n", per_cu); grid = -1; return; }
        grid = cus;
    }
    if (grid < 0) return;
    (void)hipMemsetAsync((char*)d_ws + WS_CTL, 0, CTL_BYTES, stream);
#if PROBE == 11
    (void)hipMemsetAsync((char*)d_ws + WS_END, 0, CTL_BYTES, stream);
    (void)hipMemsetAsync((char*)d_ws + WS_END + CTL_BYTES, 0, CTL_BYTES, stream);
#endif
    Args a{};
    for (int i = 0; i < 19; ++i) a.in[i] = (const float*)d_in[i];
    a.out = (float*)d_out; a.ws = (unsigned char*)d_ws;
#if MK_MULTI
    for (int p = 0; p < N_PHASES; ++p) { a.ph_lo = p; a.ph_hi = p + 1; hipLaunchKernelGGL(fwd_kernel, dim3(grid), dim3(NWAVES * 64), LDS_BYTES, stream, a); }
#else
    a.ph_lo = 0; a.ph_hi = N_PHASES;
    void* kargs[] = {&a};
#if PROBE == 12
    (void)kargs; hipLaunchKernelGGL(fwd_kernel, dim3(grid), dim3(NWAVES * 64), LDS_BYTES, stream, a); hipError_t e = hipSuccess;
#else
    hipError_t e = hipLaunchCooperativeKernel((const void*)fwd_kernel, dim3(grid), dim3(NWAVES * 64), kargs, LDS_BYTES, stream);
#endif
    if (e != hipSuccess) fprintf(stderr, "kernel_launch: cooperative launch failed: %s (grid %d)\n", hipGetErrorString(e), grid);
#endif
}
```

```cpp
#include <hip/hip_runtime.h>
#include <hip/hip_cooperative_groups.h>
#include <cstdio>
#include <cstdint>
namespace cg = cooperative_groups;

#ifndef PROBE
#define PROBE 0
#endif
#ifndef WGM_IN
#define WGM_IN 2
#endif
#ifndef WGM_FF
#define WGM_FF 2
#endif
#ifndef WGM_N1
#define WGM_N1 4
#endif
#ifndef MK_MULTI
#define MK_MULTI 0
#endif

namespace pg8 {
#define PG8_LAS __attribute__((address_space(3)))
typedef unsigned short bf16_t;
typedef short bf16x8 __attribute__((ext_vector_type(8)));
typedef float f32x4 __attribute__((ext_vector_type(4)));
typedef unsigned u32x4 __attribute__((ext_vector_type(4)));
typedef unsigned u32x2 __attribute__((ext_vector_type(2)));
constexpr int BM = 256, BK = 64, HALF = 128, HTB = HALF * BK * 2, STAGE_BYTES = 8 * HTB, NXCD = 8;

__host__ __device__ __forceinline__ int lds_byte(int r, int c) { const int st = (r >> 4) * 2 + (c >> 5), rr = r & 15, cc = c & 31, ob = rr * 64 + cc * 2; return st * 1024 + (ob ^ (((ob >> 9) & 1) << 5)); }
__host__ __device__ __forceinline__ void stage_rc(int b, int& R, int& C) { const int st = b / 1024, sb = b % 1024, swz = sb ^ (((sb >> 9) & 1) << 5); R = (st >> 1) * 16 + swz / 64; C = (st & 1) * 32 + (swz % 64) / 2; }
__host__ __device__ __forceinline__ int perm32(int rho) { const int n = rho >> 4, i = rho & 15; return 8 * (i >> 2) + 4 * n + (i & 3); }

struct Unit { int pm, pn, j; };
struct Gemm { const bf16_t* A; const bf16_t* Bt; int lda, K; size_t a_j1, a_j2, b_j;
    __device__ __forceinline__ size_t aoff(int j) const { return j == 0 ? (size_t)0 : (j == 1 ? a_j1 : a_j2); } };

struct StaticOrder {
    int nM, nN, nwg, G, c, NJ, WGM;
    __host__ __device__ void init(int M, int N, int G_, int c_, int NJ_ = 1, int WGM_ = 4) { nM = M / BM; nN = N / BM; nwg = nM * nN; G = G_; c = c_; NJ = NJ_; WGM = WGM_; }
    __host__ __device__ bool next(int i, Unit& u) const {
        const int ti = i / NJ; u.j = i - ti * NJ;
        const long L = (long)ti * G + c; if (L >= nwg) return false;
        int wgid = (int)L; { const int q = nwg / NXCD, r = nwg % NXCD, xcd = wgid % NXCD, off = wgid / NXCD; wgid = (xcd < r ? xcd * (q + 1) : r * (q + 1) + (xcd - r) * q) + off; }
        const int nig = WGM * nN, gid = wgid / nig, fm = gid * WGM, gsz = (nM - fm) < WGM ? (nM - fm) : WGM;
        u.pm = fm + ((wgid % nig) % gsz); u.pn = (wgid % nig) / gsz; return true;
    }
};

__device__ __forceinline__ unsigned cvt_pk_bf16(float lo, float hi) { unsigned r; asm volatile("v_cvt_pk_bf16_f32 %0, %1, %2" : "=v"(r) : "v"(lo), "v"(hi)); return r; }

template <class Epi, class Sched>
__device__ __forceinline__ void gemm_phase(PG8_LAS unsigned char* lds, const Gemm g, const Sched& S, const Epi& E) {
    int tid_ = threadIdx.x; asm volatile("" : "+v"(tid_));
    const int tid = tid_, wid = __builtin_amdgcn_readfirstlane(tid >> 6), lane = tid & 63, wr = wid >> 2, wc = wid & 3, fr = lane & 15, fq = lane >> 4;
    const int K = g.K, nt = K / BK, lda = g.lda;
    unsigned voffA[2], voffB[2];
#pragma unroll
    for (int i = 0; i < 2; ++i) { int R, C; stage_rc(tid * 16 + i * 8192, R, C); const int Rb = Epi::PERM ? ((R & ~31) + perm32(R & 31)) : R;
        voffA[i] = (unsigned)(R * lda + C) * 2u; voffB[i] = (unsigned)(Rb * K + C) * 2u; }
    const size_t kstep = (size_t)(BK * 2);
    const size_t hstepA = (size_t)HALF * lda * 2, hstepB = (size_t)HALF * K * 2;
    const size_t tstepA = 2 * hstepA, tstepB = 2 * hstepB;
    const unsigned ldsw = (unsigned)wid * 1024u;
    const int aoff = lds_byte(wr * 64 + fr, fq * 8), boff = lds_byte(wc * 32 + fr, fq * 8);
#define PG8_SA(b, h) (((b) * 2 + (h)) * HTB)
#define PG8_SB(b, h) ((4 + (b) * 2 + (h)) * HTB)
#define PG8_STAGE(bufoff, gbase, voff) do { _Pragma("unroll") for (int _i = 0; _i < 2; ++_i) \
        __builtin_amdgcn_global_load_lds((const unsigned*)((const char*)(gbase) + (voff)[_i]), (PG8_LAS unsigned*)(lds + (bufoff) + ldsw + _i * 8192), 16, 0, 0); } while (0)
#define PG8_LDA(dst, b, h) do { _Pragma("unroll") for (int m = 0; m < 4; ++m) _Pragma("unroll") for (int k = 0; k < 2; ++k) dst[m][k] = *(const PG8_LAS bf16x8*)(lds + PG8_SA(b, h) + aoff + m * 2048 + k * 1024); } while (0)
#define PG8_LDB(dst, b, h) do { _Pragma("unroll") for (int n = 0; n < 2; ++n) _Pragma("unroll") for (int k = 0; k < 2; ++k) dst[n][k] = *(const PG8_LAS bf16x8*)(lds + PG8_SB(b, h) + boff + n * 2048 + k * 1024); } while (0)
#define PG8_MMA(ai, bj, At, Bt) do { __builtin_amdgcn_s_setprio(1); _Pragma("unroll") for (int m = 0; m < 4; ++m) _Pragma("unroll") for (int n = 0; n < 2; ++n) _Pragma("unroll") for (int k = 0; k < 2; ++k) \
        acc[ai][bj][m][n] = __builtin_amdgcn_mfma_f32_16x16x32_bf16(Bt[n][k], At[m][k], acc[ai][bj][m][n], 0, 0, 0); __builtin_amdgcn_s_setprio(0); } while (0)
#define PG8_WAIT_V(n) asm volatile("s_waitcnt vmcnt(" #n ")" ::: "memory")
#define PG8_WAIT_L(n) asm volatile("s_waitcnt lgkmcnt(" #n ")" ::: "memory")
#define PG8_BAR __builtin_amdgcn_s_barrier()
#define PG8_SCHED __builtin_amdgcn_sched_barrier(0)
    Unit cur, nxt; int ui = 0;
    if (!S.next(0, cur)) return;
    typename Epi::Pre epre;
    f32x4 acc[2][2][4][2];
#pragma unroll
    for (int a = 0; a < 2; ++a)
#pragma unroll
        for (int b = 0; b < 2; ++b)
#pragma unroll
            for (int m = 0; m < 4; ++m)
#pragma unroll
                for (int n = 0; n < 2; ++n) acc[a][b][m][n] = (f32x4){0.f, 0.f, 0.f, 0.f};
    bf16x8 At[4][2], B0[2][2], B1[2][2];
    const char* cA = (const char*)g.A + (size_t)cur.pm * tstepA + g.aoff(cur.j); const char* cB = (const char*)g.Bt + (size_t)cur.pn * tstepB + (size_t)cur.j * g.b_j;
    {
        PG8_STAGE(PG8_SB(0, 0), cB, voffB); PG8_STAGE(PG8_SB(0, 1), cB + hstepB, voffB); PG8_STAGE(PG8_SA(0, 0), cA, voffA); PG8_STAGE(PG8_SA(0, 1), cA + hstepA, voffA);
        if (wr == 1) PG8_BAR;
        PG8_WAIT_V(2); PG8_BAR;
        PG8_STAGE(PG8_SB(1, 0), cB + kstep, voffB); PG8_STAGE(PG8_SA(1, 0), cA + kstep, voffA); PG8_STAGE(PG8_SB(1, 1), cB + hstepB + kstep, voffB);
        PG8_WAIT_V(6); PG8_BAR;
    }
    for (;;) {
        const bool has_next = S.next(ui + 1, nxt);
        const char* nA = has_next ? (const char*)g.A + (size_t)nxt.pm * tstepA + g.aoff(nxt.j) : cA; const char* nB = has_next ? (const char*)g.Bt + (size_t)nxt.pn * tstepB + (size_t)nxt.j * g.b_j : cB;
        for (int t = 0; t < nt; t += 2) {
            const bool last = (t == nt - 2);
            if (last) E.pre(epre, cur, wr, fr);
            const char* a1 = cA + (size_t)(t + 1) * kstep;
            const char* a2 = last ? nA : cA + (size_t)(t + 2) * kstep; const char* b2 = last ? nB : cB + (size_t)(t + 2) * kstep;
            const char* a3 = a2 + kstep; const char* b3 = b2 + kstep;
            PG8_LDB(B0, 0, 0); PG8_LDB(B1, 0, 1); PG8_SCHED; PG8_LDA(At, 0, 0); PG8_STAGE(PG8_SA(1, 1), a1 + hstepA, voffA);
            PG8_WAIT_V(8); PG8_WAIT_L(0); PG8_BAR; PG8_MMA(0, 0, At, B0); PG8_MMA(0, 1, At, B1); PG8_BAR; PG8_SCHED;
            PG8_LDA(At, 0, 1); PG8_STAGE(PG8_SB(0, 0), b2, voffB); PG8_STAGE(PG8_SB(0, 1), b2 + hstepB, voffB); PG8_STAGE(PG8_SA(0, 0), a2, voffA);
            PG8_WAIT_V(8); PG8_WAIT_L(0); PG8_BAR; PG8_MMA(1, 0, At, B0); PG8_MMA(1, 1, At, B1); PG8_BAR; PG8_SCHED;
            PG8_LDB(B0, 1, 0); PG8_LDB(B1, 1, 1); PG8_SCHED; PG8_LDA(At, 1, 0); PG8_STAGE(PG8_SA(0, 1), a2 + hstepA, voffA);
            PG8_WAIT_V(8); PG8_WAIT_L(0); PG8_BAR; PG8_MMA(0, 0, At, B0); PG8_MMA(0, 1, At, B1); PG8_BAR; PG8_SCHED;
            PG8_LDA(At, 1, 1); PG8_STAGE(PG8_SB(1, 0), b3, voffB); PG8_STAGE(PG8_SB(1, 1), b3 + hstepB, voffB); PG8_STAGE(PG8_SA(1, 0), a3, voffA);
            PG8_WAIT_V(8); PG8_WAIT_L(0); PG8_BAR; PG8_MMA(1, 0, At, B0); PG8_MMA(1, 1, At, B1); PG8_BAR; PG8_SCHED;
        }
        if (wr == 0) PG8_BAR;
        E(acc, cur, wr, wc, fr, fq, epre);
        if (!has_next) break;
        if (!(Epi::ACCUM && nxt.j != 0)) {
#pragma unroll
        for (int a = 0; a < 2; ++a)
#pragma unroll
            for (int b = 0; b < 2; ++b)
#pragma unroll
                for (int m = 0; m < 4; ++m)
#pragma unroll
                    for (int n = 0; n < 2; ++n) acc[a][b][m][n] = (f32x4){0.f, 0.f, 0.f, 0.f};
        }
        cur = nxt; cA = nA; cB = nB; ++ui;
        if (wr == 1) PG8_BAR;
    }
    PG8_WAIT_V(0);
    PG8_BAR;
#undef PG8_SA
#undef PG8_SB
#undef PG8_STAGE
#undef PG8_LDA
#undef PG8_LDB
#undef PG8_MMA
#undef PG8_WAIT_V
#undef PG8_WAIT_L
#undef PG8_BAR
#undef PG8_SCHED
}
}

using pg8::bf16_t; using pg8::f32x4; using pg8::u32x4; using pg8::u32x2; using pg8::cvt_pk_bf16;
#define LAS __attribute__((address_space(3)))

constexpr int DM = 1024, NB = 4, SEQ = 4096, M = NB * SEQ, DEPTH = 2;
constexpr int NIN = 7168, NPM = 4096, NG = 3072, FF = 4096;
constexpr int C_AU = 0, C_AV = 512, C_Q = 1024, C_K = 1536, C_V = 2048, C_CB = 2560, C_CC = 3072, C_CX = 3584;
constexpr float EPS = 1e-6f;
constexpr float LOG2E = 1.4426950408889634f;

constexpr size_t MiB = 1u << 20;
constexpr size_t WS_CTL = 0, CTL_BYTES = 1 * MiB, WS_BAR = 512 * 1024;
constexpr size_t WS_WIN = 1 * MiB, WS_WBR = 15 * MiB, WS_WOUT = 18 * MiB;
constexpr size_t WS_WF1 = 20 * MiB, WS_WF2 = 28 * MiB;
constexpr size_t WS_XB = 36 * MiB;
constexpr size_t WS_PM = 68 * MiB;
constexpr size_t WS_G8 = 196 * MiB;
constexpr size_t WS_HB = 100 * MiB;
constexpr size_t WS_END = 244 * MiB;

constexpr int NWAVES = 8;
constexpr int RING_BYTES = 131072, LDS_BYTES = 139264;

struct Args { const float* in[19]; float* out; unsigned char* ws; int ph_lo, ph_hi; };

#define GAS __attribute__((address_space(1)))
#define XB_TMO      128
#define XB_XCNT(j)  (256  + 64 * (j))
#define XB_XSUB(j)  (1280 + 64 * (j))
#define XB_XGEN(j)  (2304 + 64 * (j))
#define XB_TOP      3328
#define XB_TOPGEN   3392
#define XCD_BAR_WORDS 3456
#define XB_SPIN_CAP (1u << 18)

__device__ __forceinline__ unsigned xb_ld(unsigned* p)              { return __hip_atomic_load(p, __ATOMIC_RELAXED, __HIP_MEMORY_SCOPE_AGENT); }
__device__ __forceinline__ unsigned xb_add(unsigned* p, unsigned v) { return __hip_atomic_fetch_add(p, v, __ATOMIC_RELAXED, __HIP_MEMORY_SCOPE_AGENT); }
__device__ __forceinline__ unsigned xb_xcc_id() { return (unsigned)__builtin_amdgcn_s_getreg((3 << 11) | 20) & 0xFu; }
#define XB_SPIN(cond, bar) do { unsigned _sp = 0; while (cond) { __builtin_amdgcn_s_sleep(1); \
    if ((++_sp & 255u) == 0u) { if (xb_ld(&(bar)[XB_TMO])) break; if (_sp > XB_SPIN_CAP) { atomicAdd(&(bar)[XB_TMO], 1u); break; } } } } while (0)

struct XcdBarrier {
    unsigned* bar; unsigned x;
    volatile LAS unsigned* st;
};

__device__ __forceinline__ XcdBarrier xcd_barrier_post(unsigned* bar, volatile LAS unsigned* st) {
    XcdBarrier b; b.bar = bar; b.x = xb_xcc_id(); b.st = st;
    if (threadIdx.x == 0) (void)xb_add(&bar[XB_XCNT(b.x)], 1u);
    return b;
}
__device__ __forceinline__ void xcd_barrier_complete(unsigned* bar, unsigned x, unsigned& nloc, unsigned& nx) {
    const unsigned G = gridDim.x * gridDim.y * gridDim.z;
    unsigned sum, cnt, mine, sp = 0u;
    for (;;) {
        sum = 0u; cnt = 0u; mine = 0u;
#pragma unroll
        for (unsigned j = 0; j < 16; ++j) { const unsigned c = xb_ld(&bar[XB_XCNT(j)]); sum += c; cnt += (c > 0u) ? 1u : 0u; mine = (j == x) ? c : mine; }
        if (sum == G) break;
        __builtin_amdgcn_s_sleep(1);
        if ((++sp & 255u) == 0u) { if (xb_ld(&bar[XB_TMO])) break; if (sp > XB_SPIN_CAP) { atomicAdd(&bar[XB_TMO], 1u); break; } }
    }
    nloc = mine > 0u ? mine : 1u; nx = cnt > 0u ? cnt : 1u;
}

__device__ __forceinline__ void xcd_barrier(const XcdBarrier& b) {
    asm volatile("s_waitcnt vmcnt(0)" ::: "memory");
    __syncthreads();
    if (threadIdx.x == 0) {
        unsigned* bar = b.bar;
        __builtin_amdgcn_s_waitcnt(0);
        unsigned nloc = b.st[0], nx = b.st[1];
        if (nloc == 0u) { xcd_barrier_complete(bar, b.x, nloc, nx); b.st[0] = nloc; b.st[1] = nx; }
        const unsigned old = xb_add(&bar[XB_XSUB(b.x)], 1u);
        const unsigned gen = old / nloc;
        if (old + 1u == (gen + 1u) * nloc) {
            __builtin_amdgcn_fence(__ATOMIC_RELEASE, "agent");
            asm volatile("s_waitcnt vmcnt(0)" ::: "memory");
            const unsigned og = xb_add(&bar[XB_TOP], 1u);
            const unsigned tg = og / nx;
            if (og + 1u == (tg + 1u) * nx) xb_add(&bar[XB_TOPGEN], 1u);
            else XB_SPIN(xb_ld(&bar[XB_TOPGEN]) == tg, bar);
            __builtin_amdgcn_fence(__ATOMIC_ACQUIRE, "agent");
            xb_add(&bar[XB_XGEN(b.x)], 1u);
            asm volatile("s_waitcnt vmcnt(0)" ::: "memory");
        } else {
            XB_SPIN(xb_ld(&bar[XB_TOPGEN]) == gen, bar);
            __builtin_amdgcn_fence(__ATOMIC_ACQUIRE, "agent");
            asm volatile("s_waitcnt vmcnt(0)" ::: "memory");
        }
    }
    __syncthreads();
}

__device__ __forceinline__ float bf_lo(unsigned w) { return __uint_as_float(w << 16); }
__device__ __forceinline__ float bf_hi(unsigned w) { return __uint_as_float(w & 0xffff0000u); }
__device__ __forceinline__ float wave_sum(float v) {
#pragma unroll
    for (int o = 1; o < 64; o <<= 1) v += __shfl_xor(v, o);
    return v;
}
__device__ __forceinline__ float gelu_tanh(float x) {
    const float u = 0.7978845608028654f * (x + 0.044715f * x * x * x);
    return x * __builtin_amdgcn_rcpf(1.f + __builtin_amdgcn_exp2f(-2.f * LOG2E * u));
}
__device__ __forceinline__ float sigmoidf(float x) { return __builtin_amdgcn_rcpf(1.f + __builtin_amdgcn_exp2f(-LOG2E * x)); }
__device__ __forceinline__ float g8f(unsigned b) { return ((float)b + 0.5f) * (1.f / 256.f); }

__device__ __forceinline__ int inproj_phys(int n) {
    if (n < C_Q || n >= C_V) return n;
    const int t = n & ~255, g = (n & 255) >> 6, d = n & 63;
    return t + ((d >> 5) << 7) + (g << 5) + (d & 31);
}

struct EpiInProj {
    static constexpr bool PERM = true, ACCUM = false;
    bf16_t* PM; unsigned char* G8; const float* rowss; const float* gate_b; const float* qnw; const float* knw; float* avss;
    struct Pre { float v[2][4]; };
    __device__ __forceinline__ void pre(Pre& p, const pg8::Unit& u, int wr, int fr) const {
        const int row0 = u.pm * 256 + wr * 64 + fr;
#pragma unroll
        for (int ai = 0; ai < 2; ++ai)
#pragma unroll
            for (int m = 0; m < 4; ++m) p.v[ai][m] = rowss[row0 + ai * 128 + m * 16];
    }
    __device__ __forceinline__ void operator()(f32x4 (&acc)[2][2][4][2], const pg8::Unit& u, int wr, int wc, int fr, int fq, const Pre& p) const {
        const int row0 = u.pm * 256 + wr * 64 + fr;
        float rs[2][4];
#pragma unroll
        for (int ai = 0; ai < 2; ++ai)
#pragma unroll
            for (int m = 0; m < 4; ++m) rs[ai][m] = rsqrtf(p.v[ai][m] * (1.f / DM) + EPS);
        const int pn = u.pn;
        if (pn < 4) {
            const int col0 = pn * 256 + wc * 32 + 8 * fq;
#pragma unroll
            for (int ai = 0; ai < 2; ++ai)
#pragma unroll
                for (int m = 0; m < 4; ++m) { bf16_t* rowp = PM + (size_t)(row0 + ai * 128 + m * 16) * NPM + col0; const float r = rs[ai][m]; float ss = 0.f;
#pragma unroll
                    for (int bj = 0; bj < 2; ++bj) { const f32x4 v0 = acc[ai][bj][m][0] * r, v1 = acc[ai][bj][m][1] * r; u32x4 w; float gl[8];
#pragma unroll
                        for (int e = 0; e < 4; ++e) { gl[e] = gelu_tanh(v0[e]); gl[4 + e] = gelu_tanh(v1[e]); }
#pragma unroll
                        for (int e = 0; e < 8; ++e) ss += gl[e] * gl[e];
                        w.x = cvt_pk_bf16(gl[0], gl[1]); w.y = cvt_pk_bf16(gl[2], gl[3]); w.z = cvt_pk_bf16(gl[4], gl[5]); w.w = cvt_pk_bf16(gl[6], gl[7]);
                        *(u32x4*)(rowp + bj * 128) = w; }
                    if (pn >= 2) { ss += __shfl_xor(ss, 16); ss += __shfl_xor(ss, 32); if (fq == 0) atomicAdd(avss + row0 + ai * 128 + m * 16, ss); } }
        } else if (pn < 8) {
            const bool isq = pn < 6;
            const float* nw = (isq ? qnw : knw) + (wc & 1) * 64 + 8 * fq;
            const float extra = isq ? 0.125f * LOG2E : 1.f;
            float wv[2][8];
#pragma unroll
            for (int bj = 0; bj < 2; ++bj)
#pragma unroll
                for (int i = 0; i < 8; ++i) wv[bj][i] = nw[32 * bj + i] * extra;
            const int col0 = pn * 256 + 64 * wc + 8 * fq;
#pragma unroll
            for (int ai = 0; ai < 2; ++ai)
#pragma unroll
                for (int m = 0; m < 4; ++m) { bf16_t* rowp = PM + (size_t)(row0 + ai * 128 + m * 16) * NPM + col0; const float r = rs[ai][m];
                    f32x4 v[2][2]; float ss = 0.f;
#pragma unroll
                    for (int bj = 0; bj < 2; ++bj)
#pragma unroll
                        for (int n = 0; n < 2; ++n) { v[bj][n] = acc[ai][bj][m][n] * r; const f32x4 x = v[bj][n]; ss += (x[0] * x[0] + x[1] * x[1]) + (x[2] * x[2] + x[3] * x[3]); }
                    ss += __shfl_xor(ss, 16); ss += __shfl_xor(ss, 32);
                    const float rn = rsqrtf(ss * (1.f / 64.f) + EPS);
#pragma unroll
                    for (int bj = 0; bj < 2; ++bj) { const f32x4 v0 = v[bj][0] * rn, v1 = v[bj][1] * rn; u32x4 w;
                        w.x = cvt_pk_bf16(v0[0] * wv[bj][0], v0[1] * wv[bj][1]); w.y = cvt_pk_bf16(v0[2] * wv[bj][2], v0[3] * wv[bj][3]);
                        w.z = cvt_pk_bf16(v1[0] * wv[bj][4], v1[1] * wv[bj][5]); w.w = cvt_pk_bf16(v1[2] * wv[bj][6], v1[3] * wv[bj][7]);
                        *(u32x4*)(rowp + bj * 32) = w; } }
        } else if (pn < 16) {
            const int col0 = pn * 256 + wc * 32 + 8 * fq;
#pragma unroll
            for (int ai = 0; ai < 2; ++ai)
#pragma unroll
                for (int m = 0; m < 4; ++m) { bf16_t* rowp = PM + (size_t)(row0 + ai * 128 + m * 16) * NPM + col0; const float r = rs[ai][m];
#pragma unroll
                    for (int bj = 0; bj < 2; ++bj) { const f32x4 v0 = acc[ai][bj][m][0] * r, v1 = acc[ai][bj][m][1] * r; u32x4 w;
                        w.x = cvt_pk_bf16(v0[0], v0[1]); w.y = cvt_pk_bf16(v0[2], v0[3]); w.z = cvt_pk_bf16(v1[0], v1[1]); w.w = cvt_pk_bf16(v1[2], v1[3]);
                        *(u32x4*)(rowp + bj * 128) = w; } }
        } else {
            const int col0 = (pn - 16) * 256 + wc * 32 + 8 * fq;
            f32x4 bv[2][2];
#pragma unroll
            for (int bj = 0; bj < 2; ++bj)
#pragma unroll
                for (int n = 0; n < 2; ++n) bv[bj][n] = *(const f32x4*)(gate_b + col0 + bj * 128 + 4 * n);
#pragma unroll
            for (int ai = 0; ai < 2; ++ai)
#pragma unroll
                for (int m = 0; m < 4; ++m) { unsigned char* rowp = G8 + (size_t)(row0 + ai * 128 + m * 16) * NG + col0; const float r = rs[ai][m];
#pragma unroll
                    for (int bj = 0; bj < 2; ++bj) { unsigned q[8];
#pragma unroll
                        for (int n = 0; n < 2; ++n)
#pragma unroll
                            for (int e = 0; e < 4; ++e) { const float gx = sigmoidf(acc[ai][bj][m][n][e] * r + bv[bj][n][e]); q[4 * n + e] = (unsigned)__builtin_fminf(gx * 256.f, 255.f); }
                        u32x2 w; w.x = q[0] | (q[1] << 8) | (q[2] << 16) | (q[3] << 24); w.y = q[4] | (q[5] << 8) | (q[6] << 16) | (q[7] << 24);
                        *(u32x2*)(rowp + bj * 128) = w; } }
        }
    }
};

struct EpiBranch {
    static constexpr bool PERM = true, ACCUM = true;
    bf16_t* O; const unsigned char* G8;
    struct Pre { };
    __device__ __forceinline__ void pre(Pre&, const pg8::Unit&, int, int) const {}
    __device__ __forceinline__ void operator()(f32x4 (&acc)[2][2][4][2], const pg8::Unit& u, int wr, int wc, int fr, int fq, const Pre&) const {
        const int row0 = u.pm * 256 + wr * 64 + fr, col0 = u.pn * 256 + wc * 32 + 8 * fq, j = u.j;
#pragma unroll
        for (int ai = 0; ai < 2; ++ai) {
            u32x2 ga[4][2], gb[4][2];
#pragma unroll
            for (int m = 0; m < 4; ++m)
#pragma unroll
                for (int bj = 0; bj < 2; ++bj) { const size_t row = (size_t)(row0 + ai * 128 + m * 16);
                    ga[m][bj] = *(const u32x2*)(G8 + row * NG + j * 1024 + col0 + bj * 128);
                    gb[m][bj] = (j < 2) ? *(const u32x2*)(G8 + row * NG + (j + 1) * 1024 + col0 + bj * 128) : (u32x2){0u, 0u}; }
#pragma unroll
            for (int m = 0; m < 4; ++m) { const size_t row = (size_t)(row0 + ai * 128 + m * 16);
#pragma unroll
                for (int bj = 0; bj < 2; ++bj) {
                    float f[8];
#pragma unroll
                    for (int e = 0; e < 4; ++e) { f[e] = g8f((ga[m][bj].x >> (8 * e)) & 0xffu); f[4 + e] = g8f((ga[m][bj].y >> (8 * e)) & 0xffu); }
                    if (j < 2) {
#pragma unroll
                        for (int e = 0; e < 4; ++e) { f[e] *= __builtin_amdgcn_rcpf(g8f((gb[m][bj].x >> (8 * e)) & 0xffu)); f[4 + e] *= __builtin_amdgcn_rcpf(g8f((gb[m][bj].y >> (8 * e)) & 0xffu)); }
                    }
#pragma unroll
                    for (int e = 0; e < 4; ++e) { acc[ai][bj][m][0][e] *= f[e]; acc[ai][bj][m][1][e] *= f[4 + e]; }
                    if (j == 2) { const f32x4 v0 = acc[ai][bj][m][0], v1 = acc[ai][bj][m][1]; u32x4 w;
                        w.x = cvt_pk_bf16(v0[0], v0[1]); w.y = cvt_pk_bf16(v0[2], v0[3]); w.z = cvt_pk_bf16(v1[0], v1[1]); w.w = cvt_pk_bf16(v1[2], v1[3]);
                        *(u32x4*)(O + row * DM + col0 + bj * 128) = w; }
                } }
        }
    }
};

struct EpiResid {
    static constexpr bool PERM = false, ACCUM = false;
    const float* xin; float* xout; bf16_t* xb; float* rowss;
    struct Pre { };
    __device__ __forceinline__ void pre(Pre&, const pg8::Unit&, int, int) const {}
    __device__ __forceinline__ void operator()(f32x4 (&acc)[2][2][4][2], const pg8::Unit& u, int wr, int wc, int fr, int fq, const Pre&) const {
        const int row0 = u.pm * 256 + wr * 64 + fr, col0 = u.pn * 256 + wc * 32 + 4 * fq;
#pragma unroll
        for (int ai = 0; ai < 2; ++ai) {
            f32x4 xr[4][2][2];
#pragma unroll
            for (int m = 0; m < 4; ++m)
#pragma unroll
                for (int bj = 0; bj < 2; ++bj)
#pragma unroll
                    for (int n = 0; n < 2; ++n) xr[m][bj][n] = *(const f32x4*)(xin + (size_t)(row0 + ai * 128 + m * 16) * DM + col0 + bj * 128 + n * 16);
#pragma unroll
            for (int m = 0; m < 4; ++m) { const int row = row0 + ai * 128 + m * 16; const size_t off = (size_t)row * DM + col0; float ss = 0.f;
#pragma unroll
                for (int bj = 0; bj < 2; ++bj)
#pragma unroll
                    for (int n = 0; n < 2; ++n) { const size_t o = off + bj * 128 + n * 16; const f32x4 x = xr[m][bj][n] + acc[ai][bj][m][n];
                        *(f32x4*)(xout + o) = x;
                        if (xb) { u32x2 w; w.x = cvt_pk_bf16(x[0], x[1]); w.y = cvt_pk_bf16(x[2], x[3]); *(u32x2*)(xb + o) = w; ss += (x[0] * x[0] + x[1] * x[1]) + (x[2] * x[2] + x[3] * x[3]); } }
                if (xb) { ss += __shfl_xor(ss, 16); ss += __shfl_xor(ss, 32); if (fq == 0) atomicAdd(rowss + row, ss); } }
        }
    }
};

struct EpiFF1 {
    static constexpr bool PERM = true, ACCUM = false;
    bf16_t* O; const float* rowss; int ldc;
    struct Pre { float v[2][4]; };
    __device__ __forceinline__ void pre(Pre& p, const pg8::Unit& u, int wr, int fr) const {
        const int row0 = u.pm * 256 + wr * 64 + fr;
#pragma unroll
        for (int ai = 0; ai < 2; ++ai)
#pragma unroll
            for (int m = 0; m < 4; ++m) p.v[ai][m] = rowss[row0 + ai * 128 + m * 16];
    }
    __device__ __forceinline__ void operator()(f32x4 (&acc)[2][2][4][2], const pg8::Unit& u, int wr, int wc, int fr, int fq, const Pre& p) const {
        const int row0 = u.pm * 256 + wr * 64 + fr, col0 = u.pn * 256 + wc * 32 + 8 * fq;
        float rsv[2][4];
#pragma unroll
        for (int ai = 0; ai < 2; ++ai)
#pragma unroll
            for (int m = 0; m < 4; ++m) rsv[ai][m] = rsqrtf(p.v[ai][m] * (1.f / DM) + EPS);
#pragma unroll
        for (int ai = 0; ai < 2; ++ai)
#pragma unroll
            for (int m = 0; m < 4; ++m) { const int row = row0 + ai * 128 + m * 16; const float r = rsv[ai][m]; bf16_t* rowp = O + (size_t)row * ldc + col0;
#pragma unroll
                for (int bj = 0; bj < 2; ++bj) { f32x4 v0 = acc[ai][bj][m][0] * r, v1 = acc[ai][bj][m][1] * r;
#pragma unroll
                    for (int e = 0; e < 4; ++e) { const float a = __builtin_fmaxf(v0[e], 0.f), b = __builtin_fmaxf(v1[e], 0.f); v0[e] = a * a; v1[e] = b * b; }
                    u32x4 w; w.x = cvt_pk_bf16(v0[0], v0[1]); w.y = cvt_pk_bf16(v0[2], v0[3]); w.z = cvt_pk_bf16(v1[0], v1[1]); w.w = cvt_pk_bf16(v1[2], v1[3]);
                    *(u32x4*)(rowp + bj * 128) = w; } }
    }
};

template <bool INPERM>
__device__ __forceinline__ void transpose_item(const float* W, const float* kscale, int K, int N, bf16_t* WT, LAS float* scr, int item, int lane) {
    const int nblk = N / 32, kb = item / nblk, nb = item % nblk, k0 = 64 * kb, n0 = 32 * nb;
    float v[32];
#pragma unroll
    for (int i = 0; i < 32; ++i) { const int kk = 2 * i + (lane >> 5); v[i] = W[(size_t)(k0 + kk) * N + n0 + (lane & 31)]; }
    if (kscale) {
#pragma unroll
        for (int i = 0; i < 32; ++i) v[i] *= kscale[k0 + 2 * i + (lane >> 5)]; }
#pragma unroll
    for (int i = 0; i < 32; ++i) { const int kk = 2 * i + (lane >> 5); scr[kk * 33 + (lane & 31)] = v[i]; }
    asm volatile("s_waitcnt lgkmcnt(0)" ::: "memory");
    const int c = lane & 7;
    const int r0 = INPERM ? inproj_phys(n0) : n0;
#pragma unroll
    for (int j = 0; j < 4; ++j) { const int n = (lane >> 3) + 8 * j; const LAS float* s = scr + (8 * c) * 33 + n;
        u32x4 o; o.x = cvt_pk_bf16(s[0 * 33], s[1 * 33]); o.y = cvt_pk_bf16(s[2 * 33], s[3 * 33]); o.z = cvt_pk_bf16(s[4 * 33], s[5 * 33]); o.w = cvt_pk_bf16(s[6 * 33], s[7 * 33]);
        *(u32x4*)(WT + (size_t)(r0 + n) * K + k0 + 8 * c) = o; }
    asm volatile("s_waitcnt lgkmcnt(0)" ::: "memory");
}
constexpr int IT_WIN = 16 * 224, IT_BR = 8 * 32, IT_OUT = 16 * 32, IT_F1 = 16 * 128, IT_F2 = 64 * 32;
__device__ __forceinline__ void convert_region_a(const Args& a, int l, LAS unsigned char* lds, int gw, int ngw, int wave, int lane) {
    LAS float* scr = (LAS float*)(lds + wave * 16384);
    unsigned char* ws = a.ws;
    constexpr int NIT = IT_WIN + 3 * IT_BR + IT_OUT;
    for (int it = gw; it < NIT; it += ngw) {
        int r = it;
        if (r < IT_WIN) { transpose_item<true>(a.in[2] + (size_t)l * DM * NIN, a.in[1] + l * DM, DM, NIN, (bf16_t*)(ws + WS_WIN), scr, r, lane); continue; } r -= IT_WIN;
        if (r < 3 * IT_BR) { const int j = r / IT_BR; transpose_item<false>(a.in[12 + j] + (size_t)l * 512 * DM, nullptr, 512, DM, (bf16_t*)(ws + WS_WBR + j * MiB), scr, r % IT_BR, lane); continue; } r -= 3 * IT_BR;
        transpose_item<false>(a.in[15] + (size_t)l * DM * DM, nullptr, DM, DM, (bf16_t*)(ws + WS_WOUT), scr, r, lane);
    }
}
__device__ __forceinline__ void convert_region_b(const Args& a, int l, LAS unsigned char* lds, int gw, int ngw, int wave, int lane) {
    LAS float* scr = (LAS float*)(lds + wave * 16384);
    unsigned char* ws = a.ws;
    constexpr int NIT = IT_F1 + IT_F2;
    for (int it = gw; it < NIT; it += ngw) {
        int r = it;
        if (r < IT_F1) { transpose_item<false>(a.in[17] + (size_t)l * DM * FF, a.in[16] + l * DM, DM, FF, (bf16_t*)(ws + WS_WF1), scr, r, lane); continue; } r -= IT_F1;
        transpose_item<false>(a.in[18] + (size_t)l * FF * DM, nullptr, FF, DM, (bf16_t*)(ws + WS_WF2), scr, r, lane);
    }
}

namespace att {
typedef short bf16x8 __attribute__((ext_vector_type(8)));
typedef short s16x4 __attribute__((ext_vector_type(4)));
typedef short v4i16_t __attribute__((ext_vector_type(4)));
typedef float f32x16 __attribute__((ext_vector_type(16)));
typedef float f32x8 __attribute__((ext_vector_type(8)));
typedef float f32x2_t __attribute__((ext_vector_type(2))); typedef __bf16 bf16x2_t __attribute__((ext_vector_type(2)));
__device__ __forceinline__ unsigned cvtpk_s(float lo, float hi) { f32x2_t v = {lo, hi}; bf16x2_t b = __builtin_convertvector(v, bf16x2_t); return __builtin_bit_cast(unsigned, b); }
__device__ __forceinline__ s16x4 vtr(const LAS unsigned char* p) { return __builtin_bit_cast(s16x4, __builtin_amdgcn_ds_read_tr16_b64_v4i16((LAS v4i16_t*)p)); }
constexpr int KSTR = 144, VSTR = 320, KMAP = 64 * KSTR, V_OFF = 2 * KMAP, BUF = V_OFF + 64 * VSTR;
__device__ __forceinline__ bf16x8 pack8(const f32x16& p, int o) {
    u32x4 w; w.x = cvtpk_s(p[o], p[o + 1]); w.y = cvtpk_s(p[o + 2], p[o + 3]); w.z = cvtpk_s(p[o + 4], p[o + 5]); w.w = cvtpk_s(p[o + 6], p[o + 7]); return __builtin_bit_cast(bf16x8, w); }

__device__ __forceinline__ void attn_unit(bf16_t* PM, bf16_t* obase, int opitch, int b, int h, int qb, float lam, float post, const float* subw, const float* knw, LAS unsigned char* lds, int tid_in) {
    int tid = tid_in; asm volatile("" : "+v"(tid));
    const int lane = tid & 63, wid = __builtin_amdgcn_readfirstlane(tid >> 6), r32 = lane & 31, hi = lane >> 5, m = wid >> 2, qs = wid & 3;
    const int qpos = 128 * qb + 32 * qs + r32;
    bf16_t* base = PM + (size_t)b * SEQ * NPM;
    bf16_t* qrow = base + (size_t)qpos * NPM + C_Q + h * 128;
    bf16_t* orow = obase + (size_t)(b * SEQ + qpos) * opitch + h * 128;
    bf16x8 qr[4];
#pragma unroll
    for (int d0 = 0; d0 < 4; ++d0) qr[d0] = *(const bf16x8*)(qrow + m * 64 + d0 * 16 + hi * 8);
    bool need_check;
    { float qn2 = 0.f;
#pragma unroll
      for (int d0 = 0; d0 < 4; ++d0) { const u32x4 w = __builtin_bit_cast(u32x4, qr[d0]);
          const float a0 = bf_lo(w.x), a1 = bf_hi(w.x), a2 = bf_lo(w.y), a3 = bf_hi(w.y), a4 = bf_lo(w.z), a5 = bf_hi(w.z), a6 = bf_lo(w.w), a7 = bf_hi(w.w);
          qn2 += (a0 * a0 + a1 * a1) + (a2 * a2 + a3 * a3) + (a4 * a4 + a5 * a5) + (a6 * a6 + a7 * a7); }
      qn2 += __shfl_xor(qn2, 32);
      float wk = __builtin_fmaxf(__builtin_fabsf(knw[lane]), __builtin_fabsf(knw[64 + lane]));
#pragma unroll
      for (int o = 1; o < 64; o <<= 1) wk = __builtin_fmaxf(wk, __shfl_xor(wk, o));
      need_check = __any(sqrtf(qn2) * 8.f * wk * 1.02f > 40.f); }
    const int NT = 2 * (qb + 1), my_nt = (qs < 2) ? NT - 1 : NT;
    const float sl2 = __builtin_amdgcn_exp2f(-2.f * (float)(h + 1)) * LOG2E;
    const bf16_t* gk = base + (size_t)(tid >> 3) * NPM + C_K + h * 128 + (tid & 7) * 8;
    const bf16_t* gv = base + (size_t)(tid >> 4) * NPM + C_V + h * 128 + (tid & 15) * 8;
    const int lk = (tid >> 3) * KSTR + (tid & 7) * 16, lv = V_OFF + (tid >> 4) * VSTR + (tid & 15) * 16;
    u32x4 st0, st1, st2, st3;
#define ATT_LOAD(t) do { const size_t ro = (size_t)(t) * 64 * NPM; st0 = *(const u32x4*)(gk + ro); st1 = *(const u32x4*)(gk + ro + 64); st2 = *(const u32x4*)(gv + ro); st3 = *(const u32x4*)(gv + ro + (size_t)32 * NPM); } while (0)
#define ATT_STORE(bufp) do { *(LAS u32x4*)((bufp) + lk) = st0; *(LAS u32x4*)((bufp) + KMAP + lk) = st1; *(LAS u32x4*)((bufp) + lv) = st2; *(LAS u32x4*)((bufp) + lv + 32 * VSTR) = st3; } while (0)
    __syncthreads();
    ATT_LOAD(0); ATT_STORE(lds);
    __syncthreads();
    f32x16 OT[4];
#pragma unroll
    for (int eb = 0; eb < 4; ++eb)
#pragma unroll
        for (int r = 0; r < 16; ++r) OT[eb][r] = 0.f;
    float mref = 0.f, lsum = 0.f;
    const float s64 = 64.f * sl2;
    const float s32 = 32.f * sl2;
    f32x16 ci0;
#pragma unroll
    for (int r = 0; r < 16; ++r) ci0[r] = sl2 * (float)(4 * hi + (r & 3) + 8 * (r >> 2) - qpos);
    for (int t = 0; t < NT; ++t) {
        LAS unsigned char* buf = lds + (t & 1) * BUF;
        if (t + 1 < NT) ATT_LOAD(t + 1);
        if (t < my_nt) {
            const LAS unsigned char* kp = buf + m * KMAP + r32 * KSTR + hi * 16;
            f32x16 p0 = ci0, p1 = ci0 + s32;
            if (t == my_nt - 1) {
                int hid = hi; asm volatile("" : "+v"(hid));
                const float qf = (float)qpos, k0 = (float)(64 * t + 4 * hid), cadd = -mref;
#pragma unroll
                for (int r = 0; r < 16; ++r) { const float kf = k0 + (float)((r & 3) + 8 * (r >> 2));
                    p0[r] = __builtin_fmaf(-sl2, __builtin_fabsf(qf - kf), cadd); p1[r] = __builtin_fmaf(-sl2, __builtin_fabsf(qf - (kf + 32.f)), cadd); }
            }
            bf16x8 ka[4], kb2[4];
#pragma unroll
            for (int d0 = 0; d0 < 4; ++d0) { ka[d0] = *(const LAS bf16x8*)(kp + d0 * 32); kb2[d0] = *(const LAS bf16x8*)(kp + 32 * KSTR + d0 * 32); }
#pragma unroll
            for (int d0 = 0; d0 < 4; ++d0) {
                p0 = __builtin_amdgcn_mfma_f32_32x32x16_bf16(ka[d0], qr[d0], p0, 0, 0, 0);
                p1 = __builtin_amdgcn_mfma_f32_32x32x16_bf16(kb2[d0], qr[d0], p1, 0, 0, 0);
            }
            const LAS unsigned char* vp = buf + V_OFF + (4 * hi + ((lane & 15) >> 2)) * VSTR + ((lane >> 4) & 1) * 32 + (lane & 3) * 8;
            s16x4 vlo[2][4], vhi[2][4];
#pragma unroll
            for (int eb = 0; eb < 4; ++eb) { vlo[0][eb] = vtr(vp + eb * 64); vhi[0][eb] = vtr(vp + 8 * VSTR + eb * 64); }
            float mt = 0.f;
            if (need_check) { mt = __builtin_fmaxf(p0[0], p1[0]);
#pragma unroll
                for (int r = 1; r < 16; ++r) mt = __builtin_fmaxf(__builtin_fmaxf(mt, p0[r]), p1[r]);
                mt = __builtin_fmaxf(mt, __shfl_xor(mt, 32)); }
            if (need_check && __any(mt > 40.f)) {
                const float dl = __builtin_fmaxf(mt, 0.f), f = __builtin_amdgcn_exp2f(-dl);
                mref += dl; lsum *= f; p0 -= dl; p1 -= dl; ci0 -= dl;
#pragma unroll
                for (int eb = 0; eb < 4; ++eb) OT[eb] *= f;
            }
#if PROBE == 13
            { float dz = 0.f;
#pragma unroll
              for (int r = 0; r < 16; ++r) { dz += __builtin_amdgcn_exp2f(p0[r] + 1.f) + __builtin_amdgcn_exp2f(p1[r] + 1.f); }
              asm volatile("" :: "v"(dz)); }
#endif
#if PROBE == 14
            { f32x16 dacc = p0;
#pragma unroll
              for (int d0 = 0; d0 < 4; ++d0) { dacc = __builtin_amdgcn_mfma_f32_32x32x16_bf16(ka[d0], qr[d0], dacc, 0, 0, 0); dacc = __builtin_amdgcn_mfma_f32_32x32x16_bf16(kb2[d0], qr[d0], dacc, 0, 0, 0); }
              asm volatile("" :: "v"(dacc)); }
#endif
#pragma unroll
            for (int r = 0; r < 16; ++r) { p0[r] = __builtin_amdgcn_exp2f(p0[r]); p1[r] = __builtin_amdgcn_exp2f(p1[r]); }
            { const f32x16 s16 = p0 + p1; const f32x8 s8 = s16.lo + s16.hi; const f32x4 s4v = s8.lo + s8.hi; const f32x2_t s2 = s4v.lo + s4v.hi; lsum += s2.x + s2.y; }
            ci0 += s64;
            bf16x8 pf[4]; pf[0] = pack8(p0, 0); pf[1] = pack8(p0, 8); pf[2] = pack8(p1, 0); pf[3] = pack8(p1, 8);
#pragma unroll
            for (int s4 = 0; s4 < 4; ++s4) {
                if (s4 < 3) {
#pragma unroll
                    for (int eb = 0; eb < 4; ++eb) { vlo[(s4 + 1) & 1][eb] = vtr(vp + (16 * (s4 + 1)) * VSTR + eb * 64); vhi[(s4 + 1) & 1][eb] = vtr(vp + (16 * (s4 + 1) + 8) * VSTR + eb * 64); }
                }
#pragma unroll
                for (int eb = 0; eb < 4; ++eb) {
                    const s16x4 a = vlo[s4 & 1][eb], c = vhi[s4 & 1][eb];
                    const bf16x8 vf = (bf16x8){a[0], a[1], a[2], a[3], c[0], c[1], c[2], c[3]};
                    OT[eb] = __builtin_amdgcn_mfma_f32_32x32x16_bf16(vf, pf[s4], OT[eb], 0, 0, 0);
                }
            }
        }
        if (t + 1 < NT) ATT_STORE(lds + ((t + 1) & 1) * BUF);
        __syncthreads();
    }
#undef ATT_LOAD
#undef ATT_STORE
    lsum += __shfl_xor(lsum, 32);
    const float inv = 1.f / lsum;
#pragma unroll
    for (int eb = 0; eb < 4; ++eb)
#pragma unroll
        for (int r = 0; r < 16; ++r) OT[eb][r] *= inv;
    int hif = hi, lanef = lane; asm volatile("" : "+v"(hif), "+v"(lanef));
    LAS float* X = (LAS float*)(lds + qs * 16384) + lanef;
    if (m == 1) {
#pragma unroll
        for (int eb = 0; eb < 4; ++eb)
#pragma unroll
            for (int r = 0; r < 16; ++r) X[(eb * 16 + r) * 64] = OT[eb][r];
    }
    __syncthreads();
    if (m == 0) {
        float ss = 0.f;
#pragma unroll
        for (int eb = 0; eb < 4; ++eb) {
            __builtin_amdgcn_sched_barrier(0);
#pragma unroll
            for (int r = 0; r < 16; ++r) { const float o = OT[eb][r] - lam * X[(eb * 16 + r) * 64]; OT[eb][r] = o; ss += o * o; } }
        __builtin_amdgcn_sched_barrier(0);
        ss += __shfl_xor(ss, 32);
        const float rn = rsqrtf(ss * (1.f / 128.f) + EPS) * post;
        f32x4 w4a[4][4];
#pragma unroll
        for (int eb = 0; eb < 4; ++eb)
#pragma unroll
            for (int rg = 0; rg < 4; ++rg) w4a[eb][rg] = *(const f32x4*)(subw + 32 * eb + 8 * rg + 4 * hif);
#pragma unroll
        for (int eb = 0; eb < 4; ++eb)
#pragma unroll
            for (int rg = 0; rg < 4; ++rg) { const int e = 32 * eb + 8 * rg + 4 * hif; const f32x4 w4 = w4a[eb][rg];
                u32x2 w; w.x = cvtpk_s(OT[eb][4 * rg] * rn * w4[0], OT[eb][4 * rg + 1] * rn * w4[1]); w.y = cvtpk_s(OT[eb][4 * rg + 2] * rn * w4[2], OT[eb][4 * rg + 3] * rn * w4[3]);
                *(u32x2*)(orow + e) = w; }
    }
}
}

__device__ __forceinline__ void gmlp_unit(bf16_t* PM, bf16_t* obase, int opitch, const float* avss, const float* vnw, const float* ws_g, const float* bs_g, int rowbase, int g, LAS unsigned char* lds, int tid) {
    constexpr int VSTR = 320, WSTR = 272, W_OFF = 128 * VSTR;
    const int lane = tid & 63, wid = __builtin_amdgcn_readfirstlane(tid >> 6), r32 = lane & 31, hi = lane >> 5;
    __syncthreads();
    {
        const int row = tid >> 2, part = tid & 3;
        const bf16_t* rp = PM + (size_t)(rowbase + row) * NPM + C_AV;
        const float r = rsqrtf(avss[rowbase + row] * (1.f / 512.f) + EPS);
        const int c0 = part * 32;
#pragma unroll
        for (int i = 0; i < 4; ++i) { const u32x4 w = *(const u32x4*)(rp + g * 128 + c0 + i * 8); const float* nw = vnw + g * 128 + c0 + i * 8;
            const f32x4 n0 = *(const f32x4*)nw, n1 = *(const f32x4*)(nw + 4); u32x4 o;
            o.x = att::cvtpk_s(bf_lo(w.x) * r * n0[0], bf_hi(w.x) * r * n0[1]); o.y = att::cvtpk_s(bf_lo(w.y) * r * n0[2], bf_hi(w.y) * r * n0[3]);
            o.z = att::cvtpk_s(bf_lo(w.z) * r * n1[0], bf_hi(w.z) * r * n1[1]); o.w = att::cvtpk_s(bf_lo(w.w) * r * n1[2], bf_hi(w.w) * r * n1[3]);
            *(LAS u32x4*)(lds + row * VSTR + (c0 + i * 8) * 2) = o; }
#pragma unroll
        for (int i = 0; i < 4; ++i) { const int e8 = (i * 512 + tid) * 8, t = e8 >> 7, s0 = e8 & 127; f32x4 a = *(const f32x4*)(ws_g + e8), b = *(const f32x4*)(ws_g + e8 + 4);
#pragma unroll
            for (int e = 0; e < 4; ++e) { if (s0 + e > t) a[e] = 0.f; if (s0 + 4 + e > t) b[e] = 0.f; }
            u32x4 o; o.x = att::cvtpk_s(a[0], a[1]); o.y = att::cvtpk_s(a[2], a[3]); o.z = att::cvtpk_s(b[0], b[1]); o.w = att::cvtpk_s(b[2], b[3]);
            *(LAS u32x4*)(lds + W_OFF + t * WSTR + s0 * 2) = o; }
    }
    __syncthreads();
    const int cb = wid & 3;
    const LAS unsigned char* vp = lds + (8 * hi + ((lane & 15) >> 2)) * VSTR + (32 * cb + 16 * ((lane >> 4) & 1) + 4 * (lane & 3)) * 2;
#pragma unroll
    for (int pass = 0; pass < 2; ++pass) {
        const int tb = pass == 0 ? (wid >> 2) : 3 - (wid >> 2);
        att::f32x16 acc;
#pragma unroll
        for (int r = 0; r < 16; ++r) acc[r] = 0.f;
        const LAS unsigned char* wp = lds + W_OFF + (32 * tb + r32) * WSTR + hi * 16;
        const int nk = 2 * (tb + 1);
        for (int kk = 0; kk < nk; ++kk) {
            const att::s16x4 vlo = att::vtr(vp + (16 * kk) * VSTR), vhi = att::vtr(vp + (16 * kk + 4) * VSTR);
            const att::bf16x8 A = (att::bf16x8){vlo[0], vlo[1], vlo[2], vlo[3], vhi[0], vhi[1], vhi[2], vhi[3]};
            const att::bf16x8 B = *(const LAS att::bf16x8*)(wp + kk * 32);
            acc = __builtin_amdgcn_mfma_f32_32x32x16_bf16(A, B, acc, 0, 0, 0);
        }
        const int t = 32 * tb + r32; const float bsv = bs_g[t];
        u32x2 uua[4];
#pragma unroll
        for (int rg = 0; rg < 4; ++rg) uua[rg] = *(const u32x2*)(PM + (size_t)(rowbase + t) * NPM + C_AU + g * 128 + 32 * cb + 8 * rg + 4 * hi);
#pragma unroll
        for (int rg = 0; rg < 4; ++rg) { const int c = 32 * cb + 8 * rg + 4 * hi;
            const u32x2 uu = uua[rg];
            u32x2 o; o.x = att::cvtpk_s(bf_lo(uu.x) * (acc[4 * rg] + bsv), bf_hi(uu.x) * (acc[4 * rg + 1] + bsv)); o.y = att::cvtpk_s(bf_lo(uu.y) * (acc[4 * rg + 2] + bsv), bf_hi(uu.y) * (acc[4 * rg + 3] + bsv));
            *(u32x2*)(obase + (size_t)(rowbase + t) * opitch + g * 128 + c) = o; }
    }
}

__device__ __forceinline__ void conv_items(bf16_t* PM, bf16_t* obase, int opitch, const float* cw, int gtid, int gthreads) {
    const int c0 = (gtid & 63) * 8;
    float cwv[3][8];
#pragma unroll
    for (int j = 0; j < 3; ++j)
#pragma unroll
        for (int e = 0; e < 8; ++e) cwv[j][e] = cw[j * 512 + c0 + e];
    for (int idx = gtid; idx < M * 64; idx += 4 * gthreads) {
        u32x4 A[4][3], B[4][3], CB[4];
#pragma unroll
        for (int u = 0; u < 4; ++u) { const int i = (idx + u * gthreads < M * 64) ? idx + u * gthreads : idx; const int row = i >> 6, spos = row & (SEQ - 1);
            const bf16_t* rp = PM + (size_t)row * NPM;
#pragma unroll
            for (int j = 0; j < 3; ++j) { const int dt = (spos >= 2 - j) ? 2 - j : 0; A[u][j] = *(const u32x4*)(rp - (size_t)dt * NPM + C_CC + c0); B[u][j] = *(const u32x4*)(rp - (size_t)dt * NPM + C_CX + c0); }
            CB[u] = *(const u32x4*)(rp + C_CB + c0); }
#pragma unroll
        for (int u = 0; u < 4; ++u) { const int i = idx + u * gthreads; if (i < M * 64) { const int row = i >> 6, spos = row & (SEQ - 1);
            float y[8];
#pragma unroll
            for (int e = 0; e < 8; ++e) y[e] = 0.f;
#pragma unroll
            for (int j = 0; j < 3; ++j) { const float mk = (spos >= 2 - j) ? 1.f : 0.f; const u32x4 a = A[u][j], b2 = B[u][j];
                y[0] += mk * cwv[j][0] * (bf_lo(a.x) * bf_lo(b2.x)); y[1] += mk * cwv[j][1] * (bf_hi(a.x) * bf_hi(b2.x)); y[2] += mk * cwv[j][2] * (bf_lo(a.y) * bf_lo(b2.y)); y[3] += mk * cwv[j][3] * (bf_hi(a.y) * bf_hi(b2.y));
                y[4] += mk * cwv[j][4] * (bf_lo(a.z) * bf_lo(b2.z)); y[5] += mk * cwv[j][5] * (bf_hi(a.z) * bf_hi(b2.z)); y[6] += mk * cwv[j][6] * (bf_lo(a.w) * bf_lo(b2.w)); y[7] += mk * cwv[j][7] * (bf_hi(a.w) * bf_hi(b2.w)); }
            const u32x4 cb = CB[u];
            u32x4 w; w.x = cvt_pk_bf16(bf_lo(cb.x) * y[0], bf_hi(cb.x) * y[1]); w.y = cvt_pk_bf16(bf_lo(cb.y) * y[2], bf_hi(cb.y) * y[3]);
            w.z = cvt_pk_bf16(bf_lo(cb.z) * y[4], bf_hi(cb.z) * y[5]); w.w = cvt_pk_bf16(bf_lo(cb.w) * y[6], bf_hi(cb.w) * y[7]);
            *(u32x4*)(obase + (size_t)row * opitch + c0) = w; } }
    }
}

constexpr int N_PHASES = 1 + 6 * DEPTH;
__global__ void __launch_bounds__(NWAVES * 64, 2) fwd_kernel(Args args) {
    extern __shared__ __attribute__((aligned(16))) unsigned char lds_raw[];
    LAS unsigned char* lds = (LAS unsigned char*)lds_raw;
    const int G = gridDim.x, bx = blockIdx.x, ngw = G * NWAVES, gthreads = G * NWAVES * 64;
#define TIDS() int tid_ = threadIdx.x; asm volatile("" : "+v"(tid_)); const int tid = tid_, lane = tid & 63, wave = __builtin_amdgcn_readfirstlane(tid >> 6), gw = bx * NWAVES + wave, gtid = bx * (NWAVES * 64) + tid; (void)lane; (void)gw; (void)gtid
    unsigned char* ws = args.ws;
    float* ROWSS = (float*)(ws + WS_CTL);
    bf16_t* XB = (bf16_t*)(ws + WS_XB); bf16_t* PM = (bf16_t*)(ws + WS_PM); bf16_t* XBM = (bf16_t*)(ws + WS_PM); bf16_t* HB = (bf16_t*)(ws + WS_HB);
    unsigned char* G8 = ws + WS_G8;
    const int lo = args.ph_lo, hi = args.ph_hi;
#if !MK_MULTI
    cg::grid_group grid = cg::this_grid();
    volatile LAS unsigned* bst = (volatile LAS unsigned*)(lds + RING_BYTES + 512);
    if (threadIdx.x < 2) bst[threadIdx.x] = 0u;
    __syncthreads();
    const XcdBarrier xbar = xcd_barrier_post((unsigned*)(ws + WS_BAR), bst);
#define SEAM(ph) do { if ((ph) + 1 < hi) { if (PROBE != 12 && hi > 1000) grid.sync();   xcd_barrier(xbar); if (PROBE == 6) { xcd_barrier(xbar); xcd_barrier(xbar); } } } while (0)
#else
#define SEAM(ph) do { } while (0)
#endif
#define IN(k) (lo <= (k) && (k) < hi)
#if PROBE >= 20
    unsigned long long tp_acc = 0, tp_t0 = 0;
#define TP_BEGIN(type) do { if (PROBE - 20 == (type)) tp_t0 = __builtin_amdgcn_s_memrealtime(); } while (0)
#define TP_END(type) do { if (PROBE - 20 == (type)) tp_acc += __builtin_amdgcn_s_memrealtime() - tp_t0; } while (0)
#else
#define TP_BEGIN(type) do { } while (0)
#define TP_END(type) do { } while (0)
#endif

    TP_BEGIN(0);
    if (IN(0)) {
        TIDS();
        for (int rep = 0; rep < (PROBE == 1 ? 2 : 1); ++rep) {
        convert_region_a(args, 0, lds, gw, ngw, wave, lane);
        convert_region_b(args, 0, lds, gw, ngw, wave, lane); }
        const float* x = args.in[0];
        for (int r = gw; r < M; r += 2 * ngw) {
            const int r2 = (r + ngw < M) ? r + ngw : r;
            const f32x4* xr = (const f32x4*)(x + (size_t)r * DM) + lane; const f32x4* xr2 = (const f32x4*)(x + (size_t)r2 * DM) + lane;
            f32x4 va[4], vb[4];
#pragma unroll
            for (int j = 0; j < 4; ++j) { va[j] = xr[64 * j]; vb[j] = xr2[64 * j]; }
            u32x2* o = (u32x2*)(XB + (size_t)r * DM) + lane; u32x2* o2 = (u32x2*)(XB + (size_t)r2 * DM) + lane; float s = 0.f, s2 = 0.f;
#pragma unroll
            for (int j = 0; j < 4; ++j) { const f32x4 v = va[j]; s += (v[0] * v[0] + v[1] * v[1]) + (v[2] * v[2] + v[3] * v[3]); u32x2 w; w.x = cvt_pk_bf16(v[0], v[1]); w.y = cvt_pk_bf16(v[2], v[3]); o[64 * j] = w;
                const f32x4 q = vb[j]; s2 += (q[0] * q[0] + q[1] * q[1]) + (q[2] * q[2] + q[3] * q[3]); u32x2 w2; w2.x = cvt_pk_bf16(q[0], q[1]); w2.y = cvt_pk_bf16(q[2], q[3]); o2[64 * j] = w2; }
            s = wave_sum(s); s2 = wave_sum(s2); if (lane == 0) { ROWSS[r] = s; ROWSS[r2] = s2; }
        }
        SEAM(0);
    }
    TP_END(0);
    for (int l = 0; l < DEPTH; ++l) {
        const int pb = 1 + 6 * l;
        const float* xres_in = (l == 0) ? args.in[0] : args.out;
        TP_BEGIN(1);
        if (IN(pb + 0)) {
            pg8::Gemm g{XB, (const bf16_t*)(ws + WS_WIN), DM, DM, 0, 0, 0}; pg8::StaticOrder S; S.init(M, NIN, G, bx, 1, WGM_IN);
            EpiInProj E{PM, G8, ROWSS + (size_t)(2 * l) * M, args.in[3] + l * NG, args.in[7] + l * 128, args.in[8] + l * 128, ROWSS + (size_t)(4 + l) * M};
            pg8::gemm_phase<EpiInProj, pg8::StaticOrder>(lds, g, S, E);
#if PROBE == 2
            pg8::gemm_phase<EpiInProj, pg8::StaticOrder>(lds, g, S, E);
#endif
            SEAM(pb + 0);
        }
        TP_END(1);
        TP_BEGIN(2);
        if (IN(pb + 1)) {
            TIDS();
            if (l == 1) convert_region_b(args, 1, lds, gw, ngw, wave, lane);
            const float* lp = args.in[9] + l * 256;
            const float sa = wave_sum(lp[lane] * lp[64 + lane]), sb = wave_sum(lp[128 + lane] * lp[192 + lane]);
            const float lam_init = 0.8f - 0.6f * expf(-0.3f * (float)l);
            const float lam = expf(sa) - expf(sb) + lam_init;
#if PROBE == 4
            for (int pi = bx; pi < 256; pi += G) { const int bh = pi >> 4, sq = pi & 15;
                att::attn_unit(PM, XB, DM, bh >> 2, bh & 3, 31 - sq, lam, 1.f - lam_init, args.in[10] + l * 128, args.in[8] + l * 128, lds, tid);
                att::attn_unit(PM, XB, DM, bh >> 2, bh & 3, sq, lam, 1.f - lam_init, args.in[10] + l * 128, args.in[8] + l * 128, lds, tid); }
#endif
            for (int pi = bx; pi < 256; pi += G) { const int bh = pi >> 4, sq = pi & 15;
                att::attn_unit(PM, PM + C_Q, NPM, bh >> 2, bh & 3, 31 - sq, lam, 1.f - lam_init, args.in[10] + l * 128, args.in[8] + l * 128, lds, tid);
                att::attn_unit(PM, PM + C_Q, NPM, bh >> 2, bh & 3, sq, lam, 1.f - lam_init, args.in[10] + l * 128, args.in[8] + l * 128, lds, tid); }
#if PROBE == 5
            for (int uu = bx; uu < 512; uu += G) { const int g4 = uu & 3, blk = uu >> 2;
                gmlp_unit(PM, XB, DM, ROWSS + (size_t)(4 + l) * M, args.in[4] + l * 512, args.in[5] + (size_t)(l * 4 + g4) * 16384, args.in[6] + (l * 4 + g4) * 128, blk * 128, g4, lds, tid); }
#endif
            for (int uu = bx; uu < 512; uu += G) { const int g4 = uu & 3, blk = uu >> 2;
                gmlp_unit(PM, PM + C_AU, NPM, ROWSS + (size_t)(4 + l) * M, args.in[4] + l * 512, args.in[5] + (size_t)(l * 4 + g4) * 16384, args.in[6] + (l * 4 + g4) * 128, blk * 128, g4, lds, tid); }
#if PROBE == 8
            conv_items(PM, XB, DM, args.in[11] + l * 1536, gtid, gthreads);
#endif
            conv_items(PM, PM + C_CB, NPM, args.in[11] + l * 1536, gtid, gthreads);
            SEAM(pb + 1);
        }
        TP_END(2);
        TP_BEGIN(3);
        if (IN(pb + 2)) {
            pg8::Gemm g{PM + C_AU, (const bf16_t*)(ws + WS_WBR), NPM, 512, (size_t)(C_Q - C_AU) * 2, (size_t)(C_CB - C_AU) * 2, MiB}; pg8::StaticOrder S; S.init(M, DM, G, bx, 3, WGM_N1);
            EpiBranch E{XB, G8};
            pg8::gemm_phase<EpiBranch, pg8::StaticOrder>(lds, g, S, E);
#if PROBE == 7
            pg8::gemm_phase<EpiBranch, pg8::StaticOrder>(lds, g, S, E);
#endif
            SEAM(pb + 2);
        }
        TP_END(3);
        TP_BEGIN(4);
        if (IN(pb + 3)) {
            pg8::Gemm g{XB, (const bf16_t*)(ws + WS_WOUT), DM, DM, 0, 0, 0}; pg8::StaticOrder S; S.init(M, DM, G, bx, 1, WGM_N1);
            EpiResid E{xres_in, args.out, XBM, ROWSS + (size_t)(2 * l + 1) * M};
#if PROBE == 9
            { EpiResid E2{args.in[0], (float*)(ws + WS_HB), nullptr, nullptr}; pg8::gemm_phase<EpiResid, pg8::StaticOrder>(lds, g, S, E2); }
#endif
            pg8::gemm_phase<EpiResid, pg8::StaticOrder>(lds, g, S, E);
            SEAM(pb + 3);
        }
        TP_END(4);
        TP_BEGIN(5);
        if (IN(pb + 4)) {
            if (l == 0) { TIDS(); convert_region_a(args, 1, lds, gw, ngw, wave, lane); }
            __syncthreads();
            pg8::Gemm g{XBM, (const bf16_t*)(ws + WS_WF1), DM, DM, 0, 0, 0}; pg8::StaticOrder S; S.init(M, FF, G, bx, 1, WGM_FF);
            EpiFF1 E{HB, ROWSS + (size_t)(2 * l + 1) * M, FF};
            pg8::gemm_phase<EpiFF1, pg8::StaticOrder>(lds, g, S, E);
#if PROBE == 3
            pg8::gemm_phase<EpiFF1, pg8::StaticOrder>(lds, g, S, E);
#endif
            SEAM(pb + 4);
        }
        TP_END(5);
        TP_BEGIN(6);
        if (IN(pb + 5)) {
            pg8::Gemm g{HB, (const bf16_t*)(ws + WS_WF2), FF, FF, 0, 0, 0}; pg8::StaticOrder S; S.init(M, DM, G, bx, 1, WGM_N1);
            EpiResid E{args.out, args.out, (l + 1 < DEPTH) ? XB : nullptr, ROWSS + (size_t)(2 * l + 2 < 4 ? 2 * l + 2 : 0) * M};
#if PROBE == 10
            { EpiFF1 E2{XBM, ROWSS + (size_t)(2 * l + 1) * M, DM}; pg8::gemm_phase<EpiFF1, pg8::StaticOrder>(lds, g, S, E2); }
#endif
            pg8::gemm_phase<EpiResid, pg8::StaticOrder>(lds, g, S, E);
            SEAM(pb + 5);
        }
        TP_END(6);
    }
#if PROBE >= 20
    if (blockIdx.x == 0 && threadIdx.x == 0) { const unsigned long long tb = __builtin_amdgcn_s_memrealtime(); while (__builtin_amdgcn_s_memrealtime() - tb < 4 * tp_acc) __builtin_amdgcn_s_sleep(8); }
#endif
#undef IN
#undef SEAM
}

extern "C" void kernel_launch(void* const* d_in, const int* in_sizes, int n_in, void* d_out, int out_size, void* d_ws, size_t ws_size, hipStream_t stream) {
    static int grid = 0;
    if (grid == 0) {
        if (n_in != 19 || in_sizes[0] != M * DM || out_size != M * DM || ws_size < WS_END) { fprintf(stderr, "kernel_launch: unexpected shapes / workspace (%d inputs, ws %zu)\n", n_in, ws_size); grid = -1; return; }
        int dev = 0, cus = 0, per_cu = 0;
        if (hipGetDevice(&dev) != hipSuccess || hipDeviceGetAttribute(&cus, hipDeviceAttributeMultiprocessorCount, dev) != hipSuccess) { grid = -1; return; }
        if (hipFuncSetAttribute((const void*)fwd_kernel, hipFuncAttributeMaxDynamicSharedMemorySize, LDS_BYTES) != hipSuccess) { fprintf(stderr, "kernel_launch: hipFuncSetAttribute failed\n"); grid = -1; return; }
        if (hipOccupancyMaxActiveBlocksPerMultiprocessor(&per_cu, (const void*)fwd_kernel, NWAVES * 64, LDS_BYTES) != hipSuccess || per_cu < 1) { fprintf(stderr, "kernel_launch: occupancy query says %d blocks per CU\n", per_cu); grid = -1; return; }
        grid = cus;
    }
    if (grid < 0) return;
    (void)hipMemsetAsync((char*)d_ws + WS_CTL, 0, CTL_BYTES, stream);
#if PROBE == 11
    (void)hipMemsetAsync((char*)d_ws + WS_END, 0, CTL_BYTES, stream);
    (void)hipMemsetAsync((char*)d_ws + WS_END + CTL_BYTES, 0, CTL_BYTES, stream);
#endif
    Args a{};
    for (int i = 0; i < 19; ++i) a.in[i] = (const float*)d_in[i];
    a.out = (float*)d_out; a.ws = (unsigned char*)d_ws;
#if MK_MULTI
    for (int p = 0; p < N_PHASES; ++p) { a.ph_lo = p; a.ph_hi = p + 1; hipLaunchKernelGGL(fwd_kernel, dim3(grid), dim3(NWAVES * 64), LDS_BYTES, stream, a); }
#else
    a.ph_lo = 0; a.ph_hi = N_PHASES;
    void* kargs[] = {&a};
#if PROBE == 12
    (void)kargs; hipLaunchKernelGGL(fwd_kernel, dim3(grid), dim3(NWAVES * 64), LDS_BYTES, stream, a); hipError_t e = hipSuccess;
#else
    hipError_t e = hipLaunchCooperativeKernel((const void*)fwd_kernel, dim3(grid), dim3(NWAVES * 64), kargs, LDS_BYTES, stream);
#endif
    if (e != hipSuccess) fprintf(stderr, "kernel_launch: cooperative launch failed: %s (grid %d)\n", hipGetErrorString(e), grid);
#endif
}
```

```cpp
#include <hip/hip_runtime.h>
#include <hip/hip_cooperative_groups.h>
#include <cstdio>
#include <cstdint>
namespace cg = cooperative_groups;

#ifndef PROBE
#define PROBE 0
#endif
#ifndef WGM_IN
#define WGM_IN 2
#endif
#ifndef WGM_FF
#define WGM_FF 2
#endif
#ifndef WGM_N1
#define WGM_N1 4
#endif
#ifndef MK_MULTI
#define MK_MULTI 0
#endif

namespace pg8 {
#define PG8_LAS __attribute__((address_space(3)))
typedef unsigned short bf16_t;
typedef short bf16x8 __attribute__((ext_vector_type(8)));
typedef float f32x4 __attribute__((ext_vector_type(4)));
typedef unsigned u32x4 __attribute__((ext_vector_type(4)));
typedef unsigned u32x2 __attribute__((ext_vector_type(2)));
constexpr int BM = 256, BK = 64, HALF = 128, HTB = HALF * BK * 2, STAGE_BYTES = 8 * HTB, NXCD = 8;

__host__ __device__ __forceinline__ int lds_byte(int r, int c) { const int st = (r >> 4) * 2 + (c >> 5), rr = r & 15, cc = c & 31, ob = rr * 64 + cc * 2; return st * 1024 + (ob ^ (((ob >> 9) & 1) << 5)); }
__host__ __device__ __forceinline__ void stage_rc(int b, int& R, int& C) { const int st = b / 1024, sb = b % 1024, swz = sb ^ (((sb >> 9) & 1) << 5); R = (st >> 1) * 16 + swz / 64; C = (st & 1) * 32 + (swz % 64) / 2; }
__host__ __device__ __forceinline__ int perm32(int rho) { const int n = rho >> 4, i = rho & 15; return 8 * (i >> 2) + 4 * n + (i & 3); }

struct Unit { int pm, pn, j; };
struct Gemm { const bf16_t* A; const bf16_t* Bt; int lda, K; size_t a_j1, a_j2, b_j;
    __device__ __forceinline__ size_t aoff(int j) const { return j == 0 ? (size_t)0 : (j == 1 ? a_j1 : a_j2); } };

struct StaticOrder {
    int nM, nN, nwg, G, c, NJ, WGM;
    __host__ __device__ void init(int M, int N, int G_, int c_, int NJ_ = 1, int WGM_ = 4) { nM = M / BM; nN = N / BM; nwg = nM * nN; G = G_; c = c_; NJ = NJ_; WGM = WGM_; }
    __host__ __device__ bool next(int i, Unit& u) const {
        const int ti = i / NJ; u.j = i - ti * NJ;
        const long L = (long)ti * G + c; if (L >= nwg) return false;
        int wgid = (int)L; { const int q = nwg / NXCD, r = nwg % NXCD, xcd = wgid % NXCD, off = wgid / NXCD; wgid = (xcd < r ? xcd * (q + 1) : r * (q + 1) + (xcd - r) * q) + off; }
        const int nig = WGM * nN, gid = wgid / nig, fm = gid * WGM, gsz = (nM - fm) < WGM ? (nM - fm) : WGM;
        u.pm = fm + ((wgid % nig) % gsz); u.pn = (wgid % nig) / gsz; return true;
    }
};

__device__ __forceinline__ unsigned cvt_pk_bf16(float lo, float hi) { unsigned r; asm volatile("v_cvt_pk_bf16_f32 %0, %1, %2" : "=v"(r) : "v"(lo), "v"(hi)); return r; }

template <class Epi, class Sched>
__device__ __forceinline__ void gemm_phase(PG8_LAS unsigned char* lds, const Gemm g, const Sched& S, const Epi& E) {
    int tid_ = threadIdx.x; asm volatile("" : "+v"(tid_));
    const int tid = tid_, wid = __builtin_amdgcn_readfirstlane(tid >> 6), lane = tid & 63, wr = wid >> 2, wc = wid & 3, fr = lane & 15, fq = lane >> 4;
    const int K = g.K, nt = K / BK, lda = g.lda;
    unsigned voffA[2], voffB[2];
#pragma unroll
    for (int i = 0; i < 2; ++i) { int R, C; stage_rc(tid * 16 + i * 8192, R, C); const int Rb = Epi::PERM ? ((R & ~31) + perm32(R & 31)) : R;
        voffA[i] = (unsigned)(R * lda + C) * 2u; voffB[i] = (unsigned)(Rb * K + C) * 2u; }
    const size_t kstep = (size_t)(BK * 2);
    const size_t hstepA = (size_t)HALF * lda * 2, hstepB = (size_t)HALF * K * 2;
    const size_t tstepA = 2 * hstepA, tstepB = 2 * hstepB;
    const unsigned ldsw = (unsigned)wid * 1024u;
    const int aoff = lds_byte(wr * 64 + fr, fq * 8), boff = lds_byte(wc * 32 + fr, fq * 8);
#define PG8_SA(b, h) (((b) * 2 + (h)) * HTB)
#define PG8_SB(b, h) ((4 + (b) * 2 + (h)) * HTB)
#define PG8_STAGE(bufoff, gbase, voff) do { _Pragma("unroll") for (int _i = 0; _i < 2; ++_i) \
        __builtin_amdgcn_global_load_lds((const unsigned*)((const char*)(gbase) + (voff)[_i]), (PG8_LAS unsigned*)(lds + (bufoff) + ldsw + _i * 8192), 16, 0, 0); } while (0)
#define PG8_LDA(dst, b, h) do { _Pragma("unroll") for (int m = 0; m < 4; ++m) _Pragma("unroll") for (int k = 0; k < 2; ++k) dst[m][k] = *(const PG8_LAS bf16x8*)(lds + PG8_SA(b, h) + aoff + m * 2048 + k * 1024); } while (0)
#define PG8_LDB(dst, b, h) do { _Pragma("unroll") for (int n = 0; n < 2; ++n) _Pragma("unroll") for (int k = 0; k < 2; ++k) dst[n][k] = *(const PG8_LAS bf16x8*)(lds + PG8_SB(b, h) + boff + n * 2048 + k * 1024); } while (0)
#define PG8_MMA(ai, bj, At, Bt) do { __builtin_amdgcn_s_setprio(1); _Pragma("unroll") for (int m = 0; m < 4; ++m) _Pragma("unroll") for (int n = 0; n < 2; ++n) _Pragma("unroll") for (int k = 0; k < 2; ++k) \
        acc[ai][bj][m][n] = __builtin_amdgcn_mfma_f32_16x16x32_bf16(Bt[n][k], At[m][k], acc[ai][bj][m][n], 0, 0, 0); __builtin_amdgcn_s_setprio(0); } while (0)
#define PG8_WAIT_V(n) asm volatile("s_waitcnt vmcnt(" #n ")" ::: "memory")
#define PG8_WAIT_L(n) asm volatile("s_waitcnt lgkmcnt(" #n ")" ::: "memory")
#define PG8_BAR __builtin_amdgcn_s_barrier()
#define PG8_SCHED __builtin_amdgcn_sched_barrier(0)
    Unit cur, nxt; int ui = 0;
    if (!S.next(0, cur)) return;
    typename Epi::Pre epre;
    f32x4 acc[2][2][4][2];
#pragma unroll
    for (int a = 0; a < 2; ++a)
#pragma unroll
        for (int b = 0; b < 2; ++b)
#pragma unroll
            for (int m = 0; m < 4; ++m)
#pragma unroll
                for (int n = 0; n < 2; ++n) acc[a][b][m][n] = (f32x4){0.f, 0.f, 0.f, 0.f};
    bf16x8 At[4][2], B0[2][2], B1[2][2];
    const char* cA = (const char*)g.A + (size_t)cur.pm * tstepA + g.aoff(cur.j); const char* cB = (const char*)g.Bt + (size_t)cur.pn * tstepB + (size_t)cur.j * g.b_j;
    {
        PG8_STAGE(PG8_SB(0, 0), cB, voffB); PG8_STAGE(PG8_SB(0, 1), cB + hstepB, voffB); PG8_STAGE(PG8_SA(0, 0), cA, voffA); PG8_STAGE(PG8_SA(0, 1), cA + hstepA, voffA);
        if (wr == 1) PG8_BAR;
        PG8_WAIT_V(2); PG8_BAR;
        PG8_STAGE(PG8_SB(1, 0), cB + kstep, voffB); PG8_STAGE(PG8_SA(1, 0), cA + kstep, voffA); PG8_STAGE(PG8_SB(1, 1), cB + hstepB + kstep, voffB);
        PG8_WAIT_V(6); PG8_BAR;
    }
    for (;;) {
        const bool has_next = S.next(ui + 1, nxt);
        const char* nA = has_next ? (const char*)g.A + (size_t)nxt.pm * tstepA + g.aoff(nxt.j) : cA; const char* nB = has_next ? (const char*)g.Bt + (size_t)nxt.pn * tstepB + (size_t)nxt.j * g.b_j : cB;
        for (int t = 0; t < nt; t += 2) {
            const bool last = (t == nt - 2);
            if (last) E.pre(epre, cur, wr, fr);
            const char* a1 = cA + (size_t)(t + 1) * kstep;
            const char* a2 = last ? nA : cA + (size_t)(t + 2) * kstep; const char* b2 = last ? nB : cB + (size_t)(t + 2) * kstep;
            const char* a3 = a2 + kstep; const char* b3 = b2 + kstep;
            PG8_LDB(B0, 0, 0); PG8_LDB(B1, 0, 1); PG8_SCHED; PG8_LDA(At, 0, 0); PG8_STAGE(PG8_SA(1, 1), a1 + hstepA, voffA);
            PG8_WAIT_V(8); PG8_WAIT_L(0); PG8_BAR; PG8_MMA(0, 0, At, B0); PG8_MMA(0, 1, At, B1); PG8_BAR; PG8_SCHED;
            PG8_LDA(At, 0, 1); PG8_STAGE(PG8_SB(0, 0), b2, voffB); PG8_STAGE(PG8_SB(0, 1), b2 + hstepB, voffB); PG8_STAGE(PG8_SA(0, 0), a2, voffA);
            PG8_WAIT_V(8); PG8_WAIT_L(0); PG8_BAR; PG8_MMA(1, 0, At, B0); PG8_MMA(1, 1, At, B1); PG8_BAR; PG8_SCHED;
            PG8_LDB(B0, 1, 0); PG8_LDB(B1, 1, 1); PG8_SCHED; PG8_LDA(At, 1, 0); PG8_STAGE(PG8_SA(0, 1), a2 + hstepA, voffA);
            PG8_WAIT_V(8); PG8_WAIT_L(0); PG8_BAR; PG8_MMA(0, 0, At, B0); PG8_MMA(0, 1, At, B1); PG8_BAR; PG8_SCHED;
            PG8_LDA(At, 1, 1); PG8_STAGE(PG8_SB(1, 0), b3, voffB); PG8_STAGE(PG8_SB(1, 1), b3 + hstepB, voffB); PG8_STAGE(PG8_SA(1, 0), a3, voffA);
            PG8_WAIT_V(8); PG8_WAIT_L(0); PG8_BAR; PG8_MMA(1, 0, At, B0); PG8_MMA(1, 1, At, B1); PG8_BAR; PG8_SCHED;
        }
        if (wr == 0) PG8_BAR;
        E(acc, cur, wr, wc, fr, fq, epre);
        if (!has_next) break;
        if (!(Epi::ACCUM && nxt.j != 0)) {
#pragma unroll
        for (int a = 0; a < 2; ++a)
#pragma unroll
            for (int b = 0; b < 2; ++b)
#pragma unroll
                for (int m = 0; m < 4; ++m)
#pragma unroll
                    for (int n = 0; n < 2; ++n) acc[a][b][m][n] = (f32x4){0.f, 0.f, 0.f, 0.f};
        }
        cur = nxt; cA = nA; cB = nB; ++ui;
        if (wr == 1) PG8_BAR;
    }
    PG8_WAIT_V(0);
    PG8_BAR;
#undef PG8_SA
#undef PG8_SB
#undef PG8_STAGE
#undef PG8_LDA
#undef PG8_LDB
#undef PG8_MMA
#undef PG8_WAIT_V
#undef PG8_WAIT_L
#undef PG8_BAR
#undef PG8_SCHED
}
}

using pg8::bf16_t; using pg8::f32x4; using pg8::u32x4; using pg8::u32x2; using pg8::cvt_pk_bf16;
#define LAS __attribute__((address_space(3)))

constexpr int DM = 1024, NB = 4, SEQ = 4096, M = NB * SEQ, DEPTH = 2;
constexpr int NIN = 7168, NPM = 4096, NG = 3072, FF = 4096;
constexpr int C_AU = 0, C_AV = 512, C_Q = 1024, C_K = 1536, C_V = 2048, C_CB = 2560, C_CC = 3072, C_CX = 3584;
constexpr float EPS = 1e-6f;
constexpr float LOG2E = 1.4426950408889634f;

constexpr size_t MiB = 1u << 20;
constexpr size_t WS_CTL = 0, CTL_BYTES = 1 * MiB, WS_BAR = 512 * 1024;
constexpr size_t WS_WIN = 1 * MiB, WS_WBR = 15 * MiB, WS_WOUT = 18 * MiB;
constexpr size_t WS_WF1 = 20 * MiB, WS_WF2 = 28 * MiB;
constexpr size_t WS_XB = 36 * MiB;
constexpr size_t WS_PM = 68 * MiB;
constexpr size_t WS_G8 = 196 * MiB;
constexpr size_t WS_HB = 100 * MiB;
constexpr size_t WS_END = 244 * MiB;

constexpr int NWAVES = 8;
constexpr int RING_BYTES = 131072, LDS_BYTES = 139264;

struct Args { const float* in[19]; float* out; unsigned char* ws; int ph_lo, ph_hi; };

#define GAS __attribute__((address_space(1)))
#define XB_TMO      128
#define XB_XCNT(j)  (256  + 64 * (j))
#define XB_XSUB(j)  (1280 + 64 * (j))
#define XB_XGEN(j)  (2304 + 64 * (j))
#define XB_TOP      3328
#define XB_TOPGEN   3392
#define XCD_BAR_WORDS 3456
#define XB_SPIN_CAP (1u << 18)

__device__ __forceinline__ unsigned xb_ld(unsigned* p)              { return __hip_atomic_load(p, __ATOMIC_RELAXED, __HIP_MEMORY_SCOPE_AGENT); }
__device__ __forceinline__ unsigned xb_add(unsigned* p, unsigned v) { return __hip_atomic_fetch_add(p, v, __ATOMIC_RELAXED, __HIP_MEMORY_SCOPE_AGENT); }
__device__ __forceinline__ unsigned xb_xcc_id() { return (unsigned)__builtin_amdgcn_s_getreg((3 << 11) | 20) & 0xFu; }
#define XB_SPIN(cond, bar) do { unsigned _sp = 0; while (cond) { __builtin_amdgcn_s_sleep(1); \
    if ((++_sp & 255u) == 0u) { if (xb_ld(&(bar)[XB_TMO])) break; if (_sp > XB_SPIN_CAP) { atomicAdd(&(bar)[XB_TMO], 1u); break; } } } } while (0)

struct XcdBarrier {
    unsigned* bar; unsigned x;
    volatile LAS unsigned* st;
};

__device__ __forceinline__ XcdBarrier xcd_barrier_post(unsigned* bar, volatile LAS unsigned* st) {
    XcdBarrier b; b.bar = bar; b.x = xb_xcc_id(); b.st = st;
    if (threadIdx.x == 0) (void)xb_add(&bar[XB_XCNT(b.x)], 1u);
    return b;
}
__device__ __forceinline__ void xcd_barrier_complete(unsigned* bar, unsigned x, unsigned& nloc, unsigned& nx) {
    const unsigned G = gridDim.x * gridDim.y * gridDim.z;
    unsigned sum, cnt, mine, sp = 0u;
    for (;;) {
        sum = 0u; cnt = 0u; mine = 0u;
#pragma unroll
        for (unsigned j = 0; j < 16; ++j) { const unsigned c = xb_ld(&bar[XB_XCNT(j)]); sum += c; cnt += (c > 0u) ? 1u : 0u; mine = (j == x) ? c : mine; }
        if (sum == G) break;
        __builtin_amdgcn_s_sleep(1);
        if ((++sp & 255u) == 0u) { if (xb_ld(&bar[XB_TMO])) break; if (sp > XB_SPIN_CAP) { atomicAdd(&bar[XB_TMO], 1u); break; } }
    }
    nloc = mine > 0u ? mine : 1u; nx = cnt > 0u ? cnt : 1u;
}

__device__ __forceinline__ void xcd_barrier(const XcdBarrier& b) {
    asm volatile("s_waitcnt vmcnt(0)" ::: "memory");
    __syncthreads();
    if (threadIdx.x == 0) {
        unsigned* bar = b.bar;
        __builtin_amdgcn_s_waitcnt(0);
        unsigned nloc = b.st[0], nx = b.st[1];
        if (nloc == 0u) { xcd_barrier_complete(bar, b.x, nloc, nx); b.st[0] = nloc; b.st[1] = nx; }
        const unsigned old = xb_add(&bar[XB_XSUB(b.x)], 1u);
        const unsigned gen = old / nloc;
        if (old + 1u == (gen + 1u) * nloc) {
            __builtin_amdgcn_fence(__ATOMIC_RELEASE, "agent");
            asm volatile("s_waitcnt vmcnt(0)" ::: "memory");
            const unsigned og = xb_add(&bar[XB_TOP], 1u);
            const unsigned tg = og / nx;
            if (og + 1u == (tg + 1u) * nx) xb_add(&bar[XB_TOPGEN], 1u);
            else XB_SPIN(xb_ld(&bar[XB_TOPGEN]) == tg, bar);
            __builtin_amdgcn_fence(__ATOMIC_ACQUIRE, "agent");
            asm volatile("s_waitcnt vmcnt(0)" ::: "memory");
        } else {
            XB_SPIN(xb_ld(&bar[XB_TOPGEN]) == gen, bar);
            __builtin_amdgcn_fence(__ATOMIC_ACQUIRE, "agent");
            asm volatile("s_waitcnt vmcnt(0)" ::: "memory");
        }
    }
    __syncthreads();
}

__device__ __forceinline__ float bf_lo(unsigned w) { return __uint_as_float(w << 16); }
__device__ __forceinline__ float bf_hi(unsigned w) { return __uint_as_float(w & 0xffff0000u); }
__device__ __forceinline__ float wave_sum(float v) {
#pragma unroll
    for (int o = 1; o < 64; o <<= 1) v += __shfl_xor(v, o);
    return v;
}
__device__ __forceinline__ float gelu_tanh(float x) {
    const float u = 0.7978845608028654f * (x + 0.044715f * x * x * x);
    return x * __builtin_amdgcn_rcpf(1.f + __builtin_amdgcn_exp2f(-2.f * LOG2E * u));
}
__device__ __forceinline__ float sigmoidf(float x) { return __builtin_amdgcn_rcpf(1.f + __builtin_amdgcn_exp2f(-LOG2E * x)); }
__device__ __forceinline__ float g8f(unsigned b) { return ((float)b + 0.5f) * (1.f / 256.f); }

__device__ __forceinline__ int inproj_phys(int n) {
    if (n < C_Q || n >= C_V) return n;
    const int t = n & ~255, g = (n & 255) >> 6, d = n & 63;
    return t + ((d >> 5) << 7) + (g << 5) + (d & 31);
}

struct EpiInProj {
    static constexpr bool PERM = true, ACCUM = false;
    bf16_t* PM; unsigned char* G8; const float* rowss; const float* gate_b; const float* qnw; const float* knw; float* avss;
    struct Pre { float v[2][4]; };
    __device__ __forceinline__ void pre(Pre& p, const pg8::Unit& u, int wr, int fr) const {
        const int row0 = u.pm * 256 + wr * 64 + fr;
#pragma unroll
        for (int ai = 0; ai < 2; ++ai)
#pragma unroll
            for (int m = 0; m < 4; ++m) p.v[ai][m] = rowss[row0 + ai * 128 + m * 16];
    }
    __device__ __forceinline__ void operator()(f32x4 (&acc)[2][2][4][2], const pg8::Unit& u, int wr, int wc, int fr, int fq, const Pre& p) const {
        const int row0 = u.pm * 256 + wr * 64 + fr;
        float rs[2][4];
#pragma unroll
        for (int ai = 0; ai < 2; ++ai)
#pragma unroll
            for (int m = 0; m < 4; ++m) rs[ai][m] = rsqrtf(p.v[ai][m] * (1.f / DM) + EPS);
        const int pn = u.pn;
        if (pn < 4) {
            const int col0 = pn * 256 + wc * 32 + 8 * fq;
#pragma unroll
            for (int ai = 0; ai < 2; ++ai)
#pragma unroll
                for (int m = 0; m < 4; ++m) { bf16_t* rowp = PM + (size_t)(row0 + ai * 128 + m * 16) * NPM + col0; const float r = rs[ai][m]; float ss = 0.f;
#pragma unroll
                    for (int bj = 0; bj < 2; ++bj) { const f32x4 v0 = acc[ai][bj][m][0] * r, v1 = acc[ai][bj][m][1] * r; u32x4 w; float gl[8];
#pragma unroll
                        for (int e = 0; e < 4; ++e) { gl[e] = gelu_tanh(v0[e]); gl[4 + e] = gelu_tanh(v1[e]); }
#pragma unroll
                        for (int e = 0; e < 8; ++e) ss += gl[e] * gl[e];
                        w.x = cvt_pk_bf16(gl[0], gl[1]); w.y = cvt_pk_bf16(gl[2], gl[3]); w.z = cvt_pk_bf16(gl[4], gl[5]); w.w = cvt_pk_bf16(gl[6], gl[7]);
                        *(u32x4*)(rowp + bj * 128) = w; }
                    if (pn >= 2) { ss += __shfl_xor(ss, 16); ss += __shfl_xor(ss, 32); if (fq == 0) atomicAdd(avss + row0 + ai * 128 + m * 16, ss); } }
        } else if (pn < 8) {
            const bool isq = pn < 6;
            const float* nw = (isq ? qnw : knw) + (wc & 1) * 64 + 8 * fq;
            const float extra = isq ? 0.125f * LOG2E : 1.f;
            float wv[2][8];
#pragma unroll
            for (int bj = 0; bj < 2; ++bj)
#pragma unroll
                for (int i = 0; i < 8; ++i) wv[bj][i] = nw[32 * bj + i] * extra;
            const int col0 = pn * 256 + 64 * wc + 8 * fq;
#pragma unroll
            for (int ai = 0; ai < 2; ++ai)
#pragma unroll
                for (int m = 0; m < 4; ++m) { bf16_t* rowp = PM + (size_t)(row0 + ai * 128 + m * 16) * NPM + col0; const float r = rs[ai][m];
                    f32x4 v[2][2]; float ss = 0.f;
#pragma unroll
                    for (int bj = 0; bj < 2; ++bj)
#pragma unroll
                        for (int n = 0; n < 2; ++n) { v[bj][n] = acc[ai][bj][m][n] * r; const f32x4 x = v[bj][n]; ss += (x[0] * x[0] + x[1] * x[1]) + (x[2] * x[2] + x[3] * x[3]); }
                    ss += __shfl_xor(ss, 16); ss += __shfl_xor(ss, 32);
                    const float rn = rsqrtf(ss * (1.f / 64.f) + EPS);
#pragma unroll
                    for (int bj = 0; bj < 2; ++bj) { const f32x4 v0 = v[bj][0] * rn, v1 = v[bj][1] * rn; u32x4 w;
                        w.x = cvt_pk_bf16(v0[0] * wv[bj][0], v0[1] * wv[bj][1]); w.y = cvt_pk_bf16(v0[2] * wv[bj][2], v0[3] * wv[bj][3]);
                        w.z = cvt_pk_bf16(v1[0] * wv[bj][4], v1[1] * wv[bj][5]); w.w = cvt_pk_bf16(v1[2] * wv[bj][6], v1[3] * wv[bj][7]);
                        *(u32x4*)(rowp + bj * 32) = w; } }
        } else if (pn < 16) {
            const int col0 = pn * 256 + wc * 32 + 8 * fq;
#pragma unroll
            for (int ai = 0; ai < 2; ++ai)
#pragma unroll
                for (int m = 0; m < 4; ++m) { bf16_t* rowp = PM + (size_t)(row0 + ai * 128 + m * 16) * NPM + col0; const float r = rs[ai][m];
#pragma unroll
                    for (int bj = 0; bj < 2; ++bj) { const f32x4 v0 = acc[ai][bj][m][0] * r, v1 = acc[ai][bj][m][1] * r; u32x4 w;
                        w.x = cvt_pk_bf16(v0[0], v0[1]); w.y = cvt_pk_bf16(v0[2], v0[3]); w.z = cvt_pk_bf16(v1[0], v1[1]); w.w = cvt_pk_bf16(v1[2], v1[3]);
                        *(u32x4*)(rowp + bj * 128) = w; } }
        } else {
            const int col0 = (pn - 16) * 256 + wc * 32 + 8 * fq;
            f32x4 bv[2][2];
#pragma unroll
            for (int bj = 0; bj < 2; ++bj)
#pragma unroll
                for (int n = 0; n < 2; ++n) bv[bj][n] = *(const f32x4*)(gate_b + col0 + bj * 128 + 4 * n);
#pragma unroll
            for (int ai = 0; ai < 2; ++ai)
#pragma unroll
                for (int m = 0; m < 4; ++m) { unsigned char* rowp = G8 + (size_t)(row0 + ai * 128 + m * 16) * NG + col0; const float r = rs[ai][m];
#pragma unroll
                    for (int bj = 0; bj < 2; ++bj) { unsigned q[8];
#pragma unroll
                        for (int n = 0; n < 2; ++n)
#pragma unroll
                            for (int e = 0; e < 4; ++e) { const float gx = sigmoidf(acc[ai][bj][m][n][e] * r + bv[bj][n][e]); q[4 * n + e] = (unsigned)__builtin_fminf(gx * 256.f, 255.f); }
                        u32x2 w; w.x = q[0] | (q[1] << 8) | (q[2] << 16) | (q[3] << 24); w.y = q[4] | (q[5] << 8) | (q[6] << 16) | (q[7] << 24);
                        *(u32x2*)(rowp + bj * 128) = w; } }
        }
    }
};

struct EpiBranch {
    static constexpr bool PERM = true, ACCUM = true;
    bf16_t* O; const unsigned char* G8;
    struct Pre { };
    __device__ __forceinline__ void pre(Pre&, const pg8::Unit&, int, int) const {}
    __device__ __forceinline__ void operator()(f32x4 (&acc)[2][2][4][2], const pg8::Unit& u, int wr, int wc, int fr, int fq, const Pre&) const {
        const int row0 = u.pm * 256 + wr * 64 + fr, col0 = u.pn * 256 + wc * 32 + 8 * fq, j = u.j;
#pragma unroll
        for (int ai = 0; ai < 2; ++ai) {
            u32x2 ga[4][2], gb[4][2];
#pragma unroll
            for (int m = 0; m < 4; ++m)
#pragma unroll
                for (int bj = 0; bj < 2; ++bj) { const size_t row = (size_t)(row0 + ai * 128 + m * 16);
                    ga[m][bj] = *(const u32x2*)(G8 + row * NG + j * 1024 + col0 + bj * 128);
                    gb[m][bj] = (j < 2) ? *(const u32x2*)(G8 + row * NG + (j + 1) * 1024 + col0 + bj * 128) : (u32x2){0u, 0u}; }
#pragma unroll
            for (int m = 0; m < 4; ++m) { const size_t row = (size_t)(row0 + ai * 128 + m * 16);
#pragma unroll
                for (int bj = 0; bj < 2; ++bj) {
                    float f[8];
#pragma unroll
                    for (int e = 0; e < 4; ++e) { f[e] = g8f((ga[m][bj].x >> (8 * e)) & 0xffu); f[4 + e] = g8f((ga[m][bj].y >> (8 * e)) & 0xffu); }
                    if (j < 2) {
#pragma unroll
                        for (int e = 0; e < 4; ++e) { f[e] *= __builtin_amdgcn_rcpf(g8f((gb[m][bj].x >> (8 * e)) & 0xffu)); f[4 + e] *= __builtin_amdgcn_rcpf(g8f((gb[m][bj].y >> (8 * e)) & 0xffu)); }
                    }
#pragma unroll
                    for (int e = 0; e < 4; ++e) { acc[ai][bj][m][0][e] *= f[e]; acc[ai][bj][m][1][e] *= f[4 + e]; }
                    if (j == 2) { const f32x4 v0 = acc[ai][bj][m][0], v1 = acc[ai][bj][m][1]; u32x4 w;
                        w.x = cvt_pk_bf16(v0[0], v0[1]); w.y = cvt_pk_bf16(v0[2], v0[3]); w.z = cvt_pk_bf16(v1[0], v1[1]); w.w = cvt_pk_bf16(v1[2], v1[3]);
                        *(u32x4*)(O + row * DM + col0 + bj * 128) = w; }
                } }
        }
    }
};

struct EpiResid {
    static constexpr bool PERM = false, ACCUM = false;
    const float* xin; float* xout; bf16_t* xb; float* rowss;
    struct Pre { };
    __device__ __forceinline__ void pre(Pre&, const pg8::Unit&, int, int) const {}
    __device__ __forceinline__ void operator()(f32x4 (&acc)[2][2][4][2], const pg8::Unit& u, int wr, int wc, int fr, int fq, const Pre&) const {
        const int row0 = u.pm * 256 + wr * 64 + fr, col0 = u.pn * 256 + wc * 32 + 4 * fq;
#pragma unroll
        for (int ai = 0; ai < 2; ++ai) {
            f32x4 xr[4][2][2];
#pragma unroll
            for (int m = 0; m < 4; ++m)
#pragma unroll
                for (int bj = 0; bj < 2; ++bj)
#pragma unroll
                    for (int n = 0; n < 2; ++n) xr[m][bj][n] = *(const f32x4*)(xin + (size_t)(row0 + ai * 128 + m * 16) * DM + col0 + bj * 128 + n * 16);
#pragma unroll
            for (int m = 0; m < 4; ++m) { const int row = row0 + ai * 128 + m * 16; const size_t off = (size_t)row * DM + col0; float ss = 0.f;
#pragma unroll
                for (int bj = 0; bj < 2; ++bj)
#pragma unroll
                    for (int n = 0; n < 2; ++n) { const size_t o = off + bj * 128 + n * 16; const f32x4 x = xr[m][bj][n] + acc[ai][bj][m][n];
                        *(f32x4*)(xout + o) = x;
                        if (xb) { u32x2 w; w.x = cvt_pk_bf16(x[0], x[1]); w.y = cvt_pk_bf16(x[2], x[3]); *(u32x2*)(xb + o) = w; ss += (x[0] * x[0] + x[1] * x[1]) + (x[2] * x[2] + x[3] * x[3]); } }
                if (xb) { ss += __shfl_xor(ss, 16); ss += __shfl_xor(ss, 32); if (fq == 0) atomicAdd(rowss + row, ss); } }
        }
    }
};

struct EpiFF1 {
    static constexpr bool PERM = true, ACCUM = false;
    bf16_t* O; const float* rowss; int ldc;
    struct Pre { float v[2][4]; };
    __device__ __forceinline__ void pre(Pre& p, const pg8::Unit& u, int wr, int fr) const {
        const int row0 = u.pm * 256 + wr * 64 + fr;
#pragma unroll
        for (int ai = 0; ai < 2; ++ai)
#pragma unroll
            for (int m = 0; m < 4; ++m) p.v[ai][m] = rowss[row0 + ai * 128 + m * 16];
    }
    __device__ __forceinline__ void operator()(f32x4 (&acc)[2][2][4][2], const pg8::Unit& u, int wr, int wc, int fr, int fq, const Pre& p) const {
        const int row0 = u.pm * 256 + wr * 64 + fr, col0 = u.pn * 256 + wc * 32 + 8 * fq;
        float rsv[2][4];
#pragma unroll
        for (int ai = 0; ai < 2; ++ai)
#pragma unroll
            for (int m = 0; m < 4; ++m) rsv[ai][m] = rsqrtf(p.v[ai][m] * (1.f / DM) + EPS);
#pragma unroll
        for (int ai = 0; ai < 2; ++ai)
#pragma unroll
            for (int m = 0; m < 4; ++m) { const int row = row0 + ai * 128 + m * 16; const float r = rsv[ai][m]; bf16_t* rowp = O + (size_t)row * ldc + col0;
#pragma unroll
                for (int bj = 0; bj < 2; ++bj) { f32x4 v0 = acc[ai][bj][m][0] * r, v1 = acc[ai][bj][m][1] * r;
#pragma unroll
                    for (int e = 0; e < 4; ++e) { const float a = __builtin_fmaxf(v0[e], 0.f), b = __builtin_fmaxf(v1[e], 0.f); v0[e] = a * a; v1[e] = b * b; }
                    u32x4 w; w.x = cvt_pk_bf16(v0[0], v0[1]); w.y = cvt_pk_bf16(v0[2], v0[3]); w.z = cvt_pk_bf16(v1[0], v1[1]); w.w = cvt_pk_bf16(v1[2], v1[3]);
                    *(u32x4*)(rowp + bj * 128) = w; } }
    }
};

template <bool INPERM>
__device__ __forceinline__ void transpose_item(const float* W, const float* kscale, int K, int N, bf16_t* WT, LAS float* scr, int item, int lane) {
    const int nblk = N / 32, kb = item / nblk, nb = item % nblk, k0 = 64 * kb, n0 = 32 * nb;
    float v[32];
#pragma unroll
    for (int i = 0; i < 32; ++i) { const int kk = 2 * i + (lane >> 5); v[i] = W[(size_t)(k0 + kk) * N + n0 + (lane & 31)]; }
    if (kscale) {
#pragma unroll
        for (int i = 0; i < 32; ++i) v[i] *= kscale[k0 + 2 * i + (lane >> 5)]; }
#pragma unroll
    for (int i = 0; i < 32; ++i) { const int kk = 2 * i + (lane >> 5); scr[kk * 33 + (lane & 31)] = v[i]; }
    asm volatile("s_waitcnt lgkmcnt(0)" ::: "memory");
    const int c = lane & 7;
    const int r0 = INPERM ? inproj_phys(n0) : n0;
#pragma unroll
    for (int j = 0; j < 4; ++j) { const int n = (lane >> 3) + 8 * j; const LAS float* s = scr + (8 * c) * 33 + n;
        u32x4 o; o.x = cvt_pk_bf16(s[0 * 33], s[1 * 33]); o.y = cvt_pk_bf16(s[2 * 33], s[3 * 33]); o.z = cvt_pk_bf16(s[4 * 33], s[5 * 33]); o.w = cvt_pk_bf16(s[6 * 33], s[7 * 33]);
        *(u32x4*)(WT + (size_t)(r0 + n) * K + k0 + 8 * c) = o; }
    asm volatile("s_waitcnt lgkmcnt(0)" ::: "memory");
}
constexpr int IT_WIN = 16 * 224, IT_BR = 8 * 32, IT_OUT = 16 * 32, IT_F1 = 16 * 128, IT_F2 = 64 * 32;
__device__ __forceinline__ void convert_region_a(const Args& a, int l, LAS unsigned char* lds, int gw, int ngw, int wave, int lane) {
    LAS float* scr = (LAS float*)(lds + wave * 16384);
    unsigned char* ws = a.ws;
    constexpr int NIT = IT_WIN + 3 * IT_BR + IT_OUT;
    for (int it = gw; it < NIT; it += ngw) {
        int r = it;
        if (r < IT_WIN) { transpose_item<true>(a.in[2] + (size_t)l * DM * NIN, a.in[1] + l * DM, DM, NIN, (bf16_t*)(ws + WS_WIN), scr, r, lane); continue; } r -= IT_WIN;
        if (r < 3 * IT_BR) { const int j = r / IT_BR; transpose_item<false>(a.in[12 + j] + (size_t)l * 512 * DM, nullptr, 512, DM, (bf16_t*)(ws + WS_WBR + j * MiB), scr, r % IT_BR, lane); continue; } r -= 3 * IT_BR;
        transpose_item<false>(a.in[15] + (size_t)l * DM * DM, nullptr, DM, DM, (bf16_t*)(ws + WS_WOUT), scr, r, lane);
    }
}
__device__ __forceinline__ void convert_region_b(const Args& a, int l, LAS unsigned char* lds, int gw, int ngw, int wave, int lane) {
    LAS float* scr = (LAS float*)(lds + wave * 16384);
    unsigned char* ws = a.ws;
    constexpr int NIT = IT_F1 + IT_F2;
    for (int it = gw; it < NIT; it += ngw) {
        int r = it;
        if (r < IT_F1) { transpose_item<false>(a.in[17] + (size_t)l * DM * FF, a.in[16] + l * DM, DM, FF, (bf16_t*)(ws + WS_WF1), scr, r, lane); continue; } r -= IT_F1;
        transpose_item<false>(a.in[18] + (size_t)l * FF * DM, nullptr, FF, DM, (bf16_t*)(ws + WS_WF2), scr, r, lane);
    }
}

namespace att {
typedef short bf16x8 __attribute__((ext_vector_type(8)));
typedef short s16x4 __attribute__((ext_vector_type(4)));
typedef short v4i16_t __attribute__((ext_vector_type(4)));
typedef float f32x16 __attribute__((ext_vector_type(16)));
typedef float f32x8 __attribute__((ext_vector_type(8)));
typedef float f32x2_t __attribute__((ext_vector_type(2))); typedef __bf16 bf16x2_t __attribute__((ext_vector_type(2)));
__device__ __forceinline__ unsigned cvtpk_s(float lo, float hi) { f32x2_t v = {lo, hi}; bf16x2_t b = __builtin_convertvector(v, bf16x2_t); return __builtin_bit_cast(unsigned, b); }
__device__ __forceinline__ s16x4 vtr(const LAS unsigned char* p) { return __builtin_bit_cast(s16x4, __builtin_amdgcn_ds_read_tr16_b64_v4i16((LAS v4i16_t*)p)); }
constexpr int KSTR = 144, VSTR = 320, KMAP = 64 * KSTR, V_OFF = 2 * KMAP, BUF = V_OFF + 64 * VSTR;
__device__ __forceinline__ bf16x8 pack8(const f32x16& p, int o) {
    u32x4 w; w.x = cvtpk_s(p[o], p[o + 1]); w.y = cvtpk_s(p[o + 2], p[o + 3]); w.z = cvtpk_s(p[o + 4], p[o + 5]); w.w = cvtpk_s(p[o + 6], p[o + 7]); return __builtin_bit_cast(bf16x8, w); }

__device__ __forceinline__ void attn_unit(bf16_t* PM, bf16_t* obase, int opitch, int b, int h, int qb, float lam, float post, const float* subw, const float* knw, LAS unsigned char* lds, int tid_in) {
    int tid = tid_in; asm volatile("" : "+v"(tid));
    const int lane = tid & 63, wid = __builtin_amdgcn_readfirstlane(tid >> 6), r32 = lane & 31, hi = lane >> 5, m = wid >> 2, qs = wid & 3;
    const int qpos = 128 * qb + 32 * qs + r32;
    bf16_t* base = PM + (size_t)b * SEQ * NPM;
    bf16_t* qrow = base + (size_t)qpos * NPM + C_Q + h * 128;
    bf16_t* orow = obase + (size_t)(b * SEQ + qpos) * opitch + h * 128;
    bf16x8 qr[4];
#pragma unroll
    for (int d0 = 0; d0 < 4; ++d0) qr[d0] = *(const bf16x8*)(qrow + m * 64 + d0 * 16 + hi * 8);
    bool need_check;
    { float qn2 = 0.f;
#pragma unroll
      for (int d0 = 0; d0 < 4; ++d0) { const u32x4 w = __builtin_bit_cast(u32x4, qr[d0]);
          const float a0 = bf_lo(w.x), a1 = bf_hi(w.x), a2 = bf_lo(w.y), a3 = bf_hi(w.y), a4 = bf_lo(w.z), a5 = bf_hi(w.z), a6 = bf_lo(w.w), a7 = bf_hi(w.w);
          qn2 += (a0 * a0 + a1 * a1) + (a2 * a2 + a3 * a3) + (a4 * a4 + a5 * a5) + (a6 * a6 + a7 * a7); }
      qn2 += __shfl_xor(qn2, 32);
      float wk = __builtin_fmaxf(__builtin_fabsf(knw[lane]), __builtin_fabsf(knw[64 + lane]));
#pragma unroll
      for (int o = 1; o < 64; o <<= 1) wk = __builtin_fmaxf(wk, __shfl_xor(wk, o));
      need_check = __any(sqrtf(qn2) * 8.f * wk * 1.02f > 40.f); }
    const int NT = 2 * (qb + 1), my_nt = (qs < 2) ? NT - 1 : NT;
    const float sl2 = __builtin_amdgcn_exp2f(-2.f * (float)(h + 1)) * LOG2E;
    const bf16_t* gk = base + (size_t)(tid >> 3) * NPM + C_K + h * 128 + (tid & 7) * 8;
    const bf16_t* gv = base + (size_t)(tid >> 4) * NPM + C_V + h * 128 + (tid & 15) * 8;
    const int lk = (tid >> 3) * KSTR + (tid & 7) * 16, lv = V_OFF + (tid >> 4) * VSTR + (tid & 15) * 16;
    u32x4 st0, st1, st2, st3;
#define ATT_LOAD(t) do { const size_t ro = (size_t)(t) * 64 * NPM; st0 = *(const u32x4*)(gk + ro); st1 = *(const u32x4*)(gk + ro + 64); st2 = *(const u32x4*)(gv + ro); st3 = *(const u32x4*)(gv + ro + (size_t)32 * NPM); } while (0)
#define ATT_STORE(bufp) do { *(LAS u32x4*)((bufp) + lk) = st0; *(LAS u32x4*)((bufp) + KMAP + lk) = st1; *(LAS u32x4*)((bufp) + lv) = st2; *(LAS u32x4*)((bufp) + lv + 32 * VSTR) = st3; } while (0)
    __syncthreads();
    ATT_LOAD(0); ATT_STORE(lds);
    __syncthreads();
    f32x16 OT[4];
#pragma unroll
    for (int eb = 0; eb < 4; ++eb)
#pragma unroll
        for (int r = 0; r < 16; ++r) OT[eb][r] = 0.f;
    float mref = 0.f, lsum = 0.f;
    const float s64 = 64.f * sl2;
    const float s32 = 32.f * sl2;
    f32x16 ci0;
#pragma unroll
    for (int r = 0; r < 16; ++r) ci0[r] = sl2 * (float)(4 * hi + (r & 3) + 8 * (r >> 2) - qpos);
    for (int t = 0; t < NT; ++t) {
        LAS unsigned char* buf = lds + (t & 1) * BUF;
        if (t + 1 < NT) ATT_LOAD(t + 1);
        if (t < my_nt) {
            const LAS unsigned char* kp = buf + m * KMAP + r32 * KSTR + hi * 16;
            f32x16 p0 = ci0, p1 = ci0 + s32;
            if (t == my_nt - 1) {
                int hid = hi; asm volatile("" : "+v"(hid));
                const float qf = (float)qpos, k0 = (float)(64 * t + 4 * hid), cadd = -mref;
#pragma unroll
                for (int r = 0; r < 16; ++r) { const float kf = k0 + (float)((r & 3) + 8 * (r >> 2));
                    p0[r] = __builtin_fmaf(-sl2, __builtin_fabsf(qf - kf), cadd); p1[r] = __builtin_fmaf(-sl2, __builtin_fabsf(qf - (kf + 32.f)), cadd); }
            }
            bf16x8 ka[4], kb2[4];
#pragma unroll
            for (int d0 = 0; d0 < 4; ++d0) { ka[d0] = *(const LAS bf16x8*)(kp + d0 * 32); kb2[d0] = *(const LAS bf16x8*)(kp + 32 * KSTR + d0 * 32); }
#pragma unroll
            for (int d0 = 0; d0 < 4; ++d0) {
                p0 = __builtin_amdgcn_mfma_f32_32x32x16_bf16(ka[d0], qr[d0], p0, 0, 0, 0);
                p1 = __builtin_amdgcn_mfma_f32_32x32x16_bf16(kb2[d0], qr[d0], p1, 0, 0, 0);
            }
            const LAS unsigned char* vp = buf + V_OFF + (4 * hi + ((lane & 15) >> 2)) * VSTR + ((lane >> 4) & 1) * 32 + (lane & 3) * 8;
            s16x4 vlo[2][4], vhi[2][4];
#pragma unroll
            for (int eb = 0; eb < 4; ++eb) { vlo[0][eb] = vtr(vp + eb * 64); vhi[0][eb] = vtr(vp + 8 * VSTR + eb * 64); }
            float mt = 0.f;
            if (need_check) { mt = __builtin_fmaxf(p0[0], p1[0]);
#pragma unroll
                for (int r = 1; r < 16; ++r) mt = __builtin_fmaxf(__builtin_fmaxf(mt, p0[r]), p1[r]);
                mt = __builtin_fmaxf(mt, __shfl_xor(mt, 32)); }
            if (need_check && __any(mt > 40.f)) {
                const float dl = __builtin_fmaxf(mt, 0.f), f = __builtin_amdgcn_exp2f(-dl);
                mref += dl; lsum *= f; p0 -= dl; p1 -= dl; ci0 -= dl;
#pragma unroll
                for (int eb = 0; eb < 4; ++eb) OT[eb] *= f;
            }
#if PROBE == 13
            { float dz = 0.f;
#pragma unroll
              for (int r = 0; r < 16; ++r) { dz += __builtin_amdgcn_exp2f(p0[r] + 1.f) + __builtin_amdgcn_exp2f(p1[r] + 1.f); }
              asm volatile("" :: "v"(dz)); }
#endif
#if PROBE == 14
            { f32x16 dacc = p0;
#pragma unroll
              for (int d0 = 0; d0 < 4; ++d0) { dacc = __builtin_amdgcn_mfma_f32_32x32x16_bf16(ka[d0], qr[d0], dacc, 0, 0, 0); dacc = __builtin_amdgcn_mfma_f32_32x32x16_bf16(kb2[d0], qr[d0], dacc, 0, 0, 0); }
              asm volatile("" :: "v"(dacc)); }
#endif
#pragma unroll
            for (int r = 0; r < 16; ++r) { p0[r] = __builtin_amdgcn_exp2f(p0[r]); p1[r] = __builtin_amdgcn_exp2f(p1[r]); }
            { const f32x16 s16 = p0 + p1; const f32x8 s8 = s16.lo + s16.hi; const f32x4 s4v = s8.lo + s8.hi; const f32x2_t s2 = s4v.lo + s4v.hi; lsum += s2.x + s2.y; }
            ci0 += s64;
            bf16x8 pf[4]; pf[0] = pack8(p0, 0); pf[1] = pack8(p0, 8); pf[2] = pack8(p1, 0); pf[3] = pack8(p1, 8);
#pragma unroll
            for (int s4 = 0; s4 < 4; ++s4) {
                if (s4 < 3) {
#pragma unroll
                    for (int eb = 0; eb < 4; ++eb) { vlo[(s4 + 1) & 1][eb] = vtr(vp + (16 * (s4 + 1)) * VSTR + eb * 64); vhi[(s4 + 1) & 1][eb] = vtr(vp + (16 * (s4 + 1) + 8) * VSTR + eb * 64); }
                }
#pragma unroll
                for (int eb = 0; eb < 4; ++eb) {
                    const s16x4 a = vlo[s4 & 1][eb], c = vhi[s4 & 1][eb];
                    const bf16x8 vf = (bf16x8){a[0], a[1], a[2], a[3], c[0], c[1], c[2], c[3]};
                    OT[eb] = __builtin_amdgcn_mfma_f32_32x32x16_bf16(vf, pf[s4], OT[eb], 0, 0, 0);
                }
            }
        }
        if (t + 1 < NT) ATT_STORE(lds + ((t + 1) & 1) * BUF);
        __syncthreads();
    }
#undef ATT_LOAD
#undef ATT_STORE
    lsum += __shfl_xor(lsum, 32);
    const float inv = 1.f / lsum;
#pragma unroll
    for (int eb = 0; eb < 4; ++eb)
#pragma unroll
        for (int r = 0; r < 16; ++r) OT[eb][r] *= inv;
    int hif = hi, lanef = lane; asm volatile("" : "+v"(hif), "+v"(lanef));
    LAS float* X = (LAS float*)(lds + qs * 16384) + lanef;
    if (m == 1) {
#pragma unroll
        for (int eb = 0; eb < 4; ++eb)
#pragma unroll
            for (int r = 0; r < 16; ++r) X[(eb * 16 + r) * 64] = OT[eb][r];
    }
    __syncthreads();
    if (m == 0) {
        float ss = 0.f;
#pragma unroll
        for (int eb = 0; eb < 4; ++eb) {
            __builtin_amdgcn_sched_barrier(0);
#pragma unroll
            for (int r = 0; r < 16; ++r) { const float o = OT[eb][r] - lam * X[(eb * 16 + r) * 64]; OT[eb][r] = o; ss += o * o; } }
        __builtin_amdgcn_sched_barrier(0);
        ss += __shfl_xor(ss, 32);
        const float rn = rsqrtf(ss * (1.f / 128.f) + EPS) * post;
        f32x4 w4a[4][4];
#pragma unroll
        for (int eb = 0; eb < 4; ++eb)
#pragma unroll
            for (int rg = 0; rg < 4; ++rg) w4a[eb][rg] = *(const f32x4*)(subw + 32 * eb + 8 * rg + 4 * hif);
#pragma unroll
        for (int eb = 0; eb < 4; ++eb)
#pragma unroll
            for (int rg = 0; rg < 4; ++rg) { const int e = 32 * eb + 8 * rg + 4 * hif; const f32x4 w4 = w4a[eb][rg];
                u32x2 w; w.x = cvtpk_s(OT[eb][4 * rg] * rn * w4[0], OT[eb][4 * rg + 1] * rn * w4[1]); w.y = cvtpk_s(OT[eb][4 * rg + 2] * rn * w4[2], OT[eb][4 * rg + 3] * rn * w4[3]);
                *(u32x2*)(orow + e) = w; }
    }
}
}

__device__ __forceinline__ void gmlp_unit(bf16_t* PM, bf16_t* obase, int opitch, const float* avss, const float* vnw, const float* ws_g, const float* bs_g, int rowbase, int g, LAS unsigned char* lds, int tid) {
    constexpr int VSTR = 320, WSTR = 272, W_OFF = 128 * VSTR;
    const int lane = tid & 63, wid = __builtin_amdgcn_readfirstlane(tid >> 6), r32 = lane & 31, hi = lane >> 5;
    __syncthreads();
    {
        const int row = tid >> 2, part = tid & 3;
        const bf16_t* rp = PM + (size_t)(rowbase + row) * NPM + C_AV;
        const float r = rsqrtf(avss[rowbase + row] * (1.f / 512.f) + EPS);
        const int c0 = part * 32;
#pragma unroll
        for (int i = 0; i < 4; ++i) { const u32x4 w = *(const u32x4*)(rp + g * 128 + c0 + i * 8); const float* nw = vnw + g * 128 + c0 + i * 8;
            const f32x4 n0 = *(const f32x4*)nw, n1 = *(const f32x4*)(nw + 4); u32x4 o;
            o.x = att::cvtpk_s(bf_lo(w.x) * r * n0[0], bf_hi(w.x) * r * n0[1]); o.y = att::cvtpk_s(bf_lo(w.y) * r * n0[2], bf_hi(w.y) * r * n0[3]);
            o.z = att::cvtpk_s(bf_lo(w.z) * r * n1[0], bf_hi(w.z) * r * n1[1]); o.w = att::cvtpk_s(bf_lo(w.w) * r * n1[2], bf_hi(w.w) * r * n1[3]);
            *(LAS u32x4*)(lds + row * VSTR + (c0 + i * 8) * 2) = o; }
#pragma unroll
        for (int i = 0; i < 4; ++i) { const int e8 = (i * 512 + tid) * 8, t = e8 >> 7, s0 = e8 & 127; f32x4 a = *(const f32x4*)(ws_g + e8), b = *(const f32x4*)(ws_g + e8 + 4);
#pragma unroll
            for (int e = 0; e < 4; ++e) { if (s0 + e > t) a[e] = 0.f; if (s0 + 4 + e > t) b[e] = 0.f; }
            u32x4 o; o.x = att::cvtpk_s(a[0], a[1]); o.y = att::cvtpk_s(a[2], a[3]); o.z = att::cvtpk_s(b[0], b[1]); o.w = att::cvtpk_s(b[2], b[3]);
            *(LAS u32x4*)(lds + W_OFF + t * WSTR + s0 * 2) = o; }
    }
    __syncthreads();
    const int cb = wid & 3;
    const LAS unsigned char* vp = lds + (8 * hi + ((lane & 15) >> 2)) * VSTR + (32 * cb + 16 * ((lane >> 4) & 1) + 4 * (lane & 3)) * 2;
#pragma unroll
    for (int pass = 0; pass < 2; ++pass) {
        const int tb = pass == 0 ? (wid >> 2) : 3 - (wid >> 2);
        att::f32x16 acc;
#pragma unroll
        for (int r = 0; r < 16; ++r) acc[r] = 0.f;
        const LAS unsigned char* wp = lds + W_OFF + (32 * tb + r32) * WSTR + hi * 16;
        const int nk = 2 * (tb + 1);
        for (int kk = 0; kk < nk; ++kk) {
            const att::s16x4 vlo = att::vtr(vp + (16 * kk) * VSTR), vhi = att::vtr(vp + (16 * kk + 4) * VSTR);
            const att::bf16x8 A = (att::bf16x8){vlo[0], vlo[1], vlo[2], vlo[3], vhi[0], vhi[1], vhi[2], vhi[3]};
            const att::bf16x8 B = *(const LAS att::bf16x8*)(wp + kk * 32);
            acc = __builtin_amdgcn_mfma_f32_32x32x16_bf16(A, B, acc, 0, 0, 0);
        }
        const int t = 32 * tb + r32; const float bsv = bs_g[t];
        u32x2 uua[4];
#pragma unroll
        for (int rg = 0; rg < 4; ++rg) uua[rg] = *(const u32x2*)(PM + (size_t)(rowbase + t) * NPM + C_AU + g * 128 + 32 * cb + 8 * rg + 4 * hi);
#pragma unroll
        for (int rg = 0; rg < 4; ++rg) { const int c = 32 * cb + 8 * rg + 4 * hi;
            const u32x2 uu = uua[rg];
            u32x2 o; o.x = att::cvtpk_s(bf_lo(uu.x) * (acc[4 * rg] + bsv), bf_hi(uu.x) * (acc[4 * rg + 1] + bsv)); o.y = att::cvtpk_s(bf_lo(uu.y) * (acc[4 * rg + 2] + bsv), bf_hi(uu.y) * (acc[4 * rg + 3] + bsv));
            *(u32x2*)(obase + (size_t)(rowbase + t) * opitch + g * 128 + c) = o; }
    }
}

__device__ __forceinline__ void conv_items(bf16_t* PM, bf16_t* obase, int opitch, const float* cw, int gtid, int gthreads) {
    const int c0 = (gtid & 63) * 8;
    float cwv[3][8];
#pragma unroll
    for (int j = 0; j < 3; ++j)
#pragma unroll
        for (int e = 0; e < 8; ++e) cwv[j][e] = cw[j * 512 + c0 + e];
    for (int idx = gtid; idx < M * 64; idx += 4 * gthreads) {
        u32x4 A[4][3], B[4][3], CB[4];
#pragma unroll
        for (int u = 0; u < 4; ++u) { const int i = (idx + u * gthreads < M * 64) ? idx + u * gthreads : idx; const int row = i >> 6, spos = row & (SEQ - 1);
            const bf16_t* rp = PM + (size_t)row * NPM;
#pragma unroll
            for (int j = 0; j < 3; ++j) { const int dt = (spos >= 2 - j) ? 2 - j : 0; A[u][j] = *(const u32x4*)(rp - (size_t)dt * NPM + C_CC + c0); B[u][j] = *(const u32x4*)(rp - (size_t)dt * NPM + C_CX + c0); }
            CB[u] = *(const u32x4*)(rp + C_CB + c0); }
#pragma unroll
        for (int u = 0; u < 4; ++u) { const int i = idx + u * gthreads; if (i < M * 64) { const int row = i >> 6, spos = row & (SEQ - 1);
            float y[8];
#pragma unroll
            for (int e = 0; e < 8; ++e) y[e] = 0.f;
#pragma unroll
            for (int j = 0; j < 3; ++j) { const float mk = (spos >= 2 - j) ? 1.f : 0.f; const u32x4 a = A[u][j], b2 = B[u][j];
                y[0] += mk * cwv[j][0] * (bf_lo(a.x) * bf_lo(b2.x)); y[1] += mk * cwv[j][1] * (bf_hi(a.x) * bf_hi(b2.x)); y[2] += mk * cwv[j][2] * (bf_lo(a.y) * bf_lo(b2.y)); y[3] += mk * cwv[j][3] * (bf_hi(a.y) * bf_hi(b2.y));
                y[4] += mk * cwv[j][4] * (bf_lo(a.z) * bf_lo(b2.z)); y[5] += mk * cwv[j][5] * (bf_hi(a.z) * bf_hi(b2.z)); y[6] += mk * cwv[j][6] * (bf_lo(a.w) * bf_lo(b2.w)); y[7] += mk * cwv[j][7] * (bf_hi(a.w) * bf_hi(b2.w)); }
            const u32x4 cb = CB[u];
            u32x4 w; w.x = cvt_pk_bf16(bf_lo(cb.x) * y[0], bf_hi(cb.x) * y[1]); w.y = cvt_pk_bf16(bf_lo(cb.y) * y[2], bf_hi(cb.y) * y[3]);
            w.z = cvt_pk_bf16(bf_lo(cb.z) * y[4], bf_hi(cb.z) * y[5]); w.w = cvt_pk_bf16(bf_lo(cb.w) * y[6], bf_hi(cb.w) * y[7]);
            *(u32x4*)(obase + (size_t)row * opitch + c0) = w; } }
    }
}

constexpr int N_PHASES = 1 + 6 * DEPTH;
__global__ void __launch_bounds__(NWAVES * 64, 2) fwd_kernel(Args args) {
    extern __shared__ __attribute__((aligned(16))) unsigned char lds_raw[];
    LAS unsigned char* lds = (LAS unsigned char*)lds_raw;
    const int G = gridDim.x, bx = blockIdx.x, ngw = G * NWAVES, gthreads = G * NWAVES * 64;
#define TIDS() int tid_ = threadIdx.x; asm volatile("" : "+v"(tid_)); const int tid = tid_, lane = tid & 63, wave = __builtin_amdgcn_readfirstlane(tid >> 6), gw = bx * NWAVES + wave, gtid = bx * (NWAVES * 64) + tid; (void)lane; (void)gw; (void)gtid
    unsigned char* ws = args.ws;
    float* ROWSS = (float*)(ws + WS_CTL);
    bf16_t* XB = (bf16_t*)(ws + WS_XB); bf16_t* PM = (bf16_t*)(ws + WS_PM); bf16_t* XBM = (bf16_t*)(ws + WS_PM); bf16_t* HB = (bf16_t*)(ws + WS_HB);
    unsigned char* G8 = ws + WS_G8;
    const int lo = args.ph_lo, hi = args.ph_hi;
#if !MK_MULTI
    cg::grid_group grid = cg::this_grid();
    volatile LAS unsigned* bst = (volatile LAS unsigned*)(lds + RING_BYTES + 512);
    if (threadIdx.x < 2) bst[threadIdx.x] = 0u;
    __syncthreads();
    const XcdBarrier xbar = xcd_barrier_post((unsigned*)(ws + WS_BAR), bst);
#define SEAM(ph) do { if ((ph) + 1 < hi) { if (PROBE != 12 && hi > 1000) grid.sync();   xcd_barrier(xbar); if (PROBE == 6) { xcd_barrier(xbar); xcd_barrier(xbar); } } } while (0)
#else
#define SEAM(ph) do { } while (0)
#endif
#define IN(k) (lo <= (k) && (k) < hi)
#if PROBE >= 20
    unsigned long long tp_acc = 0, tp_t0 = 0;
#define TP_BEGIN(type) do { if (PROBE - 20 == (type)) tp_t0 = __builtin_amdgcn_s_memrealtime(); } while (0)
#define TP_END(type) do { if (PROBE - 20 == (type)) tp_acc += __builtin_amdgcn_s_memrealtime() - tp_t0; } while (0)
#else
#define TP_BEGIN(type) do { } while (0)
#define TP_END(type) do { } while (0)
#endif

    TP_BEGIN(0);
    if (IN(0)) {
        TIDS();
        for (int rep = 0; rep < (PROBE == 1 ? 2 : 1); ++rep) {
        convert_region_a(args, 0, lds, gw, ngw, wave, lane);
        convert_region_b(args, 0, lds, gw, ngw, wave, lane); }
        const float* x = args.in[0];
        for (int r = gw; r < M; r += 2 * ngw) {
            const int r2 = (r + ngw < M) ? r + ngw : r;
            const f32x4* xr = (const f32x4*)(x + (size_t)r * DM) + lane; const f32x4* xr2 = (const f32x4*)(x + (size_t)r2 * DM) + lane;
            f32x4 va[4], vb[4];
#pragma unroll
            for (int j = 0; j < 4; ++j) { va[j] = xr[64 * j]; vb[j] = xr2[64 * j]; }
            u32x2* o = (u32x2*)(XB + (size_t)r * DM) + lane; u32x2* o2 = (u32x2*)(XB + (size_t)r2 * DM) + lane; float s = 0.f, s2 = 0.f;
#pragma unroll
            for (int j = 0; j < 4; ++j) { const f32x4 v = va[j]; s += (v[0] * v[0] + v[1] * v[1]) + (v[2] * v[2] + v[3] * v[3]); u32x2 w; w.x = cvt_pk_bf16(v[0], v[1]); w.y = cvt_pk_bf16(v[2], v[3]); o[64 * j] = w;
                const f32x4 q = vb[j]; s2 += (q[0] * q[0] + q[1] * q[1]) + (q[2] * q[2] + q[3] * q[3]); u32x2 w2; w2.x = cvt_pk_bf16(q[0], q[1]); w2.y = cvt_pk_bf16(q[2], q[3]); o2[64 * j] = w2; }
            s = wave_sum(s); s2 = wave_sum(s2); if (lane == 0) { ROWSS[r] = s; ROWSS[r2] = s2; }
        }
        SEAM(0);
    }
    TP_END(0);
    for (int l = 0; l < DEPTH; ++l) {
        const int pb = 1 + 6 * l;
        const float* xres_in = (l == 0) ? args.in[0] : args.out;
        TP_BEGIN(1);
        if (IN(pb + 0)) {
            pg8::Gemm g{XB, (const bf16_t*)(ws + WS_WIN), DM, DM, 0, 0, 0}; pg8::StaticOrder S; S.init(M, NIN, G, bx, 1, WGM_IN);
            EpiInProj E{PM, G8, ROWSS + (size_t)(2 * l) * M, args.in[3] + l * NG, args.in[7] + l * 128, args.in[8] + l * 128, ROWSS + (size_t)(4 + l) * M};
            pg8::gemm_phase<EpiInProj, pg8::StaticOrder>(lds, g, S, E);
#if PROBE == 2
            pg8::gemm_phase<EpiInProj, pg8::StaticOrder>(lds, g, S, E);
#endif
            SEAM(pb + 0);
        }
        TP_END(1);
        TP_BEGIN(2);
        if (IN(pb + 1)) {
            TIDS();
            if (l == 1) convert_region_b(args, 1, lds, gw, ngw, wave, lane);
            const float* lp = args.in[9] + l * 256;
            const float sa = wave_sum(lp[lane] * lp[64 + lane]), sb = wave_sum(lp[128 + lane] * lp[192 + lane]);
            const float lam_init = 0.8f - 0.6f * expf(-0.3f * (float)l);
            const float lam = expf(sa) - expf(sb) + lam_init;
#if PROBE == 4
            for (int pi = bx; pi < 256; pi += G) { const int bh = pi >> 4, sq = pi & 15;
                att::attn_unit(PM, XB, DM, bh >> 2, bh & 3, 31 - sq, lam, 1.f - lam_init, args.in[10] + l * 128, args.in[8] + l * 128, lds, tid);
                att::attn_unit(PM, XB, DM, bh >> 2, bh & 3, sq, lam, 1.f - lam_init, args.in[10] + l * 128, args.in[8] + l * 128, lds, tid); }
#endif
            for (int pi = bx; pi < 256; pi += G) { const int bh = pi >> 4, sq = pi & 15;
                att::attn_unit(PM, PM + C_Q, NPM, bh >> 2, bh & 3, 31 - sq, lam, 1.f - lam_init, args.in[10] + l * 128, args.in[8] + l * 128, lds, tid);
                att::attn_unit(PM, PM + C_Q, NPM, bh >> 2, bh & 3, sq, lam, 1.f - lam_init, args.in[10] + l * 128, args.in[8] + l * 128, lds, tid); }
#if PROBE == 5
            for (int uu = bx; uu < 512; uu += G) { const int g4 = uu & 3, blk = uu >> 2;
                gmlp_unit(PM, XB, DM, ROWSS + (size_t)(4 + l) * M, args.in[4] + l * 512, args.in[5] + (size_t)(l * 4 + g4) * 16384, args.in[6] + (l * 4 + g4) * 128, blk * 128, g4, lds, tid); }
#endif
            for (int uu = bx; uu < 512; uu += G) { const int g4 = uu & 3, blk = uu >> 2;
                gmlp_unit(PM, PM + C_AU, NPM, ROWSS + (size_t)(4 + l) * M, args.in[4] + l * 512, args.in[5] + (size_t)(l * 4 + g4) * 16384, args.in[6] + (l * 4 + g4) * 128, blk * 128, g4, lds, tid); }
#if PROBE == 8
            conv_items(PM, XB, DM, args.in[11] + l * 1536, gtid, gthreads);
#endif
            conv_items(PM, PM + C_CB, NPM, args.in[11] + l * 1536, gtid, gthreads);
            SEAM(pb + 1);
        }
        TP_END(2);
        TP_BEGIN(3);
        if (IN(pb + 2)) {
            pg8::Gemm g{PM + C_AU, (const bf16_t*)(ws + WS_WBR), NPM, 512, (size_t)(C_Q - C_AU) * 2, (size_t)(C_CB - C_AU) * 2, MiB}; pg8::StaticOrder S; S.init(M, DM, G, bx, 3, WGM_N1);
            EpiBranch E{XB, G8};
            pg8::gemm_phase<EpiBranch, pg8::StaticOrder>(lds, g, S, E);
#if PROBE == 7
            pg8::gemm_phase<EpiBranch, pg8::StaticOrder>(lds, g, S, E);
#endif
            SEAM(pb + 2);
        }
        TP_END(3);
        TP_BEGIN(4);
        if (IN(pb + 3)) {
            pg8::Gemm g{XB, (const bf16_t*)(ws + WS_WOUT), DM, DM, 0, 0, 0}; pg8::StaticOrder S; S.init(M, DM, G, bx, 1, WGM_N1);
            EpiResid E{xres_in, args.out, XBM, ROWSS + (size_t)(2 * l + 1) * M};
#if PROBE == 9
            { EpiResid E2{args.in[0], (float*)(ws + WS_HB), nullptr, nullptr}; pg8::gemm_phase<EpiResid, pg8::StaticOrder>(lds, g, S, E2); }
#endif
            pg8::gemm_phase<EpiResid, pg8::StaticOrder>(lds, g, S, E);
            SEAM(pb + 3);
        }
        TP_END(4);
        TP_BEGIN(5);
        if (IN(pb + 4)) {
            if (l == 0) { TIDS(); convert_region_a(args, 1, lds, gw, ngw, wave, lane); }
            __syncthreads();
            pg8::Gemm g{XBM, (const bf16_t*)(ws + WS_WF1), DM, DM, 0, 0, 0}; pg8::StaticOrder S; S.init(M, FF, G, bx, 1, WGM_FF);
            EpiFF1 E{HB, ROWSS + (size_t)(2 * l + 1) * M, FF};
            pg8::gemm_phase<EpiFF1, pg8::StaticOrder>(lds, g, S, E);
#if PROBE == 3
            pg8::gemm_phase<EpiFF1, pg8::StaticOrder>(lds, g, S, E);
#endif
            SEAM(pb + 4);
        }
        TP_END(5);
        TP_BEGIN(6);
        if (IN(pb + 5)) {
            pg8::Gemm g{HB, (const bf16_t*)(ws + WS_WF2), FF, FF, 0, 0, 0}; pg8::StaticOrder S; S.init(M, DM, G, bx, 1, WGM_N1);
            EpiResid E{args.out, args.out, (l + 1 < DEPTH) ? XB : nullptr, ROWSS + (size_t)(2 * l + 2 < 4 ? 2 * l + 2 : 0) * M};
#if PROBE == 10
            { EpiFF1 E2{XBM, ROWSS + (size_t)(2 * l + 1) * M, DM}; pg8::gemm_phase<EpiFF1, pg8::StaticOrder>(lds, g, S, E2); }
#endif
            pg8::gemm_phase<EpiResid, pg8::StaticOrder>(lds, g, S, E);
            SEAM(pb + 5);
        }
        TP_END(6);
    }
#if PROBE >= 20
    if (blockIdx.x == 0 && threadIdx.x == 0) { const unsigned long long tb = __builtin_amdgcn_s_memrealtime(); while (__builtin_amdgcn_s_memrealtime() - tb < 4 * tp_acc) __builtin_amdgcn_s_sleep(8); }
#endif
#undef IN
#undef SEAM
}

extern "C" void kernel_launch(void* const* d_in, const int* in_sizes, int n_in, void* d_out, int out_size, void* d_ws, size_t ws_size, hipStream_t stream) {
    static int grid = 0;
    if (grid == 0) {
        if (n_in != 19 || in_sizes[0] != M * DM || out_size != M * DM || ws_size < WS_END) { fprintf(stderr, "kernel_launch: unexpected shapes / workspace (%d inputs, ws %zu)\n", n_in, ws_size); grid = -1; return; }
        int dev = 0, cus = 0, per_cu = 0;
        if (hipGetDevice(&dev) != hipSuccess || hipDeviceGetAttribute(&cus, hipDeviceAttributeMultiprocessorCount, dev) != hipSuccess) { grid = -1; return; }
        if (hipFuncSetAttribute((const void*)fwd_kernel, hipFuncAttributeMaxDynamicSharedMemorySize, LDS_BYTES) != hipSuccess) { fprintf(stderr, "kernel_launch: hipFuncSetAttribute failed\n"); grid = -1; return; }
        if (hipOccupancyMaxActiveBlocksPerMultiprocessor(&per_cu, (const void*)fwd_kernel, NWAVES * 64, LDS_BYTES) != hipSuccess || per_cu < 1) { fprintf(stderr, "kernel_launch: occupancy query says %d blocks per CU\n", per_cu); grid = -1; return; }
        grid = cus;
    }
    if (grid < 0) return;
    (void)hipMemsetAsync((char*)d_ws + WS_CTL, 0, CTL_BYTES, stream);
#if PROBE == 11
    (void)hipMemsetAsync((char*)d_ws + WS_END, 0, CTL_BYTES, stream);
    (void)hipMemsetAsync((char*)d_ws + WS_END + CTL_BYTES, 0, CTL_BYTES, stream);
#endif
    Args a{};
    for (int i = 0; i < 19; ++i) a.in[i] = (const float*)d_in[i];
    a.out = (float*)d_out; a.ws = (unsigned char*)d_ws;
#if MK_MULTI
    for (int p = 0; p < N_PHASES; ++p) { a.ph_lo = p; a.ph_hi = p + 1; hipLaunchKernelGGL(fwd_kernel, dim3(grid), dim3(NWAVES * 64), LDS_BYTES, stream, a); }
#else
    a.ph_lo = 0; a.ph_hi = N_PHASES;
    void* kargs[] = {&a};
#if PROBE == 12
    (void)kargs; hipLaunchKernelGGL(fwd_kernel, dim3(grid), dim3(NWAVES * 64), LDS_BYTES, stream, a); hipError_t e = hipSuccess;
#else
    hipError_t e = hipLaunchCooperativeKernel((const void*)fwd_kernel, dim3(grid), dim3(NWAVES * 64), kargs, LDS_BYTES, stream);
#endif
    if (e != hipSuccess) fprintf(stderr, "kernel_launch: cooperative launch failed: %s (grid %d)\n", hipGetErrorString(e), grid);
#endif
}
```

```cpp
#include <hip/hip_runtime.h>
#include <hip/hip_cooperative_groups.h>
#include <cstdio>
#include <cstdint>
namespace cg = cooperative_groups;

#ifndef PROBE
#define PROBE 0
#endif
#ifndef WGM_IN
#define WGM_IN 2
#endif
#ifndef WGM_FF
#define WGM_FF 2
#endif
#ifndef WGM_N1
#define WGM_N1 4
#endif
#ifndef MK_MULTI
#define MK_MULTI 0
#endif

namespace pg8 {
#define PG8_LAS __attribute__((address_space(3)))
typedef unsigned short bf16_t;
typedef short bf16x8 __attribute__((ext_vector_type(8)));
typedef float f32x4 __attribute__((ext_vector_type(4)));
typedef unsigned u32x4 __attribute__((ext_vector_type(4)));
typedef unsigned u32x2 __attribute__((ext_vector_type(2)));
constexpr int BM = 256, BK = 64, HALF = 128, HTB = HALF * BK * 2, STAGE_BYTES = 8 * HTB, NXCD = 8;

__host__ __device__ __forceinline__ int lds_byte(int r, int c) { const int st = (r >> 4) * 2 + (c >> 5), rr = r & 15, cc = c & 31, ob = rr * 64 + cc * 2; return st * 1024 + (ob ^ (((ob >> 9) & 1) << 5)); }
__host__ __device__ __forceinline__ void stage_rc(int b, int& R, int& C) { const int st = b / 1024, sb = b % 1024, swz = sb ^ (((sb >> 9) & 1) << 5); R = (st >> 1) * 16 + swz / 64; C = (st & 1) * 32 + (swz % 64) / 2; }
__host__ __device__ __forceinline__ int perm32(int rho) { const int n = rho >> 4, i = rho & 15; return 8 * (i >> 2) + 4 * n + (i & 3); }

struct Unit { int pm, pn, j; };
struct Gemm { const bf16_t* A; const bf16_t* Bt; int lda, K; size_t a_j1, a_j2, b_j;
    __device__ __forceinline__ size_t aoff(int j) const { return j == 0 ? (size_t)0 : (j == 1 ? a_j1 : a_j2); } };

struct StaticOrder {
    int nM, nN, nwg, G, c, NJ, WGM;
    __host__ __device__ void init(int M, int N, int G_, int c_, int NJ_ = 1, int WGM_ = 4) { nM = M / BM; nN = N / BM; nwg = nM * nN; G = G_; c = c_; NJ = NJ_; WGM = WGM_; }
    __host__ __device__ bool next(int i, Unit& u) const {
        const int ti = i / NJ; u.j = i - ti * NJ;
        const long L = (long)ti * G + c; if (L >= nwg) return false;
        int wgid = (int)L; { const int q = nwg / NXCD, r = nwg % NXCD, xcd = wgid % NXCD, off = wgid / NXCD; wgid = (xcd < r ? xcd * (q + 1) : r * (q + 1) + (xcd - r) * q) + off; }
        const int nig = WGM * nN, gid = wgid / nig, fm = gid * WGM, gsz = (nM - fm) < WGM ? (nM - fm) : WGM;
        u.pm = fm + ((wgid % nig) % gsz); u.pn = (wgid % nig) / gsz; return true;
    }
};

__device__ __forceinline__ unsigned cvt_pk_bf16(float lo, float hi) { unsigned r; asm volatile("v_cvt_pk_bf16_f32 %0, %1, %2" : "=v"(r) : "v"(lo), "v"(hi)); return r; }

template <class Epi, class Sched>
__device__ __forceinline__ void gemm_phase(PG8_LAS unsigned char* lds, const Gemm g, const Sched& S, const Epi& E) {
    int tid_ = threadIdx.x; asm volatile("" : "+v"(tid_));
    const int tid = tid_, wid = __builtin_amdgcn_readfirstlane(tid >> 6), lane = tid & 63, wr = wid >> 2, wc = wid & 3, fr = lane & 15, fq = lane >> 4;
    const int K = g.K, nt = K / BK, lda = g.lda;
    unsigned voffA[2], voffB[2];
#pragma unroll
    for (int i = 0; i < 2; ++i) { int R, C; stage_rc(tid * 16 + i * 8192, R, C); const int Rb = Epi::PERM ? ((R & ~31) + perm32(R & 31)) : R;
        voffA[i] = (unsigned)(R * lda + C) * 2u; voffB[i] = (unsigned)(Rb * K + C) * 2u; }
    const size_t kstep = (size_t)(BK * 2);
    const size_t hstepA = (size_t)HALF * lda * 2, hstepB = (size_t)HALF * K * 2;
    const size_t tstepA = 2 * hstepA, tstepB = 2 * hstepB;
    const unsigned ldsw = (unsigned)wid * 1024u;
    const int aoff = lds_byte(wr * 64 + fr, fq * 8), boff = lds_byte(wc * 32 + fr, fq * 8);
#define PG8_SA(b, h) (((b) * 2 + (h)) * HTB)
#define PG8_SB(b, h) ((4 + (b) * 2 + (h)) * HTB)
#define PG8_STAGE(bufoff, gbase, voff) do { _Pragma("unroll") for (int _i = 0; _i < 2; ++_i) \
        __builtin_amdgcn_global_load_lds((const unsigned*)((const char*)(gbase) + (voff)[_i]), (PG8_LAS unsigned*)(lds + (bufoff) + ldsw + _i * 8192), 16, 0, 0); } while (0)
#define PG8_LDA(dst, b, h) do { _Pragma("unroll") for (int m = 0; m < 4; ++m) _Pragma("unroll") for (int k = 0; k < 2; ++k) dst[m][k] = *(const PG8_LAS bf16x8*)(lds + PG8_SA(b, h) + aoff + m * 2048 + k * 1024); } while (0)
#define PG8_LDB(dst, b, h) do { _Pragma("unroll") for (int n = 0; n < 2; ++n) _Pragma("unroll") for (int k = 0; k < 2; ++k) dst[n][k] = *(const PG8_LAS bf16x8*)(lds + PG8_SB(b, h) + boff + n * 2048 + k * 1024); } while (0)
#define PG8_MMA(ai, bj, At, Bt) do { __builtin_amdgcn_s_setprio(1); _Pragma("unroll") for (int m = 0; m < 4; ++m) _Pragma("unroll") for (int n = 0; n < 2; ++n) _Pragma("unroll") for (int k = 0; k < 2; ++k) \
        acc[ai][bj][m][n] = __builtin_amdgcn_mfma_f32_16x16x32_bf16(Bt[n][k], At[m][k], acc[ai][bj][m][n], 0, 0, 0); __builtin_amdgcn_s_setprio(0); } while (0)
#define PG8_WAIT_V(n) asm volatile("s_waitcnt vmcnt(" #n ")" ::: "memory")
#define PG8_WAIT_L(n) asm volatile("s_waitcnt lgkmcnt(" #n ")" ::: "memory")
#define PG8_BAR __builtin_amdgcn_s_barrier()
#define PG8_SCHED __builtin_amdgcn_sched_barrier(0)
    Unit cur, nxt; int ui = 0;
    if (!S.next(0, cur)) return;
    typename Epi::Pre epre;
    f32x4 acc[2][2][4][2];
#pragma unroll
    for (int a = 0; a < 2; ++a)
#pragma unroll
        for (int b = 0; b < 2; ++b)
#pragma unroll
            for (int m = 0; m < 4; ++m)
#pragma unroll
                for (int n = 0; n < 2; ++n) acc[a][b][m][n] = (f32x4){0.f, 0.f, 0.f, 0.f};
    bf16x8 At[4][2], B0[2][2], B1[2][2];
    const char* cA = (const char*)g.A + (size_t)cur.pm * tstepA + g.aoff(cur.j); const char* cB = (const char*)g.Bt + (size_t)cur.pn * tstepB + (size_t)cur.j * g.b_j;
    {
        PG8_STAGE(PG8_SB(0, 0), cB, voffB); PG8_STAGE(PG8_SB(0, 1), cB + hstepB, voffB); PG8_STAGE(PG8_SA(0, 0), cA, voffA); PG8_STAGE(PG8_SA(0, 1), cA + hstepA, voffA);
        if (wr == 1) PG8_BAR;
        PG8_WAIT_V(2); PG8_BAR;
        PG8_STAGE(PG8_SB(1, 0), cB + kstep, voffB); PG8_STAGE(PG8_SA(1, 0), cA + kstep, voffA); PG8_STAGE(PG8_SB(1, 1), cB + hstepB + kstep, voffB);
        PG8_WAIT_V(6); PG8_BAR;
    }
    for (;;) {
        const bool has_next = S.next(ui + 1, nxt);
        const char* nA = has_next ? (const char*)g.A + (size_t)nxt.pm * tstepA + g.aoff(nxt.j) : cA; const char* nB = has_next ? (const char*)g.Bt + (size_t)nxt.pn * tstepB + (size_t)nxt.j * g.b_j : cB;
        for (int t = 0; t < nt; t += 2) {
            const bool last = (t == nt - 2);
            if (last) E.pre(epre, cur, wr, fr);
            const char* a1 = cA + (size_t)(t + 1) * kstep;
            const char* a2 = last ? nA : cA + (size_t)(t + 2) * kstep; const char* b2 = last ? nB : cB + (size_t)(t + 2) * kstep;
            const char* a3 = a2 + kstep; const char* b3 = b2 + kstep;
            PG8_LDB(B0, 0, 0); PG8_LDB(B1, 0, 1); PG8_SCHED; PG8_LDA(At, 0, 0); PG8_STAGE(PG8_SA(1, 1), a1 + hstepA, voffA);
            PG8_WAIT_V(8); PG8_WAIT_L(0); PG8_BAR; PG8_MMA(0, 0, At, B0); PG8_MMA(0, 1, At, B1); PG8_BAR; PG8_SCHED;
            PG8_LDA(At, 0, 1); PG8_STAGE(PG8_SB(0, 0), b2, voffB); PG8_STAGE(PG8_SB(0, 1), b2 + hstepB, voffB); PG8_STAGE(PG8_SA(0, 0), a2, voffA);
            PG8_WAIT_V(8); PG8_WAIT_L(0); PG8_BAR; PG8_MMA(1, 0, At, B0); PG8_MMA(1, 1, At, B1); PG8_BAR; PG8_SCHED;
            PG8_LDB(B0, 1, 0); PG8_LDB(B1, 1, 1); PG8_SCHED; PG8_LDA(At, 1, 0); PG8_STAGE(PG8_SA(0, 1), a2 + hstepA, voffA);
            PG8_WAIT_V(8); PG8_WAIT_L(0); PG8_BAR; PG8_MMA(0, 0, At, B0); PG8_MMA(0, 1, At, B1); PG8_BAR; PG8_SCHED;
            PG8_LDA(At, 1, 1); PG8_STAGE(PG8_SB(1, 0), b3, voffB); PG8_STAGE(PG8_SB(1, 1), b3 + hstepB, voffB); PG8_STAGE(PG8_SA(1, 0), a3, voffA);
            PG8_WAIT_V(8); PG8_WAIT_L(0); PG8_BAR; PG8_MMA(1, 0, At, B0); PG8_MMA(1, 1, At, B1); PG8_BAR; PG8_SCHED;
        }
        if (wr == 0) PG8_BAR;
        E(acc, cur, wr, wc, fr, fq, epre);
        if (!has_next) break;
        if (!(Epi::ACCUM && nxt.j != 0)) {
#pragma unroll
        for (int a = 0; a < 2; ++a)
#pragma unroll
            for (int b = 0; b < 2; ++b)
#pragma unroll
                for (int m = 0; m < 4; ++m)
#pragma unroll
                    for (int n = 0; n < 2; ++n) acc[a][b][m][n] = (f32x4){0.f, 0.f, 0.f, 0.f};
        }
        cur = nxt; cA = nA; cB = nB; ++ui;
        if (wr == 1) PG8_BAR;
    }
    PG8_WAIT_V(0);
    PG8_BAR;
#undef PG8_SA
#undef PG8_SB
#undef PG8_STAGE
#undef PG8_LDA
#undef PG8_LDB
#undef PG8_MMA
#undef PG8_WAIT_V
#undef PG8_WAIT_L
#undef PG8_BAR
#undef PG8_SCHED
}
}

using pg8::bf16_t; using pg8::f32x4; using pg8::u32x4; using pg8::u32x2; using pg8::cvt_pk_bf16;
#define LAS __attribute__((address_space(3)))

constexpr int DM = 1024, NB = 4, SEQ = 4096, M = NB * SEQ, DEPTH = 2;
constexpr int NIN = 7168, NPM = 4096, NG = 3072, FF = 4096;
constexpr int C_AU = 0, C_AV = 512, C_Q = 1024, C_K = 1536, C_V = 2048, C_CB = 2560, C_CC = 3072, C_CX = 3584;
constexpr float EPS = 1e-6f;
constexpr float LOG2E = 1.4426950408889634f;

constexpr size_t MiB = 1u << 20;
constexpr size_t WS_CTL = 0, CTL_BYTES = 1 * MiB, WS_BAR = 512 * 1024;
constexpr size_t WS_WIN = 1 * MiB, WS_WBR = 15 * MiB, WS_WOUT = 18 * MiB;
constexpr size_t WS_WF1 = 20 * MiB, WS_WF2 = 28 * MiB;
constexpr size_t WS_XB = 36 * MiB;
constexpr size_t WS_PM = 68 * MiB;
constexpr size_t WS_G8 = 196 * MiB;
constexpr size_t WS_HB = 100 * MiB;
constexpr size_t WS_END = 244 * MiB;

constexpr int NWAVES = 8;
constexpr int RING_BYTES = 131072, LDS_BYTES = 139264;

struct Args { const float* in[19]; float* out; unsigned char* ws; int ph_lo, ph_hi; };

#define GAS __attribute__((address_space(1)))
#define XB_TMO      128
#define XB_XCNT(j)  (256  + 64 * (j))
#define XB_XSUB(j)  (1280 + 64 * (j))
#define XB_XGEN(j)  (2304 + 64 * (j))
#define XB_TOP      3328
#define XB_TOPGEN   3392
#define XCD_BAR_WORDS 3456
#define XB_SPIN_CAP (1u << 18)

__device__ __forceinline__ unsigned xb_ld(unsigned* p)              { return __hip_atomic_load(p, __ATOMIC_RELAXED, __HIP_MEMORY_SCOPE_AGENT); }
__device__ __forceinline__ unsigned xb_add(unsigned* p, unsigned v) { return __hip_atomic_fetch_add(p, v, __ATOMIC_RELAXED, __HIP_MEMORY_SCOPE_AGENT); }
__device__ __forceinline__ unsigned xb_xcc_id() { return (unsigned)__builtin_amdgcn_s_getreg((3 << 11) | 20) & 0xFu; }
#define XB_SPIN(cond, bar) do { unsigned _sp = 0; while (cond) { __builtin_amdgcn_s_sleep(1); \
    if ((++_sp & 255u) == 0u) { if (xb_ld(&(bar)[XB_TMO])) break; if (_sp > XB_SPIN_CAP) { atomicAdd(&(bar)[XB_TMO], 1u); break; } } } } while (0)

struct XcdBarrier {
    unsigned* bar; unsigned x;
    volatile LAS unsigned* st;
};

__device__ __forceinline__ XcdBarrier xcd_barrier_post(unsigned* bar, volatile LAS unsigned* st) {
    XcdBarrier b; b.bar = bar; b.x = xb_xcc_id(); b.st = st;
    if (threadIdx.x == 0) (void)xb_add(&bar[XB_XCNT(b.x)], 1u);
    return b;
}
__device__ __forceinline__ void xcd_barrier_complete(unsigned* bar, unsigned x, unsigned& nloc, unsigned& nx) {
    const unsigned G = gridDim.x * gridDim.y * gridDim.z;
    unsigned sum, cnt, mine, sp = 0u;
    for (;;) {
        sum = 0u; cnt = 0u; mine = 0u;
#pragma unroll
        for (unsigned j = 0; j < 16; ++j) { const unsigned c = xb_ld(&bar[XB_XCNT(j)]); sum += c; cnt += (c > 0u) ? 1u : 0u; mine = (j == x) ? c : mine; }
        if (sum == G) break;
        __builtin_amdgcn_s_sleep(1);
        if ((++sp & 255u) == 0u) { if (xb_ld(&bar[XB_TMO])) break; if (sp > XB_SPIN_CAP) { atomicAdd(&bar[XB_TMO], 1u); break; } }
    }
    nloc = mine > 0u ? mine : 1u; nx = cnt > 0u ? cnt : 1u;
}

__device__ __forceinline__ void xcd_barrier(const XcdBarrier& b) {
    asm volatile("s_waitcnt vmcnt(0)" ::: "memory");
    __syncthreads();
    if (threadIdx.x == 0) {
        unsigned* bar = b.bar;
        __builtin_amdgcn_s_waitcnt(0);
        unsigned nloc = b.st[0], nx = b.st[1];
        if (nloc == 0u) { xcd_barrier_complete(bar, b.x, nloc, nx); b.st[0] = nloc; b.st[1] = nx; }
        const unsigned old = xb_add(&bar[XB_XSUB(b.x)], 1u);
        const unsigned gen = old / nloc;
        if (old + 1u == (gen + 1u) * nloc) {
            __builtin_amdgcn_fence(__ATOMIC_RELEASE, "agent");
            asm volatile("s_waitcnt vmcnt(0)" ::: "memory");
            const unsigned og = xb_add(&bar[XB_TOP], 1u);
            const unsigned tg = og / nx;
            if (og + 1u == (tg + 1u) * nx) xb_add(&bar[XB_TOPGEN], 1u);
            else XB_SPIN(xb_ld(&bar[XB_TOPGEN]) == tg, bar);
            __builtin_amdgcn_fence(__ATOMIC_ACQUIRE, "agent");
            asm volatile("s_waitcnt vmcnt(0)" ::: "memory");
        } else {
            XB_SPIN(xb_ld(&bar[XB_TOPGEN]) == gen, bar);
            __builtin_amdgcn_fence(__ATOMIC_ACQUIRE, "agent");
            asm volatile("s_waitcnt vmcnt(0)" ::: "memory");
        }
    }
    __syncthreads();
}

__device__ __forceinline__ float bf_lo(unsigned w) { return __uint_as_float(w << 16); }
__device__ __forceinline__ float bf_hi(unsigned w) { return __uint_as_float(w & 0xffff0000u); }
__device__ __forceinline__ float wave_sum(float v) {
#pragma unroll
    for (int o = 1; o < 64; o <<= 1) v += __shfl_xor(v, o);
    return v;
}
__device__ __forceinline__ float gelu_tanh(float x) {
    const float u = 0.7978845608028654f * (x + 0.044715f * x * x * x);
    return x * __builtin_amdgcn_rcpf(1.f + __builtin_amdgcn_exp2f(-2.f * LOG2E * u));
}
__device__ __forceinline__ float sigmoidf(float x) { return __builtin_amdgcn_rcpf(1.f + __builtin_amdgcn_exp2f(-LOG2E * x)); }
__device__ __forceinline__ float g8f(unsigned b) { return ((float)b + 0.5f) * (1.f / 256.f); }

__device__ __forceinline__ int inproj_phys(int n) {
    if (n < C_Q || n >= C_V) return n;
    const int t = n & ~255, g = (n & 255) >> 6, d = n & 63;
    return t + ((d >> 5) << 7) + (g << 5) + (d & 31);
}

struct EpiInProj {
    static constexpr bool PERM = true, ACCUM = false;
    bf16_t* PM; unsigned char* G8; const float* rowss; const float* gate_b; const float* qnw; const float* knw; float* avss;
    struct Pre { float v[2][4]; };
    __device__ __forceinline__ void pre(Pre& p, const pg8::Unit& u, int wr, int fr) const {
        const int row0 = u.pm * 256 + wr * 64 + fr;
#pragma unroll
        for (int ai = 0; ai < 2; ++ai)
#pragma unroll
            for (int m = 0; m < 4; ++m) p.v[ai][m] = rowss[row0 + ai * 128 + m * 16];
    }
    __device__ __forceinline__ void operator()(f32x4 (&acc)[2][2][4][2], const pg8::Unit& u, int wr, int wc, int fr, int fq, const Pre& p) const {
        const int row0 = u.pm * 256 + wr * 64 + fr;
        float rs[2][4];
#pragma unroll
        for (int ai = 0; ai < 2; ++ai)
#pragma unroll
            for (int m = 0; m < 4; ++m) rs[ai][m] = rsqrtf(p.v[ai][m] * (1.f / DM) + EPS);
        const int pn = u.pn;
        if (pn < 4) {
            const int col0 = pn * 256 + wc * 32 + 8 * fq;
#pragma unroll
            for (int ai = 0; ai < 2; ++ai)
#pragma unroll
                for (int m = 0; m < 4; ++m) { bf16_t* rowp = PM + (size_t)(row0 + ai * 128 + m * 16) * NPM + col0; const float r = rs[ai][m]; float ss = 0.f;
#pragma unroll
                    for (int bj = 0; bj < 2; ++bj) { const f32x4 v0 = acc[ai][bj][m][0] * r, v1 = acc[ai][bj][m][1] * r; u32x4 w; float gl[8];
#pragma unroll
                        for (int e = 0; e < 4; ++e) { gl[e] = gelu_tanh(v0[e]); gl[4 + e] = gelu_tanh(v1[e]); }
#pragma unroll
                        for (int e = 0; e < 8; ++e) ss += gl[e] * gl[e];
                        w.x = cvt_pk_bf16(gl[0], gl[1]); w.y = cvt_pk_bf16(gl[2], gl[3]); w.z = cvt_pk_bf16(gl[4], gl[5]); w.w = cvt_pk_bf16(gl[6], gl[7]);
                        *(u32x4*)(rowp + bj * 128) = w; }
                    if (pn >= 2) { ss += __shfl_xor(ss, 16); ss += __shfl_xor(ss, 32); if (fq == 0) atomicAdd(avss + row0 + ai * 128 + m * 16, ss); } }
        } else if (pn < 8) {
            const bool isq = pn < 6;
            const float* nw = (isq ? qnw : knw) + (wc & 1) * 64 + 8 * fq;
            const float extra = isq ? 0.125f * LOG2E : 1.f;
            float wv[2][8];
#pragma unroll
            for (int bj = 0; bj < 2; ++bj)
#pragma unroll
                for (int i = 0; i < 8; ++i) wv[bj][i] = nw[32 * bj + i] * extra;
            const int col0 = pn * 256 + 64 * wc + 8 * fq;
#pragma unroll
            for (int ai = 0; ai < 2; ++ai)
#pragma unroll
                for (int m = 0; m < 4; ++m) { bf16_t* rowp = PM + (size_t)(row0 + ai * 128 + m * 16) * NPM + col0; const float r = rs[ai][m];
                    f32x4 v[2][2]; float ss = 0.f;
#pragma unroll
                    for (int bj = 0; bj < 2; ++bj)
#pragma unroll
                        for (int n = 0; n < 2; ++n) { v[bj][n] = acc[ai][bj][m][n] * r; const f32x4 x = v[bj][n]; ss += (x[0] * x[0] + x[1] * x[1]) + (x[2] * x[2] + x[3] * x[3]); }
                    ss += __shfl_xor(ss, 16); ss += __shfl_xor(ss, 32);
                    const float rn = rsqrtf(ss * (1.f / 64.f) + EPS);
#pragma unroll
                    for (int bj = 0; bj < 2; ++bj) { const f32x4 v0 = v[bj][0] * rn, v1 = v[bj][1] * rn; u32x4 w;
                        w.x = cvt_pk_bf16(v0[0] * wv[bj][0], v0[1] * wv[bj][1]); w.y = cvt_pk_bf16(v0[2] * wv[bj][2], v0[3] * wv[bj][3]);
                        w.z = cvt_pk_bf16(v1[0] * wv[bj][4], v1[1] * wv[bj][5]); w.w = cvt_pk_bf16(v1[2] * wv[bj][6], v1[3] * wv[bj][7]);
                        *(u32x4*)(rowp + bj * 32) = w; } }
        } else if (pn < 16) {
            const int col0 = pn * 256 + wc * 32 + 8 * fq;
#pragma unroll
            for (int ai = 0; ai < 2; ++ai)
#pragma unroll
                for (int m = 0; m < 4; ++m) { bf16_t* rowp = PM + (size_t)(row0 + ai * 128 + m * 16) * NPM + col0; const float r = rs[ai][m];
#pragma unroll
                    for (int bj = 0; bj < 2; ++bj) { const f32x4 v0 = acc[ai][bj][m][0] * r, v1 = acc[ai][bj][m][1] * r; u32x4 w;
                        w.x = cvt_pk_bf16(v0[0], v0[1]); w.y = cvt_pk_bf16(v0[2], v0[3]); w.z = cvt_pk_bf16(v1[0], v1[1]); w.w = cvt_pk_bf16(v1[2], v1[3]);
                        *(u32x4*)(rowp + bj * 128) = w; } }
        } else {
            const int col0 = (pn - 16) * 256 + wc * 32 + 8 * fq;
            f32x4 bv[2][2];
#pragma unroll
            for (int bj = 0; bj < 2; ++bj)
#pragma unroll
                for (int n = 0; n < 2; ++n) bv[bj][n] = *(const f32x4*)(gate_b + col0 + bj * 128 + 4 * n);
#pragma unroll
            for (int ai = 0; ai < 2; ++ai)
#pragma unroll
                for (int m = 0; m < 4; ++m) { unsigned char* rowp = G8 + (size_t)(row0 + ai * 128 + m * 16) * NG + col0; const float r = rs[ai][m];
#pragma unroll
                    for (int bj = 0; bj < 2; ++bj) { unsigned q[8];
#pragma unroll
                        for (int n = 0; n < 2; ++n)
#pragma unroll
                            for (int e = 0; e < 4; ++e) { const float gx = sigmoidf(acc[ai][bj][m][n][e] * r + bv[bj][n][e]); q[4 * n + e] = (unsigned)__builtin_fminf(gx * 256.f, 255.f); }
                        u32x2 w; w.x = q[0] | (q[1] << 8) | (q[2] << 16) | (q[3] << 24); w.y = q[4] | (q[5] << 8) | (q[6] << 16) | (q[7] << 24);
                        *(u32x2*)(rowp + bj * 128) = w; } }
        }
    }
};

struct EpiBranch {
    static constexpr bool PERM = true, ACCUM = true;
    bf16_t* O; const unsigned char* G8;
    struct Pre { };
    __device__ __forceinline__ void pre(Pre&, const pg8::Unit&, int, int) const {}
    __device__ __forceinline__ void operator()(f32x4 (&acc)[2][2][4][2], const pg8::Unit& u, int wr, int wc, int fr, int fq, const Pre&) const {
        const int row0 = u.pm * 256 + wr * 64 + fr, col0 = u.pn * 256 + wc * 32 + 8 * fq, j = u.j;
#pragma unroll
        for (int ai = 0; ai < 2; ++ai) {
            u32x2 ga[4][2], gb[4][2];
#pragma unroll
            for (int m = 0; m < 4; ++m)
#pragma unroll
                for (int bj = 0; bj < 2; ++bj) { const size_t row = (size_t)(row0 + ai * 128 + m * 16);
                    ga[m][bj] = *(const u32x2*)(G8 + row * NG + j * 1024 + col0 + bj * 128);
                    gb[m][bj] = (j < 2) ? *(const u32x2*)(G8 + row * NG + (j + 1) * 1024 + col0 + bj * 128) : (u32x2){0u, 0u}; }
#pragma unroll
            for (int m = 0; m < 4; ++m) { const size_t row = (size_t)(row0 + ai * 128 + m * 16);
#pragma unroll
                for (int bj = 0; bj < 2; ++bj) {
                    float f[8];
#pragma unroll
                    for (int e = 0; e < 4; ++e) { f[e] = g8f((ga[m][bj].x >> (8 * e)) & 0xffu); f[4 + e] = g8f((ga[m][bj].y >> (8 * e)) & 0xffu); }
                    if (j < 2) {
#pragma unroll
                        for (int e = 0; e < 4; ++e) { f[e] *= __builtin_amdgcn_rcpf(g8f((gb[m][bj].x >> (8 * e)) & 0xffu)); f[4 + e] *= __builtin_amdgcn_rcpf(g8f((gb[m][bj].y >> (8 * e)) & 0xffu)); }
                    }
#pragma unroll
                    for (int e = 0; e < 4; ++e) { acc[ai][bj][m][0][e] *= f[e]; acc[ai][bj][m][1][e] *= f[4 + e]; }
                    if (j == 2) { const f32x4 v0 = acc[ai][bj][m][0], v1 = acc[ai][bj][m][1]; u32x4 w;
                        w.x = cvt_pk_bf16(v0[0], v0[1]); w.y = cvt_pk_bf16(v0[2], v0[3]); w.z = cvt_pk_bf16(v1[0], v1[1]); w.w = cvt_pk_bf16(v1[2], v1[3]);
                        *(u32x4*)(O + row * DM + col0 + bj * 128) = w; }
                } }
        }
    }
};

struct EpiResid {
    static constexpr bool PERM = false, ACCUM = false;
    const float* xin_f; const bf16_t* xin_b; float* xout_f; bf16_t* xb; float* rowss;
    struct Pre { };
    __device__ __forceinline__ void pre(Pre&, const pg8::Unit&, int, int) const {}
    __device__ __forceinline__ void operator()(f32x4 (&acc)[2][2][4][2], const pg8::Unit& u, int wr, int wc, int fr, int fq, const Pre&) const {
        const int row0 = u.pm * 256 + wr * 64 + fr, col0 = u.pn * 256 + wc * 32 + 4 * fq;
#pragma unroll
        for (int ai = 0; ai < 2; ++ai) {
            f32x4 xr[4][2][2];
            if (xin_f) {
#pragma unroll
                for (int m = 0; m < 4; ++m)
#pragma unroll
                    for (int bj = 0; bj < 2; ++bj)
#pragma unroll
                        for (int n = 0; n < 2; ++n) xr[m][bj][n] = *(const f32x4*)(xin_f + (size_t)(row0 + ai * 128 + m * 16) * DM + col0 + bj * 128 + n * 16);
            } else {
                u32x2 xh[4][2][2];
#pragma unroll
                for (int m = 0; m < 4; ++m)
#pragma unroll
                    for (int bj = 0; bj < 2; ++bj)
#pragma unroll
                        for (int n = 0; n < 2; ++n) xh[m][bj][n] = *(const u32x2*)(xin_b + (size_t)(row0 + ai * 128 + m * 16) * DM + col0 + bj * 128 + n * 16);
#pragma unroll
                for (int m = 0; m < 4; ++m)
#pragma unroll
                    for (int bj = 0; bj < 2; ++bj)
#pragma unroll
                        for (int n = 0; n < 2; ++n) { const u32x2 h = xh[m][bj][n]; xr[m][bj][n] = (f32x4){bf_lo(h.x), bf_hi(h.x), bf_lo(h.y), bf_hi(h.y)}; }
            }
#pragma unroll
            for (int m = 0; m < 4; ++m) { const int row = row0 + ai * 128 + m * 16; const size_t off = (size_t)row * DM + col0; float ss = 0.f;
#pragma unroll
                for (int bj = 0; bj < 2; ++bj)
#pragma unroll
                    for (int n = 0; n < 2; ++n) { const size_t o = off + bj * 128 + n * 16; const f32x4 x = xr[m][bj][n] + acc[ai][bj][m][n];
                        if (xout_f) *(f32x4*)(xout_f + o) = x;
                        if (xb) { u32x2 w; w.x = cvt_pk_bf16(x[0], x[1]); w.y = cvt_pk_bf16(x[2], x[3]); *(u32x2*)(xb + o) = w; ss += (x[0] * x[0] + x[1] * x[1]) + (x[2] * x[2] + x[3] * x[3]); } }
                if (xb) { ss += __shfl_xor(ss, 16); ss += __shfl_xor(ss, 32); if (fq == 0) atomicAdd(rowss + row, ss); } }
        }
    }
};

struct EpiFF1 {
    static constexpr bool PERM = true, ACCUM = false;
    bf16_t* O; const float* rowss; int ldc;
    struct Pre { float v[2][4]; };
    __device__ __forceinline__ void pre(Pre& p, const pg8::Unit& u, int wr, int fr) const {
        const int row0 = u.pm * 256 + wr * 64 + fr;
#pragma unroll
        for (int ai = 0; ai < 2; ++ai)
#pragma unroll
            for (int m = 0; m < 4; ++m) p.v[ai][m] = rowss[row0 + ai * 128 + m * 16];
    }
    __device__ __forceinline__ void operator()(f32x4 (&acc)[2][2][4][2], const pg8::Unit& u, int wr, int wc, int fr, int fq, const Pre& p) const {
        const int row0 = u.pm * 256 + wr * 64 + fr, col0 = u.pn * 256 + wc * 32 + 8 * fq;
        float rsv[2][4];
#pragma unroll
        for (int ai = 0; ai < 2; ++ai)
#pragma unroll
            for (int m = 0; m < 4; ++m) rsv[ai][m] = rsqrtf(p.v[ai][m] * (1.f / DM) + EPS);
#pragma unroll
        for (int ai = 0; ai < 2; ++ai)
#pragma unroll
            for (int m = 0; m < 4; ++m) { const int row = row0 + ai * 128 + m * 16; const float r = rsv[ai][m]; bf16_t* rowp = O + (size_t)row * ldc + col0;
#pragma unroll
                for (int bj = 0; bj < 2; ++bj) { f32x4 v0 = acc[ai][bj][m][0] * r, v1 = acc[ai][bj][m][1] * r;
#pragma unroll
                    for (int e = 0; e < 4; ++e) { const float a = __builtin_fmaxf(v0[e], 0.f), b = __builtin_fmaxf(v1[e], 0.f); v0[e] = a * a; v1[e] = b * b; }
                    u32x4 w; w.x = cvt_pk_bf16(v0[0], v0[1]); w.y = cvt_pk_bf16(v0[2], v0[3]); w.z = cvt_pk_bf16(v1[0], v1[1]); w.w = cvt_pk_bf16(v1[2], v1[3]);
                    *(u32x4*)(rowp + bj * 128) = w; } }
    }
};

template <bool INPERM>
__device__ __forceinline__ void transpose_item(const float* W, const float* kscale, int K, int N, bf16_t* WT, LAS float* scr, int item, int lane) {
    const int nblk = N / 32, kb = item / nblk, nb = item % nblk, k0 = 64 * kb, n0 = 32 * nb;
    float v[32];
#pragma unroll
    for (int i = 0; i < 32; ++i) { const int kk = 2 * i + (lane >> 5); v[i] = W[(size_t)(k0 + kk) * N + n0 + (lane & 31)]; }
    if (kscale) {
#pragma unroll
        for (int i = 0; i < 32; ++i) v[i] *= kscale[k0 + 2 * i + (lane >> 5)]; }
#pragma unroll
    for (int i = 0; i < 32; ++i) { const int kk = 2 * i + (lane >> 5); scr[kk * 33 + (lane & 31)] = v[i]; }
    asm volatile("s_waitcnt lgkmcnt(0)" ::: "memory");
    const int c = lane & 7;
    const int r0 = INPERM ? inproj_phys(n0) : n0;
#pragma unroll
    for (int j = 0; j < 4; ++j) { const int n = (lane >> 3) + 8 * j; const LAS float* s = scr + (8 * c) * 33 + n;
        u32x4 o; o.x = cvt_pk_bf16(s[0 * 33], s[1 * 33]); o.y = cvt_pk_bf16(s[2 * 33], s[3 * 33]); o.z = cvt_pk_bf16(s[4 * 33], s[5 * 33]); o.w = cvt_pk_bf16(s[6 * 33], s[7 * 33]);
        *(u32x4*)(WT + (size_t)(r0 + n) * K + k0 + 8 * c) = o; }
    asm volatile("s_waitcnt lgkmcnt(0)" ::: "memory");
}
constexpr int IT_WIN = 16 * 224, IT_BR = 8 * 32, IT_OUT = 16 * 32, IT_F1 = 16 * 128, IT_F2 = 64 * 32;
__device__ __forceinline__ void convert_region_a(const Args& a, int l, LAS unsigned char* lds, int gw, int ngw, int wave, int lane) {
    LAS float* scr = (LAS float*)(lds + wave * 16384);
    unsigned char* ws = a.ws;
    constexpr int NIT = IT_WIN + 3 * IT_BR + IT_OUT;
    for (int it = gw; it < NIT; it += ngw) {
        int r = it;
        if (r < IT_WIN) { transpose_item<true>(a.in[2] + (size_t)l * DM * NIN, a.in[1] + l * DM, DM, NIN, (bf16_t*)(ws + WS_WIN), scr, r, lane); continue; } r -= IT_WIN;
        if (r < 3 * IT_BR) { const int j = r / IT_BR; transpose_item<false>(a.in[12 + j] + (size_t)l * 512 * DM, nullptr, 512, DM, (bf16_t*)(ws + WS_WBR + j * MiB), scr, r % IT_BR, lane); continue; } r -= 3 * IT_BR;
        transpose_item<false>(a.in[15] + (size_t)l * DM * DM, nullptr, DM, DM, (bf16_t*)(ws + WS_WOUT), scr, r, lane);
    }
}
__device__ __forceinline__ void convert_region_b(const Args& a, int l, LAS unsigned char* lds, int gw, int ngw, int wave, int lane) {
    LAS float* scr = (LAS float*)(lds + wave * 16384);
    unsigned char* ws = a.ws;
    constexpr int NIT = IT_F1 + IT_F2;
    for (int it = gw; it < NIT; it += ngw) {
        int r = it;
        if (r < IT_F1) { transpose_item<false>(a.in[17] + (size_t)l * DM * FF, a.in[16] + l * DM, DM, FF, (bf16_t*)(ws + WS_WF1), scr, r, lane); continue; } r -= IT_F1;
        transpose_item<false>(a.in[18] + (size_t)l * FF * DM, nullptr, FF, DM, (bf16_t*)(ws + WS_WF2), scr, r, lane);
    }
}

namespace att {
typedef short bf16x8 __attribute__((ext_vector_type(8)));
typedef short s16x4 __attribute__((ext_vector_type(4)));
typedef short v4i16_t __attribute__((ext_vector_type(4)));
typedef float f32x16 __attribute__((ext_vector_type(16)));
typedef float f32x8 __attribute__((ext_vector_type(8)));
typedef float f32x2_t __attribute__((ext_vector_type(2))); typedef __bf16 bf16x2_t __attribute__((ext_vector_type(2)));
__device__ __forceinline__ unsigned cvtpk_s(float lo, float hi) { f32x2_t v = {lo, hi}; bf16x2_t b = __builtin_convertvector(v, bf16x2_t); return __builtin_bit_cast(unsigned, b); }
__device__ __forceinline__ s16x4 vtr(const LAS unsigned char* p) { return __builtin_bit_cast(s16x4, __builtin_amdgcn_ds_read_tr16_b64_v4i16((LAS v4i16_t*)p)); }
constexpr int KSTR = 144, VSTR = 320, KMAP = 64 * KSTR, V_OFF = 2 * KMAP, BUF = V_OFF + 64 * VSTR;
__device__ __forceinline__ bf16x8 pack8(const f32x16& p, int o) {
    u32x4 w; w.x = cvtpk_s(p[o], p[o + 1]); w.y = cvtpk_s(p[o + 2], p[o + 3]); w.z = cvtpk_s(p[o + 4], p[o + 5]); w.w = cvtpk_s(p[o + 6], p[o + 7]); return __builtin_bit_cast(bf16x8, w); }

__device__ __forceinline__ void attn_unit(bf16_t* PM, bf16_t* obase, int opitch, int b, int h, int qb, float lam, float post, const float* subw, const float* knw, LAS unsigned char* lds, int tid_in) {
    int tid = tid_in; asm volatile("" : "+v"(tid));
    const int lane = tid & 63, wid = __builtin_amdgcn_readfirstlane(tid >> 6), r32 = lane & 31, hi = lane >> 5, m = wid >> 2, qs = wid & 3;
    const int qpos = 128 * qb + 32 * qs + r32;
    bf16_t* base = PM + (size_t)b * SEQ * NPM;
    bf16_t* qrow = base + (size_t)qpos * NPM + C_Q + h * 128;
    bf16_t* orow = obase + (size_t)(b * SEQ + qpos) * opitch + h * 128;
    bf16x8 qr[4];
#pragma unroll
    for (int d0 = 0; d0 < 4; ++d0) qr[d0] = *(const bf16x8*)(qrow + m * 64 + d0 * 16 + hi * 8);
    bool need_check;
    { float qn2 = 0.f;
#pragma unroll
      for (int d0 = 0; d0 < 4; ++d0) { const u32x4 w = __builtin_bit_cast(u32x4, qr[d0]);
          const float a0 = bf_lo(w.x), a1 = bf_hi(w.x), a2 = bf_lo(w.y), a3 = bf_hi(w.y), a4 = bf_lo(w.z), a5 = bf_hi(w.z), a6 = bf_lo(w.w), a7 = bf_hi(w.w);
          qn2 += (a0 * a0 + a1 * a1) + (a2 * a2 + a3 * a3) + (a4 * a4 + a5 * a5) + (a6 * a6 + a7 * a7); }
      qn2 += __shfl_xor(qn2, 32);
      float wk = __builtin_fmaxf(__builtin_fabsf(knw[lane]), __builtin_fabsf(knw[64 + lane]));
#pragma unroll
      for (int o = 1; o < 64; o <<= 1) wk = __builtin_fmaxf(wk, __shfl_xor(wk, o));
      need_check = __any(sqrtf(qn2) * 8.f * wk * 1.02f > 40.f); }
    const int NT = 2 * (qb + 1), my_nt = (qs < 2) ? NT - 1 : NT;
    const float sl2 = __builtin_amdgcn_exp2f(-2.f * (float)(h + 1)) * LOG2E;
    const bf16_t* gk = base + (size_t)(tid >> 3) * NPM + C_K + h * 128 + (tid & 7) * 8;
    const bf16_t* gv = base + (size_t)(tid >> 4) * NPM + C_V + h * 128 + (tid & 15) * 8;
    const int lk = (tid >> 3) * KSTR + (tid & 7) * 16, lv = V_OFF + (tid >> 4) * VSTR + (tid & 15) * 16;
    u32x4 st0, st1, st2, st3;
#define ATT_LOAD(t) do { const size_t ro = (size_t)(t) * 64 * NPM; st0 = *(const u32x4*)(gk + ro); st1 = *(const u32x4*)(gk + ro + 64); st2 = *(const u32x4*)(gv + ro); st3 = *(const u32x4*)(gv + ro + (size_t)32 * NPM); } while (0)
#define ATT_STORE(bufp) do { *(LAS u32x4*)((bufp) + lk) = st0; *(LAS u32x4*)((bufp) + KMAP + lk) = st1; *(LAS u32x4*)((bufp) + lv) = st2; *(LAS u32x4*)((bufp) + lv + 32 * VSTR) = st3; } while (0)
    __syncthreads();
    ATT_LOAD(0); ATT_STORE(lds);
    __syncthreads();
    f32x16 OT[4];
#pragma unroll
    for (int eb = 0; eb < 4; ++eb)
#pragma unroll
        for (int r = 0; r < 16; ++r) OT[eb][r] = 0.f;
    float mref = 0.f, lsum = 0.f;
    const float s64 = 64.f * sl2;
    const float s32 = 32.f * sl2;
    f32x16 ci0;
#pragma unroll
    for (int r = 0; r < 16; ++r) ci0[r] = sl2 * (float)(4 * hi + (r & 3) + 8 * (r >> 2) - qpos);
    for (int t = 0; t < NT; ++t) {
        LAS unsigned char* buf = lds + (t & 1) * BUF;
        if (t + 1 < NT) ATT_LOAD(t + 1);
        if (t < my_nt) {
            const LAS unsigned char* kp = buf + m * KMAP + r32 * KSTR + hi * 16;
            f32x16 p0 = ci0, p1 = ci0 + s32;
            if (t == my_nt - 1) {
                int hid = hi; asm volatile("" : "+v"(hid));
                const float qf = (float)qpos, k0 = (float)(64 * t + 4 * hid), cadd = -mref;
#pragma unroll
                for (int r = 0; r < 16; ++r) { const float kf = k0 + (float)((r & 3) + 8 * (r >> 2));
                    p0[r] = __builtin_fmaf(-sl2, __builtin_fabsf(qf - kf), cadd); p1[r] = __builtin_fmaf(-sl2, __builtin_fabsf(qf - (kf + 32.f)), cadd); }
            }
            bf16x8 ka[4], kb2[4];
#pragma unroll
            for (int d0 = 0; d0 < 4; ++d0) { ka[d0] = *(const LAS bf16x8*)(kp + d0 * 32); kb2[d0] = *(const LAS bf16x8*)(kp + 32 * KSTR + d0 * 32); }
#pragma unroll
            for (int d0 = 0; d0 < 4; ++d0) {
                p0 = __builtin_amdgcn_mfma_f32_32x32x16_bf16(ka[d0], qr[d0], p0, 0, 0, 0);
                p1 = __builtin_amdgcn_mfma_f32_32x32x16_bf16(kb2[d0], qr[d0], p1, 0, 0, 0);
            }
            const LAS unsigned char* vp = buf + V_OFF + (4 * hi + ((lane & 15) >> 2)) * VSTR + ((lane >> 4) & 1) * 32 + (lane & 3) * 8;
            s16x4 vlo[2][4], vhi[2][4];
#pragma unroll
            for (int eb = 0; eb < 4; ++eb) { vlo[0][eb] = vtr(vp + eb * 64); vhi[0][eb] = vtr(vp + 8 * VSTR + eb * 64); }
            float mt = 0.f;
            if (need_check) { mt = __builtin_fmaxf(p0[0], p1[0]);
#pragma unroll
                for (int r = 1; r < 16; ++r) mt = __builtin_fmaxf(__builtin_fmaxf(mt, p0[r]), p1[r]);
                mt = __builtin_fmaxf(mt, __shfl_xor(mt, 32)); }
            if (need_check && __any(mt > 40.f)) {
                const float dl = __builtin_fmaxf(mt, 0.f), f = __builtin_amdgcn_exp2f(-dl);
                mref += dl; lsum *= f; p0 -= dl; p1 -= dl; ci0 -= dl;
#pragma unroll
                for (int eb = 0; eb < 4; ++eb) OT[eb] *= f;
            }
#if PROBE == 13
            { float dz = 0.f;
#pragma unroll
              for (int r = 0; r < 16; ++r) { dz += __builtin_amdgcn_exp2f(p0[r] + 1.f) + __builtin_amdgcn_exp2f(p1[r] + 1.f); }
              asm volatile("" :: "v"(dz)); }
#endif
#if PROBE == 14
            { f32x16 dacc = p0;
#pragma unroll
              for (int d0 = 0; d0 < 4; ++d0) { dacc = __builtin_amdgcn_mfma_f32_32x32x16_bf16(ka[d0], qr[d0], dacc, 0, 0, 0); dacc = __builtin_amdgcn_mfma_f32_32x32x16_bf16(kb2[d0], qr[d0], dacc, 0, 0, 0); }
              asm volatile("" :: "v"(dacc)); }
#endif
#pragma unroll
            for (int r = 0; r < 16; ++r) { p0[r] = __builtin_amdgcn_exp2f(p0[r]); p1[r] = __builtin_amdgcn_exp2f(p1[r]); }
            { const f32x16 s16 = p0 + p1; const f32x8 s8 = s16.lo + s16.hi; const f32x4 s4v = s8.lo + s8.hi; const f32x2_t s2 = s4v.lo + s4v.hi; lsum += s2.x + s2.y; }
            ci0 += s64;
            bf16x8 pf[4]; pf[0] = pack8(p0, 0); pf[1] = pack8(p0, 8); pf[2] = pack8(p1, 0); pf[3] = pack8(p1, 8);
#pragma unroll
            for (int s4 = 0; s4 < 4; ++s4) {
                if (s4 < 3) {
#pragma unroll
                    for (int eb = 0; eb < 4; ++eb) { vlo[(s4 + 1) & 1][eb] = vtr(vp + (16 * (s4 + 1)) * VSTR + eb * 64); vhi[(s4 + 1) & 1][eb] = vtr(vp + (16 * (s4 + 1) + 8) * VSTR + eb * 64); }
                }
#pragma unroll
                for (int eb = 0; eb < 4; ++eb) {
                    const s16x4 a = vlo[s4 & 1][eb], c = vhi[s4 & 1][eb];
                    const bf16x8 vf = (bf16x8){a[0], a[1], a[2], a[3], c[0], c[1], c[2], c[3]};
                    OT[eb] = __builtin_amdgcn_mfma_f32_32x32x16_bf16(vf, pf[s4], OT[eb], 0, 0, 0);
                }
            }
        }
        if (t + 1 < NT) ATT_STORE(lds + ((t + 1) & 1) * BUF);
        __syncthreads();
    }
#undef ATT_LOAD
#undef ATT_STORE
    lsum += __shfl_xor(lsum, 32);
    const float inv = 1.f / lsum;
#pragma unroll
    for (int eb = 0; eb < 4; ++eb)
#pragma unroll
        for (int r = 0; r < 16; ++r) OT[eb][r] *= inv;
    int hif = hi, lanef = lane; asm volatile("" : "+v"(hif), "+v"(lanef));
    LAS float* X = (LAS float*)(lds + qs * 16384) + lanef;
    if (m == 1) {
#pragma unroll
        for (int eb = 0; eb < 4; ++eb)
#pragma unroll
            for (int r = 0; r < 16; ++r) X[(eb * 16 + r) * 64] = OT[eb][r];
    }
    __syncthreads();
    if (m == 0) {
        float ss = 0.f;
#pragma unroll
        for (int eb = 0; eb < 4; ++eb) {
            __builtin_amdgcn_sched_barrier(0);
#pragma unroll
            for (int r = 0; r < 16; ++r) { const float o = OT[eb][r] - lam * X[(eb * 16 + r) * 64]; OT[eb][r] = o; ss += o * o; } }
        __builtin_amdgcn_sched_barrier(0);
        ss += __shfl_xor(ss, 32);
        const float rn = rsqrtf(ss * (1.f / 128.f) + EPS) * post;
        f32x4 w4a[4][4];
#pragma unroll
        for (int eb = 0; eb < 4; ++eb)
#pragma unroll
            for (int rg = 0; rg < 4; ++rg) w4a[eb][rg] = *(const f32x4*)(subw + 32 * eb + 8 * rg + 4 * hif);
#pragma unroll
        for (int eb = 0; eb < 4; ++eb)
#pragma unroll
            for (int rg = 0; rg < 4; ++rg) { const int e = 32 * eb + 8 * rg + 4 * hif; const f32x4 w4 = w4a[eb][rg];
                u32x2 w; w.x = cvtpk_s(OT[eb][4 * rg] * rn * w4[0], OT[eb][4 * rg + 1] * rn * w4[1]); w.y = cvtpk_s(OT[eb][4 * rg + 2] * rn * w4[2], OT[eb][4 * rg + 3] * rn * w4[3]);
                *(u32x2*)(orow + e) = w; }
    }
}
}

__device__ __forceinline__ void gmlp_unit(bf16_t* PM, bf16_t* obase, int opitch, const float* avss, const float* vnw, const float* ws_g, const float* bs_g, int rowbase, int g, LAS unsigned char* lds, int tid) {
    constexpr int VSTR = 320, WSTR = 272, W_OFF = 128 * VSTR;
    const int lane = tid & 63, wid = __builtin_amdgcn_readfirstlane(tid >> 6), r32 = lane & 31, hi = lane >> 5;
    __syncthreads();
    {
        const int row = tid >> 2, part = tid & 3;
        const bf16_t* rp = PM + (size_t)(rowbase + row) * NPM + C_AV;
        const float r = rsqrtf(avss[rowbase + row] * (1.f / 512.f) + EPS);
        const int c0 = part * 32;
#pragma unroll
        for (int i = 0; i < 4; ++i) { const u32x4 w = *(const u32x4*)(rp + g * 128 + c0 + i * 8); const float* nw = vnw + g * 128 + c0 + i * 8;
            const f32x4 n0 = *(const f32x4*)nw, n1 = *(const f32x4*)(nw + 4); u32x4 o;
            o.x = att::cvtpk_s(bf_lo(w.x) * r * n0[0], bf_hi(w.x) * r * n0[1]); o.y = att::cvtpk_s(bf_lo(w.y) * r * n0[2], bf_hi(w.y) * r * n0[3]);
            o.z = att::cvtpk_s(bf_lo(w.z) * r * n1[0], bf_hi(w.z) * r * n1[1]); o.w = att::cvtpk_s(bf_lo(w.w) * r * n1[2], bf_hi(w.w) * r * n1[3]);
            *(LAS u32x4*)(lds + row * VSTR + (c0 + i * 8) * 2) = o; }
#pragma unroll
        for (int i = 0; i < 4; ++i) { const int e8 = (i * 512 + tid) * 8, t = e8 >> 7, s0 = e8 & 127; f32x4 a = *(const f32x4*)(ws_g + e8), b = *(const f32x4*)(ws_g + e8 + 4);
#pragma unroll
            for (int e = 0; e < 4; ++e) { if (s0 + e > t) a[e] = 0.f; if (s0 + 4 + e > t) b[e] = 0.f; }
            u32x4 o; o.x = att::cvtpk_s(a[0], a[1]); o.y = att::cvtpk_s(a[2], a[3]); o.z = att::cvtpk_s(b[0], b[1]); o.w = att::cvtpk_s(b[2], b[3]);
            *(LAS u32x4*)(lds + W_OFF + t * WSTR + s0 * 2) = o; }
    }
    __syncthreads();
    const int cb = wid & 3;
    const LAS unsigned char* vp = lds + (8 * hi + ((lane & 15) >> 2)) * VSTR + (32 * cb + 16 * ((lane >> 4) & 1) + 4 * (lane & 3)) * 2;
#pragma unroll
    for (int pass = 0; pass < 2; ++pass) {
        const int tb = pass == 0 ? (wid >> 2) : 3 - (wid >> 2);
        att::f32x16 acc;
#pragma unroll
        for (int r = 0; r < 16; ++r) acc[r] = 0.f;
        const LAS unsigned char* wp = lds + W_OFF + (32 * tb + r32) * WSTR + hi * 16;
        const int nk = 2 * (tb + 1);
        for (int kk = 0; kk < nk; ++kk) {
            const att::s16x4 vlo = att::vtr(vp + (16 * kk) * VSTR), vhi = att::vtr(vp + (16 * kk + 4) * VSTR);
            const att::bf16x8 A = (att::bf16x8){vlo[0], vlo[1], vlo[2], vlo[3], vhi[0], vhi[1], vhi[2], vhi[3]};
            const att::bf16x8 B = *(const LAS att::bf16x8*)(wp + kk * 32);
            acc = __builtin_amdgcn_mfma_f32_32x32x16_bf16(A, B, acc, 0, 0, 0);
        }
        const int t = 32 * tb + r32; const float bsv = bs_g[t];
        u32x2 uua[4];
#pragma unroll
        for (int rg = 0; rg < 4; ++rg) uua[rg] = *(const u32x2*)(PM + (size_t)(rowbase + t) * NPM + C_AU + g * 128 + 32 * cb + 8 * rg + 4 * hi);
#pragma unroll
        for (int rg = 0; rg < 4; ++rg) { const int c = 32 * cb + 8 * rg + 4 * hi;
            const u32x2 uu = uua[rg];
            u32x2 o; o.x = att::cvtpk_s(bf_lo(uu.x) * (acc[4 * rg] + bsv), bf_hi(uu.x) * (acc[4 * rg + 1] + bsv)); o.y = att::cvtpk_s(bf_lo(uu.y) * (acc[4 * rg + 2] + bsv), bf_hi(uu.y) * (acc[4 * rg + 3] + bsv));
            *(u32x2*)(obase + (size_t)(rowbase + t) * opitch + g * 128 + c) = o; }
    }
}

__device__ __forceinline__ void conv_items(bf16_t* PM, bf16_t* obase, int opitch, const float* cw, int gtid, int gthreads) {
    const int c0 = (gtid & 63) * 8;
    float cwv[3][8];
#pragma unroll
    for (int j = 0; j < 3; ++j)
#pragma unroll
        for (int e = 0; e < 8; ++e) cwv[j][e] = cw[j * 512 + c0 + e];
    for (int idx = gtid; idx < M * 64; idx += 4 * gthreads) {
        u32x4 A[4][3], B[4][3], CB[4];
#pragma unroll
        for (int u = 0; u < 4; ++u) { const int i = (idx + u * gthreads < M * 64) ? idx + u * gthreads : idx; const int row = i >> 6, spos = row & (SEQ - 1);
            const bf16_t* rp = PM + (size_t)row * NPM;
#pragma unroll
            for (int j = 0; j < 3; ++j) { const int dt = (spos >= 2 - j) ? 2 - j : 0; A[u][j] = *(const u32x4*)(rp - (size_t)dt * NPM + C_CC + c0); B[u][j] = *(const u32x4*)(rp - (size_t)dt * NPM + C_CX + c0); }
            CB[u] = *(const u32x4*)(rp + C_CB + c0); }
#pragma unroll
        for (int u = 0; u < 4; ++u) { const int i = idx + u * gthreads; if (i < M * 64) { const int row = i >> 6, spos = row & (SEQ - 1);
            float y[8];
#pragma unroll
            for (int e = 0; e < 8; ++e) y[e] = 0.f;
#pragma unroll
            for (int j = 0; j < 3; ++j) { const float mk = (spos >= 2 - j) ? 1.f : 0.f; const u32x4 a = A[u][j], b2 = B[u][j];
                y[0] += mk * cwv[j][0] * (bf_lo(a.x) * bf_lo(b2.x)); y[1] += mk * cwv[j][1] * (bf_hi(a.x) * bf_hi(b2.x)); y[2] += mk * cwv[j][2] * (bf_lo(a.y) * bf_lo(b2.y)); y[3] += mk * cwv[j][3] * (bf_hi(a.y) * bf_hi(b2.y));
                y[4] += mk * cwv[j][4] * (bf_lo(a.z) * bf_lo(b2.z)); y[5] += mk * cwv[j][5] * (bf_hi(a.z) * bf_hi(b2.z)); y[6] += mk * cwv[j][6] * (bf_lo(a.w) * bf_lo(b2.w)); y[7] += mk * cwv[j][7] * (bf_hi(a.w) * bf_hi(b2.w)); }
            const u32x4 cb = CB[u];
            u32x4 w; w.x = cvt_pk_bf16(bf_lo(cb.x) * y[0], bf_hi(cb.x) * y[1]); w.y = cvt_pk_bf16(bf_lo(cb.y) * y[2], bf_hi(cb.y) * y[3]);
            w.z = cvt_pk_bf16(bf_lo(cb.z) * y[4], bf_hi(cb.z) * y[5]); w.w = cvt_pk_bf16(bf_lo(cb.w) * y[6], bf_hi(cb.w) * y[7]);
            *(u32x4*)(obase + (size_t)row * opitch + c0) = w; } }
    }
}

constexpr int N_PHASES = 1 + 6 * DEPTH;
__global__ void __launch_bounds__(NWAVES * 64, 2) fwd_kernel(Args args) {
    extern __shared__ __attribute__((aligned(16))) unsigned char lds_raw[];
    LAS unsigned char* lds = (LAS unsigned char*)lds_raw;
    const int G = gridDim.x, bx = blockIdx.x, ngw = G * NWAVES, gthreads = G * NWAVES * 64;
#define TIDS() int tid_ = threadIdx.x; asm volatile("" : "+v"(tid_)); const int tid = tid_, lane = tid & 63, wave = __builtin_amdgcn_readfirstlane(tid >> 6), gw = bx * NWAVES + wave, gtid = bx * (NWAVES * 64) + tid; (void)lane; (void)gw; (void)gtid
    unsigned char* ws = args.ws;
    float* ROWSS = (float*)(ws + WS_CTL);
    bf16_t* XB = (bf16_t*)(ws + WS_XB); bf16_t* PM = (bf16_t*)(ws + WS_PM); bf16_t* XBM = (bf16_t*)(ws + WS_PM); bf16_t* HB = (bf16_t*)(ws + WS_HB);
    unsigned char* G8 = ws + WS_G8;
    const int lo = args.ph_lo, hi = args.ph_hi;
#if !MK_MULTI
    cg::grid_group grid = cg::this_grid();
    volatile LAS unsigned* bst = (volatile LAS unsigned*)(lds + RING_BYTES + 512);
    if (threadIdx.x < 2) bst[threadIdx.x] = 0u;
    __syncthreads();
    const XcdBarrier xbar = xcd_barrier_post((unsigned*)(ws + WS_BAR), bst);
#define SEAM(ph) do { if ((ph) + 1 < hi) { if (PROBE != 12 && hi > 1000) grid.sync();   xcd_barrier(xbar); if (PROBE == 6) { xcd_barrier(xbar); xcd_barrier(xbar); } } } while (0)
#else
#define SEAM(ph) do { } while (0)
#endif
#define IN(k) (lo <= (k) && (k) < hi)
#if PROBE >= 20
    unsigned long long tp_acc = 0, tp_t0 = 0;
#define TP_BEGIN(type) do { if (PROBE - 20 == (type)) tp_t0 = __builtin_amdgcn_s_memrealtime(); } while (0)
#define TP_END(type) do { if (PROBE - 20 == (type)) tp_acc += __builtin_amdgcn_s_memrealtime() - tp_t0; } while (0)
#else
#define TP_BEGIN(type) do { } while (0)
#define TP_END(type) do { } while (0)
#endif

    TP_BEGIN(0);
    if (IN(0)) {
        TIDS();
        for (int rep = 0; rep < (PROBE == 1 ? 2 : 1); ++rep) {
        convert_region_a(args, 0, lds, gw, ngw, wave, lane);
        convert_region_b(args, 0, lds, gw, ngw, wave, lane); }
        const float* x = args.in[0];
        for (int r = gw; r < M; r += 2 * ngw) {
            const int r2 = (r + ngw < M) ? r + ngw : r;
            const f32x4* xr = (const f32x4*)(x + (size_t)r * DM) + lane; const f32x4* xr2 = (const f32x4*)(x + (size_t)r2 * DM) + lane;
            f32x4 va[4], vb[4];
#pragma unroll
            for (int j = 0; j < 4; ++j) { va[j] = xr[64 * j]; vb[j] = xr2[64 * j]; }
            u32x2* o = (u32x2*)(XB + (size_t)r * DM) + lane; u32x2* o2 = (u32x2*)(XB + (size_t)r2 * DM) + lane; float s = 0.f, s2 = 0.f;
#pragma unroll
            for (int j = 0; j < 4; ++j) { const f32x4 v = va[j]; s += (v[0] * v[0] + v[1] * v[1]) + (v[2] * v[2] + v[3] * v[3]); u32x2 w; w.x = cvt_pk_bf16(v[0], v[1]); w.y = cvt_pk_bf16(v[2], v[3]); o[64 * j] = w;
                const f32x4 q = vb[j]; s2 += (q[0] * q[0] + q[1] * q[1]) + (q[2] * q[2] + q[3] * q[3]); u32x2 w2; w2.x = cvt_pk_bf16(q[0], q[1]); w2.y = cvt_pk_bf16(q[2], q[3]); o2[64 * j] = w2; }
            s = wave_sum(s); s2 = wave_sum(s2); if (lane == 0) { ROWSS[r] = s; ROWSS[r2] = s2; }
        }
        SEAM(0);
    }
    TP_END(0);
    for (int l = 0; l < DEPTH; ++l) {
        const int pb = 1 + 6 * l;
        const float* xres_in = (l == 0) ? args.in[0] : args.out;
        TP_BEGIN(1);
        if (IN(pb + 0)) {
            pg8::Gemm g{XB, (const bf16_t*)(ws + WS_WIN), DM, DM, 0, 0, 0}; pg8::StaticOrder S; S.init(M, NIN, G, bx, 1, WGM_IN);
            EpiInProj E{PM, G8, ROWSS + (size_t)(2 * l) * M, args.in[3] + l * NG, args.in[7] + l * 128, args.in[8] + l * 128, ROWSS + (size_t)(4 + l) * M};
            pg8::gemm_phase<EpiInProj, pg8::StaticOrder>(lds, g, S, E);
#if PROBE == 2
            pg8::gemm_phase<EpiInProj, pg8::StaticOrder>(lds, g, S, E);
#endif
            SEAM(pb + 0);
        }
        TP_END(1);
        TP_BEGIN(2);
        if (IN(pb + 1)) {
            TIDS();
            if (l == 1) convert_region_b(args, 1, lds, gw, ngw, wave, lane);
            const float* lp = args.in[9] + l * 256;
            const float sa = wave_sum(lp[lane] * lp[64 + lane]), sb = wave_sum(lp[128 + lane] * lp[192 + lane]);
            const float lam_init = 0.8f - 0.6f * expf(-0.3f * (float)l);
            const float lam = expf(sa) - expf(sb) + lam_init;
#if PROBE == 4
            for (int pi = bx; pi < 256; pi += G) { const int bh = pi >> 4, sq = pi & 15;
                att::attn_unit(PM, XB, DM, bh >> 2, bh & 3, 31 - sq, lam, 1.f - lam_init, args.in[10] + l * 128, args.in[8] + l * 128, lds, tid);
                att::attn_unit(PM, XB, DM, bh >> 2, bh & 3, sq, lam, 1.f - lam_init, args.in[10] + l * 128, args.in[8] + l * 128, lds, tid); }
#endif
            for (int pi = bx; pi < 256; pi += G) { const int bh = pi >> 4, sq = pi & 15;
                att::attn_unit(PM, PM + C_Q, NPM, bh >> 2, bh & 3, 31 - sq, lam, 1.f - lam_init, args.in[10] + l * 128, args.in[8] + l * 128, lds, tid);
                att::attn_unit(PM, PM + C_Q, NPM, bh >> 2, bh & 3, sq, lam, 1.f - lam_init, args.in[10] + l * 128, args.in[8] + l * 128, lds, tid); }
#if PROBE == 5
            for (int uu = bx; uu < 512; uu += G) { const int g4 = uu & 3, blk = uu >> 2;
                gmlp_unit(PM, XB, DM, ROWSS + (size_t)(4 + l) * M, args.in[4] + l * 512, args.in[5] + (size_t)(l * 4 + g4) * 16384, args.in[6] + (l * 4 + g4) * 128, blk * 128, g4, lds, tid); }
#endif
            for (int uu = bx; uu < 512; uu += G) { const int g4 = uu & 3, blk = uu >> 2;
                gmlp_unit(PM, PM + C_AU, NPM, ROWSS + (size_t)(4 + l) * M, args.in[4] + l * 512, args.in[5] + (size_t)(l * 4 + g4) * 16384, args.in[6] + (l * 4 + g4) * 128, blk * 128, g4, lds, tid); }
#if PROBE == 8
            conv_items(PM, XB, DM, args.in[11] + l * 1536, gtid, gthreads);
#endif
            conv_items(PM, PM + C_CB, NPM, args.in[11] + l * 1536, gtid, gthreads);
            SEAM(pb + 1);
        }
        TP_END(2);
        TP_BEGIN(3);
        if (IN(pb + 2)) {
            pg8::Gemm g{PM + C_AU, (const bf16_t*)(ws + WS_WBR), NPM, 512, (size_t)(C_Q - C_AU) * 2, (size_t)(C_CB - C_AU) * 2, MiB}; pg8::StaticOrder S; S.init(M, DM, G, bx, 3, WGM_N1);
            EpiBranch E{(bf16_t*)args.out, G8};
            pg8::gemm_phase<EpiBranch, pg8::StaticOrder>(lds, g, S, E);
#if PROBE == 7
            pg8::gemm_phase<EpiBranch, pg8::StaticOrder>(lds, g, S, E);
#endif
            SEAM(pb + 2);
        }
        TP_END(3);
        TP_BEGIN(4);
        if (IN(pb + 3)) {
            pg8::Gemm g{(const bf16_t*)args.out, (const bf16_t*)(ws + WS_WOUT), DM, DM, 0, 0, 0}; pg8::StaticOrder S; S.init(M, DM, G, bx, 1, WGM_N1);
            EpiResid E{(l == 0) ? args.in[0] : nullptr, (l == 0) ? nullptr : XB, nullptr, XBM, ROWSS + (size_t)(2 * l + 1) * M};
#if 0
            { EpiResid E2{args.in[0], (float*)(ws + WS_HB), nullptr, nullptr}; pg8::gemm_phase<EpiResid, pg8::StaticOrder>(lds, g, S, E2); }
#endif
            pg8::gemm_phase<EpiResid, pg8::StaticOrder>(lds, g, S, E);
            SEAM(pb + 3);
        }
        TP_END(4);
        TP_BEGIN(5);
        if (IN(pb + 4)) {
            if (l == 0) { TIDS(); convert_region_a(args, 1, lds, gw, ngw, wave, lane); }
            __syncthreads();
            pg8::Gemm g{XBM, (const bf16_t*)(ws + WS_WF1), DM, DM, 0, 0, 0}; pg8::StaticOrder S; S.init(M, FF, G, bx, 1, WGM_FF);
            EpiFF1 E{HB, ROWSS + (size_t)(2 * l + 1) * M, FF};
            pg8::gemm_phase<EpiFF1, pg8::StaticOrder>(lds, g, S, E);
#if PROBE == 3
            pg8::gemm_phase<EpiFF1, pg8::StaticOrder>(lds, g, S, E);
#endif
            SEAM(pb + 4);
        }
        TP_END(5);
        TP_BEGIN(6);
        if (IN(pb + 5)) {
            pg8::Gemm g{HB, (const bf16_t*)(ws + WS_WF2), FF, FF, 0, 0, 0}; pg8::StaticOrder S; S.init(M, DM, G, bx, 1, WGM_N1);
            EpiResid E{nullptr, XBM, (l + 1 < DEPTH) ? nullptr : args.out, (l + 1 < DEPTH) ? XB : nullptr, ROWSS + (size_t)(2 * l + 2 < 4 ? 2 * l + 2 : 0) * M};
#if 0
            { EpiFF1 E2{XBM, ROWSS + (size_t)(2 * l + 1) * M, DM}; pg8::gemm_phase<EpiFF1, pg8::StaticOrder>(lds, g, S, E2); }
#endif
            pg8::gemm_phase<EpiResid, pg8::StaticOrder>(lds, g, S, E);
            SEAM(pb + 5);
        }
        TP_END(6);
    }
#if PROBE >= 20
    if (blockIdx.x == 0 && threadIdx.x == 0) { const unsigned long long tb = __builtin_amdgcn_s_memrealtime(); while (__builtin_amdgcn_s_memrealtime() - tb < 4 * tp_acc) __builtin_amdgcn_s_sleep(8); }
#endif
#undef IN
#undef SEAM
}

extern "C" void kernel_launch(void* const* d_in, const int* in_sizes, int n_in, void* d_out, int out_size, void* d_ws, size_t ws_size, hipStream_t stream) {
    static int grid = 0;
    if (grid == 0) {
        if (n_in != 19 || in_sizes[0] != M * DM || out_size != M * DM || ws_size < WS_END) { fprintf(stderr, "kernel_launch: unexpected shapes / workspace (%d inputs, ws %zu)\n", n_in, ws_size); grid = -1; return; }
        int dev = 0, cus = 0, per_cu = 0;
        if (hipGetDevice(&dev) != hipSuccess || hipDeviceGetAttribute(&cus, hipDeviceAttributeMultiprocessorCount, dev) != hipSuccess) { grid = -1; return; }
        if (hipFuncSetAttribute((const void*)fwd_kernel, hipFuncAttributeMaxDynamicSharedMemorySize, LDS_BYTES) != hipSuccess) { fprintf(stderr, "kernel_launch: hipFuncSetAttribute failed\n"); grid = -1; return; }
        if (hipOccupancyMaxActiveBlocksPerMultiprocessor(&per_cu, (const void*)fwd_kernel, NWAVES * 64, LDS_BYTES) != hipSuccess || per_cu < 1) { fprintf(stderr, "kernel_launch: occupancy query says %d blocks per CU\n", per_cu); grid = -1; return; }
        grid = cus;
    }
    if (grid < 0) return;
    (void)hipMemsetAsync((char*)d_ws + WS_CTL, 0, CTL_BYTES, stream);
#if PROBE == 11
    (void)hipMemsetAsync((char*)d_ws + WS_END, 0, CTL_BYTES, stream);
    (void)hipMemsetAsync((char*)d_ws + WS_END + CTL_BYTES, 0, CTL_BYTES, stream);
#endif
    Args a{};
    for (int i = 0; i < 19; ++i) a.in[i] = (const float*)d_in[i];
    a.out = (float*)d_out; a.ws = (unsigned char*)d_ws;
#if MK_MULTI
    for (int p = 0; p < N_PHASES; ++p) { a.ph_lo = p; a.ph_hi = p + 1; hipLaunchKernelGGL(fwd_kernel, dim3(grid), dim3(NWAVES * 64), LDS_BYTES, stream, a); }
#else
    a.ph_lo = 0; a.ph_hi = N_PHASES;
    void* kargs[] = {&a};
#if PROBE == 12
    (void)kargs; hipLaunchKernelGGL(fwd_kernel, dim3(grid), dim3(NWAVES * 64), LDS_BYTES, stream, a); hipError_t e = hipSuccess;
#else
    hipError_t e = hipLaunchCooperativeKernel((const void*)fwd_kernel, dim3(grid), dim3(NWAVES * 64), kargs, LDS_BYTES, stream);
#endif
    if (e != hipSuccess) fprintf(stderr, "kernel_launch: cooperative launch failed: %s (grid %d)\n", hipGetErrorString(e), grid);
#endif
}
```

```cpp
#include <hip/hip_runtime.h>
#include <hip/hip_cooperative_groups.h>
#include <cstdio>
#include <cstdint>
namespace cg = cooperative_groups;

#ifndef PROBE
#define PROBE 0
#endif
#ifndef WGM_IN
#define WGM_IN 2
#endif
#ifndef WGM_FF
#define WGM_FF 2
#endif
#ifndef WGM_N1
#define WGM_N1 4
#endif
#ifndef MK_MULTI
#define MK_MULTI 0
#endif

namespace pg8 {
#define PG8_LAS __attribute__((address_space(3)))
typedef unsigned short bf16_t;
typedef short bf16x8 __attribute__((ext_vector_type(8)));
typedef float f32x4 __attribute__((ext_vector_type(4)));
typedef unsigned u32x4 __attribute__((ext_vector_type(4)));
typedef unsigned u32x2 __attribute__((ext_vector_type(2)));
constexpr int BM = 256, BK = 64, HALF = 128, HTB = HALF * BK * 2, STAGE_BYTES = 8 * HTB, NXCD = 8;

__host__ __device__ __forceinline__ int lds_byte(int r, int c) { const int st = (r >> 4) * 2 + (c >> 5), rr = r & 15, cc = c & 31, ob = rr * 64 + cc * 2; return st * 1024 + (ob ^ (((ob >> 9) & 1) << 5)); }
__host__ __device__ __forceinline__ void stage_rc(int b, int& R, int& C) { const int st = b / 1024, sb = b % 1024, swz = sb ^ (((sb >> 9) & 1) << 5); R = (st >> 1) * 16 + swz / 64; C = (st & 1) * 32 + (swz % 64) / 2; }
__host__ __device__ __forceinline__ int perm32(int rho) { const int n = rho >> 4, i = rho & 15; return 8 * (i >> 2) + 4 * n + (i & 3); }

struct Unit { int pm, pn, j; };
struct Gemm { const bf16_t* A; const bf16_t* Bt; int lda, K; size_t a_j1, a_j2, b_j;
    __device__ __forceinline__ size_t aoff(int j) const { return j == 0 ? (size_t)0 : (j == 1 ? a_j1 : a_j2); } };

struct StaticOrder {
    int nM, nN, nwg, G, c, NJ, WGM;
    __host__ __device__ void init(int M, int N, int G_, int c_, int NJ_ = 1, int WGM_ = 4) { nM = M / BM; nN = N / BM; nwg = nM * nN; G = G_; c = c_; NJ = NJ_; WGM = WGM_; }
    __host__ __device__ bool next(int i, Unit& u) const {
        const int ti = i / NJ; u.j = i - ti * NJ;
        const long L = (long)ti * G + c; if (L >= nwg) return false;
        int wgid = (int)L; { const int q = nwg / NXCD, r = nwg % NXCD, xcd = wgid % NXCD, off = wgid / NXCD; wgid = (xcd < r ? xcd * (q + 1) : r * (q + 1) + (xcd - r) * q) + off; }
        const int nig = WGM * nN, gid = wgid / nig, fm = gid * WGM, gsz = (nM - fm) < WGM ? (nM - fm) : WGM;
        u.pm = fm + ((wgid % nig) % gsz); u.pn = (wgid % nig) / gsz; return true;
    }
};

__device__ __forceinline__ unsigned cvt_pk_bf16(float lo, float hi) { unsigned r; asm volatile("v_cvt_pk_bf16_f32 %0, %1, %2" : "=v"(r) : "v"(lo), "v"(hi)); return r; }

template <class Epi, class Sched>
__device__ __forceinline__ void gemm_phase(PG8_LAS unsigned char* lds, const Gemm g, const Sched& S, const Epi& E) {
    int tid_ = threadIdx.x; asm volatile("" : "+v"(tid_));
    const int tid = tid_, wid = __builtin_amdgcn_readfirstlane(tid >> 6), lane = tid & 63, wr = wid >> 2, wc = wid & 3, fr = lane & 15, fq = lane >> 4;
    const int K = g.K, nt = K / BK, lda = g.lda;
    unsigned voffA[2], voffB[2];
#pragma unroll
    for (int i = 0; i < 2; ++i) { int R, C; stage_rc(tid * 16 + i * 8192, R, C); const int Rb = Epi::PERM ? ((R & ~31) + perm32(R & 31)) : R;
        voffA[i] = (unsigned)(R * lda + C) * 2u; voffB[i] = (unsigned)(Rb * K + C) * 2u; }
    const size_t kstep = (size_t)(BK * 2);
    const size_t hstepA = (size_t)HALF * lda * 2, hstepB = (size_t)HALF * K * 2;
    const size_t tstepA = 2 * hstepA, tstepB = 2 * hstepB;
    const unsigned ldsw = (unsigned)wid * 1024u;
    const int aoff = lds_byte(wr * 64 + fr, fq * 8), boff = lds_byte(wc * 32 + fr, fq * 8);
#define PG8_SA(b, h) (((b) * 2 + (h)) * HTB)
#define PG8_SB(b, h) ((4 + (b) * 2 + (h)) * HTB)
#define PG8_STAGE(bufoff, gbase, voff) do { _Pragma("unroll") for (int _i = 0; _i < 2; ++_i) \
        __builtin_amdgcn_global_load_lds((const unsigned*)((const char*)(gbase) + (voff)[_i]), (PG8_LAS unsigned*)(lds + (bufoff) + ldsw + _i * 8192), 16, 0, 0); } while (0)
#define PG8_LDA(dst, b, h) do { _Pragma("unroll") for (int m = 0; m < 4; ++m) _Pragma("unroll") for (int k = 0; k < 2; ++k) dst[m][k] = *(const PG8_LAS bf16x8*)(lds + PG8_SA(b, h) + aoff + m * 2048 + k * 1024); } while (0)
#define PG8_LDB(dst, b, h) do { _Pragma("unroll") for (int n = 0; n < 2; ++n) _Pragma("unroll") for (int k = 0; k < 2; ++k) dst[n][k] = *(const PG8_LAS bf16x8*)(lds + PG8_SB(b, h) + boff + n * 2048 + k * 1024); } while (0)
#define PG8_MMA(ai, bj, At, Bt) do { __builtin_amdgcn_s_setprio(1); _Pragma("unroll") for (int m = 0; m < 4; ++m) _Pragma("unroll") for (int n = 0; n < 2; ++n) _Pragma("unroll") for (int k = 0; k < 2; ++k) \
        acc[ai][bj][m][n] = __builtin_amdgcn_mfma_f32_16x16x32_bf16(Bt[n][k], At[m][k], acc[ai][bj][m][n], 0, 0, 0); __builtin_amdgcn_s_setprio(0); } while (0)
#define PG8_WAIT_V(n) asm volatile("s_waitcnt vmcnt(" #n ")" ::: "memory")
#define PG8_WAIT_L(n) asm volatile("s_waitcnt lgkmcnt(" #n ")" ::: "memory")
#define PG8_BAR __builtin_amdgcn_s_barrier()
#define PG8_SCHED __builtin_amdgcn_sched_barrier(0)
    Unit cur, nxt; int ui = 0;
    if (!S.next(0, cur)) return;
    typename Epi::Pre epre;
    f32x4 acc[2][2][4][2];
#pragma unroll
    for (int a = 0; a < 2; ++a)
#pragma unroll
        for (int b = 0; b < 2; ++b)
#pragma unroll
            for (int m = 0; m < 4; ++m)
#pragma unroll
                for (int n = 0; n < 2; ++n) acc[a][b][m][n] = (f32x4){0.f, 0.f, 0.f, 0.f};
    bf16x8 At[4][2], B0[2][2], B1[2][2];
    const char* cA = (const char*)g.A + (size_t)cur.pm * tstepA + g.aoff(cur.j); const char* cB = (const char*)g.Bt + (size_t)cur.pn * tstepB + (size_t)cur.j * g.b_j;
    {
        PG8_STAGE(PG8_SB(0, 0), cB, voffB); PG8_STAGE(PG8_SB(0, 1), cB + hstepB, voffB); PG8_STAGE(PG8_SA(0, 0), cA, voffA); PG8_STAGE(PG8_SA(0, 1), cA + hstepA, voffA);
        if (wr == 1) PG8_BAR;
        PG8_WAIT_V(2); PG8_BAR;
        PG8_STAGE(PG8_SB(1, 0), cB + kstep, voffB); PG8_STAGE(PG8_SA(1, 0), cA + kstep, voffA); PG8_STAGE(PG8_SB(1, 1), cB + hstepB + kstep, voffB);
        PG8_WAIT_V(6); PG8_BAR;
    }
    for (;;) {
        const bool has_next = S.next(ui + 1, nxt);
        const char* nA = has_next ? (const char*)g.A + (size_t)nxt.pm * tstepA + g.aoff(nxt.j) : cA; const char* nB = has_next ? (const char*)g.Bt + (size_t)nxt.pn * tstepB + (size_t)nxt.j * g.b_j : cB;
        for (int t = 0; t < nt; t += 2) {
            const bool last = (t == nt - 2);
            if (last) E.pre(epre, cur, wr, fr);
            const char* a1 = cA + (size_t)(t + 1) * kstep;
            const char* a2 = last ? nA : cA + (size_t)(t + 2) * kstep; const char* b2 = last ? nB : cB + (size_t)(t + 2) * kstep;
            const char* a3 = a2 + kstep; const char* b3 = b2 + kstep;
            PG8_LDB(B0, 0, 0); PG8_LDB(B1, 0, 1); PG8_SCHED; PG8_LDA(At, 0, 0); PG8_STAGE(PG8_SA(1, 1), a1 + hstepA, voffA);
            PG8_WAIT_V(8); PG8_WAIT_L(0); PG8_BAR; PG8_MMA(0, 0, At, B0); PG8_MMA(0, 1, At, B1); PG8_BAR; PG8_SCHED;
            PG8_LDA(At, 0, 1); PG8_STAGE(PG8_SB(0, 0), b2, voffB); PG8_STAGE(PG8_SB(0, 1), b2 + hstepB, voffB); PG8_STAGE(PG8_SA(0, 0), a2, voffA);
            PG8_WAIT_V(8); PG8_WAIT_L(0); PG8_BAR; PG8_MMA(1, 0, At, B0); PG8_MMA(1, 1, At, B1); PG8_BAR; PG8_SCHED;
            PG8_LDB(B0, 1, 0); PG8_LDB(B1, 1, 1); PG8_SCHED; PG8_LDA(At, 1, 0); PG8_STAGE(PG8_SA(0, 1), a2 + hstepA, voffA);
            PG8_WAIT_V(8); PG8_WAIT_L(0); PG8_BAR; PG8_MMA(0, 0, At, B0); PG8_MMA(0, 1, At, B1); PG8_BAR; PG8_SCHED;
            PG8_LDA(At, 1, 1); PG8_STAGE(PG8_SB(1, 0), b3, voffB); PG8_STAGE(PG8_SB(1, 1), b3 + hstepB, voffB); PG8_STAGE(PG8_SA(1, 0), a3, voffA);
            PG8_WAIT_V(8); PG8_WAIT_L(0); PG8_BAR; PG8_MMA(1, 0, At, B0); PG8_MMA(1, 1, At, B1); PG8_BAR; PG8_SCHED;
        }
        if (wr == 0) PG8_BAR;
        E(acc, cur, wr, wc, fr, fq, epre);
        if (!has_next) break;
        if (!(Epi::ACCUM && nxt.j != 0)) {
#pragma unroll
        for (int a = 0; a < 2; ++a)
#pragma unroll
            for (int b = 0; b < 2; ++b)
#pragma unroll
                for (int m = 0; m < 4; ++m)
#pragma unroll
                    for (int n = 0; n < 2; ++n) acc[a][b][m][n] = (f32x4){0.f, 0.f, 0.f, 0.f};
        }
        cur = nxt; cA = nA; cB = nB; ++ui;
        if (wr == 1) PG8_BAR;
    }
    PG8_WAIT_V(0);
    PG8_BAR;
#undef PG8_SA
#undef PG8_SB
#undef PG8_STAGE
#undef PG8_LDA
#undef PG8_LDB
#undef PG8_MMA
#undef PG8_WAIT_V
#undef PG8_WAIT_L
#undef PG8_BAR
#undef PG8_SCHED
}
}

using pg8::bf16_t; using pg8::f32x4; using pg8::u32x4; using pg8::u32x2; using pg8::cvt_pk_bf16;
#define LAS __attribute__((address_space(3)))

constexpr int DM = 1024, NB = 4, SEQ = 4096, M = NB * SEQ, DEPTH = 2;
constexpr int NIN = 7168, NPM = 4096, NG = 3072, FF = 4096;
constexpr int C_AU = 0, C_AV = 512, C_Q = 1024, C_K = 1536, C_V = 2048, C_CB = 2560, C_CC = 3072, C_CX = 3584;
constexpr float EPS = 1e-6f;
constexpr float LOG2E = 1.4426950408889634f;

constexpr size_t MiB = 1u << 20;
constexpr size_t WS_CTL = 0, CTL_BYTES = 1 * MiB, WS_BAR = 512 * 1024;
constexpr size_t WS_WIN = 1 * MiB, WS_WBR = 15 * MiB, WS_WOUT = 18 * MiB;
constexpr size_t WS_WF1 = 20 * MiB, WS_WF2 = 28 * MiB;
constexpr size_t WS_XB = 36 * MiB;
constexpr size_t WS_PM = 68 * MiB;
constexpr size_t WS_G8 = 196 * MiB;
constexpr size_t WS_HB = 100 * MiB;
constexpr size_t WS_END = 244 * MiB;

constexpr int NWAVES = 8;
constexpr int RING_BYTES = 131072, LDS_BYTES = 139264;

struct Args { const float* in[19]; float* out; unsigned char* ws; int ph_lo, ph_hi; };

#define GAS __attribute__((address_space(1)))
#define XB_TMO      128
#define XB_XCNT(j)  (256  + 64 * (j))
#define XB_XSUB(j)  (1280 + 64 * (j))
#define XB_XGEN(j)  (2304 + 64 * (j))
#define XB_TOP      3328
#define XB_TOPGEN   3392
#define XCD_BAR_WORDS 3456
#define XB_SPIN_CAP (1u << 18)

__device__ __forceinline__ unsigned xb_ld(unsigned* p)              { return __hip_atomic_load(p, __ATOMIC_RELAXED, __HIP_MEMORY_SCOPE_AGENT); }
__device__ __forceinline__ unsigned xb_add(unsigned* p, unsigned v) { return __hip_atomic_fetch_add(p, v, __ATOMIC_RELAXED, __HIP_MEMORY_SCOPE_AGENT); }
__device__ __forceinline__ unsigned xb_xcc_id() { return (unsigned)__builtin_amdgcn_s_getreg((3 << 11) | 20) & 0xFu; }
#define XB_SPIN(cond, bar) do { unsigned _sp = 0; while (cond) { __builtin_amdgcn_s_sleep(1); \
    if ((++_sp & 255u) == 0u) { if (xb_ld(&(bar)[XB_TMO])) break; if (_sp > XB_SPIN_CAP) { atomicAdd(&(bar)[XB_TMO], 1u); break; } } } } while (0)

struct XcdBarrier {
    unsigned* bar; unsigned x;
    volatile LAS unsigned* st;
};

__device__ __forceinline__ XcdBarrier xcd_barrier_post(unsigned* bar, volatile LAS unsigned* st) {
    XcdBarrier b; b.bar = bar; b.x = xb_xcc_id(); b.st = st;
    if (threadIdx.x == 0) (void)xb_add(&bar[XB_XCNT(b.x)], 1u);
    return b;
}
__device__ __forceinline__ void xcd_barrier_complete(unsigned* bar, unsigned x, unsigned& nloc, unsigned& nx) {
    const unsigned G = gridDim.x * gridDim.y * gridDim.z;
    unsigned sum, cnt, mine, sp = 0u;
    for (;;) {
        sum = 0u; cnt = 0u; mine = 0u;
#pragma unroll
        for (unsigned j = 0; j < 16; ++j) { const unsigned c = xb_ld(&bar[XB_XCNT(j)]); sum += c; cnt += (c > 0u) ? 1u : 0u; mine = (j == x) ? c : mine; }
        if (sum == G) break;
        __builtin_amdgcn_s_sleep(1);
        if ((++sp & 255u) == 0u) { if (xb_ld(&bar[XB_TMO])) break; if (sp > XB_SPIN_CAP) { atomicAdd(&bar[XB_TMO], 1u); break; } }
    }
    nloc = mine > 0u ? mine : 1u; nx = cnt > 0u ? cnt : 1u;
}

__device__ __forceinline__ void xcd_barrier(const XcdBarrier& b) {
    asm volatile("s_waitcnt vmcnt(0)" ::: "memory");
    __syncthreads();
    if (threadIdx.x == 0) {
        unsigned* bar = b.bar;
        __builtin_amdgcn_s_waitcnt(0);
        unsigned nloc = b.st[0], nx = b.st[1];
        if (nloc == 0u) { xcd_barrier_complete(bar, b.x, nloc, nx); b.st[0] = nloc; b.st[1] = nx; }
        const unsigned old = xb_add(&bar[XB_XSUB(b.x)], 1u);
        const unsigned gen = old / nloc;
        if (old + 1u == (gen + 1u) * nloc) {
            __builtin_amdgcn_fence(__ATOMIC_RELEASE, "agent");
            asm volatile("s_waitcnt vmcnt(0)" ::: "memory");
            const unsigned og = xb_add(&bar[XB_TOP], 1u);
            const unsigned tg = og / nx;
            if (og + 1u == (tg + 1u) * nx) xb_add(&bar[XB_TOPGEN], 1u);
            else XB_SPIN(xb_ld(&bar[XB_TOPGEN]) == tg, bar);
            __builtin_amdgcn_fence(__ATOMIC_ACQUIRE, "agent");
            asm volatile("s_waitcnt vmcnt(0)" ::: "memory");
        } else {
            XB_SPIN(xb_ld(&bar[XB_TOPGEN]) == gen, bar);
            __builtin_amdgcn_fence(__ATOMIC_ACQUIRE, "agent");
            asm volatile("s_waitcnt vmcnt(0)" ::: "memory");
        }
    }
    __syncthreads();
}

__device__ __forceinline__ float bf_lo(unsigned w) { return __uint_as_float(w << 16); }
__device__ __forceinline__ float bf_hi(unsigned w) { return __uint_as_float(w & 0xffff0000u); }
__device__ __forceinline__ float wave_sum(float v) {
#pragma unroll
    for (int o = 1; o < 64; o <<= 1) v += __shfl_xor(v, o);
    return v;
}
__device__ __forceinline__ float gelu_tanh(float x) {
    const float u = 0.7978845608028654f * (x + 0.044715f * x * x * x);
    return x * __builtin_amdgcn_rcpf(1.f + __builtin_amdgcn_exp2f(-2.f * LOG2E * u));
}
__device__ __forceinline__ float sigmoidf(float x) { return __builtin_amdgcn_rcpf(1.f + __builtin_amdgcn_exp2f(-LOG2E * x)); }
__device__ __forceinline__ float g8f(unsigned b) { return ((float)b + 0.5f) * (1.f / 256.f); }

__device__ __forceinline__ int inproj_phys(int n) {
    if (n < C_Q || n >= C_V) return n;
    const int t = n & ~255, g = (n & 255) >> 6, d = n & 63;
    return t + ((d >> 5) << 7) + (g << 5) + (d & 31);
}

struct EpiInProj {
    static constexpr bool PERM = true, ACCUM = false;
    bf16_t* PM; unsigned char* G8; const float* rowss; const float* gate_b; const float* qnw; const float* knw; float* avss;
    struct Pre { float v[2][4]; };
    __device__ __forceinline__ void pre(Pre& p, const pg8::Unit& u, int wr, int fr) const {
        const int row0 = u.pm * 256 + wr * 64 + fr;
#pragma unroll
        for (int ai = 0; ai < 2; ++ai)
#pragma unroll
            for (int m = 0; m < 4; ++m) p.v[ai][m] = rowss[row0 + ai * 128 + m * 16];
    }
    __device__ __forceinline__ void operator()(f32x4 (&acc)[2][2][4][2], const pg8::Unit& u, int wr, int wc, int fr, int fq, const Pre& p) const {
        const int row0 = u.pm * 256 + wr * 64 + fr;
        float rs[2][4];
#pragma unroll
        for (int ai = 0; ai < 2; ++ai)
#pragma unroll
            for (int m = 0; m < 4; ++m) rs[ai][m] = rsqrtf(p.v[ai][m] * (1.f / DM) + EPS);
        const int pn = u.pn;
        if (pn < 4) {
            const int col0 = pn * 256 + wc * 32 + 8 * fq;
#pragma unroll
            for (int ai = 0; ai < 2; ++ai)
#pragma unroll
                for (int m = 0; m < 4; ++m) { bf16_t* rowp = PM + (size_t)(row0 + ai * 128 + m * 16) * NPM + col0; const float r = rs[ai][m]; float ss = 0.f;
#pragma unroll
                    for (int bj = 0; bj < 2; ++bj) { const f32x4 v0 = acc[ai][bj][m][0] * r, v1 = acc[ai][bj][m][1] * r; u32x4 w; float gl[8];
#pragma unroll
                        for (int e = 0; e < 4; ++e) { gl[e] = gelu_tanh(v0[e]); gl[4 + e] = gelu_tanh(v1[e]); }
#pragma unroll
                        for (int e = 0; e < 8; ++e) ss += gl[e] * gl[e];
                        w.x = cvt_pk_bf16(gl[0], gl[1]); w.y = cvt_pk_bf16(gl[2], gl[3]); w.z = cvt_pk_bf16(gl[4], gl[5]); w.w = cvt_pk_bf16(gl[6], gl[7]);
                        *(u32x4*)(rowp + bj * 128) = w; }
                    if (pn >= 2) { ss += __shfl_xor(ss, 16); ss += __shfl_xor(ss, 32); if (fq == 0) atomicAdd(avss + row0 + ai * 128 + m * 16, ss); } }
        } else if (pn < 8) {
            const bool isq = pn < 6;
            const float* nw = (isq ? qnw : knw) + (wc & 1) * 64 + 8 * fq;
            const float extra = isq ? 0.125f * LOG2E : 1.f;
            float wv[2][8];
#pragma unroll
            for (int bj = 0; bj < 2; ++bj)
#pragma unroll
                for (int i = 0; i < 8; ++i) wv[bj][i] = nw[32 * bj + i] * extra;
            const int col0 = pn * 256 + 64 * wc + 8 * fq;
#pragma unroll
            for (int ai = 0; ai < 2; ++ai)
#pragma unroll
                for (int m = 0; m < 4; ++m) { bf16_t* rowp = PM + (size_t)(row0 + ai * 128 + m * 16) * NPM + col0; const float r = rs[ai][m];
                    f32x4 v[2][2]; float ss = 0.f;
#pragma unroll
                    for (int bj = 0; bj < 2; ++bj)
#pragma unroll
                        for (int n = 0; n < 2; ++n) { v[bj][n] = acc[ai][bj][m][n] * r; const f32x4 x = v[bj][n]; ss += (x[0] * x[0] + x[1] * x[1]) + (x[2] * x[2] + x[3] * x[3]); }
                    ss += __shfl_xor(ss, 16); ss += __shfl_xor(ss, 32);
                    const float rn = rsqrtf(ss * (1.f / 64.f) + EPS);
#pragma unroll
                    for (int bj = 0; bj < 2; ++bj) { const f32x4 v0 = v[bj][0] * rn, v1 = v[bj][1] * rn; u32x4 w;
                        w.x = cvt_pk_bf16(v0[0] * wv[bj][0], v0[1] * wv[bj][1]); w.y = cvt_pk_bf16(v0[2] * wv[bj][2], v0[3] * wv[bj][3]);
                        w.z = cvt_pk_bf16(v1[0] * wv[bj][4], v1[1] * wv[bj][5]); w.w = cvt_pk_bf16(v1[2] * wv[bj][6], v1[3] * wv[bj][7]);
                        *(u32x4*)(rowp + bj * 32) = w; } }
        } else if (pn < 16) {
            const int col0 = pn * 256 + wc * 32 + 8 * fq;
#pragma unroll
            for (int ai = 0; ai < 2; ++ai)
#pragma unroll
                for (int m = 0; m < 4; ++m) { bf16_t* rowp = PM + (size_t)(row0 + ai * 128 + m * 16) * NPM + col0; const float r = rs[ai][m];
#pragma unroll
                    for (int bj = 0; bj < 2; ++bj) { const f32x4 v0 = acc[ai][bj][m][0] * r, v1 = acc[ai][bj][m][1] * r; u32x4 w;
                        w.x = cvt_pk_bf16(v0[0], v0[1]); w.y = cvt_pk_bf16(v0[2], v0[3]); w.z = cvt_pk_bf16(v1[0], v1[1]); w.w = cvt_pk_bf16(v1[2], v1[3]);
                        *(u32x4*)(rowp + bj * 128) = w; } }
        } else {
            const int col0 = (pn - 16) * 256 + wc * 32 + 8 * fq;
            f32x4 bv[2][2];
#pragma unroll
            for (int bj = 0; bj < 2; ++bj)
#pragma unroll
                for (int n = 0; n < 2; ++n) bv[bj][n] = *(const f32x4*)(gate_b + col0 + bj * 128 + 4 * n);
#pragma unroll
            for (int ai = 0; ai < 2; ++ai)
#pragma unroll
                for (int m = 0; m < 4; ++m) { unsigned char* rowp = G8 + (size_t)(row0 + ai * 128 + m * 16) * NG + col0; const float r = rs[ai][m];
#pragma unroll
                    for (int bj = 0; bj < 2; ++bj) { unsigned q[8];
#pragma unroll
                        for (int n = 0; n < 2; ++n)
#pragma unroll
                            for (int e = 0; e < 4; ++e) { const float gx = sigmoidf(acc[ai][bj][m][n][e] * r + bv[bj][n][e]); q[4 * n + e] = (unsigned)__builtin_fminf(gx * 256.f, 255.f); }
                        u32x2 w; w.x = q[0] | (q[1] << 8) | (q[2] << 16) | (q[3] << 24); w.y = q[4] | (q[5] << 8) | (q[6] << 16) | (q[7] << 24);
                        *(u32x2*)(rowp + bj * 128) = w; } }
        }
    }
};

struct EpiBranch {
    static constexpr bool PERM = true, ACCUM = true;
    bf16_t* O; const unsigned char* G8;
    struct Pre { };
    __device__ __forceinline__ void pre(Pre&, const pg8::Unit&, int, int) const {}
    __device__ __forceinline__ void operator()(f32x4 (&acc)[2][2][4][2], const pg8::Unit& u, int wr, int wc, int fr, int fq, const Pre&) const {
        const int row0 = u.pm * 256 + wr * 64 + fr, col0 = u.pn * 256 + wc * 32 + 8 * fq, j = u.j;
#pragma unroll
        for (int ai = 0; ai < 2; ++ai) {
            u32x2 ga[4][2], gb[4][2];
#pragma unroll
            for (int m = 0; m < 4; ++m)
#pragma unroll
                for (int bj = 0; bj < 2; ++bj) { const size_t row = (size_t)(row0 + ai * 128 + m * 16);
                    ga[m][bj] = *(const u32x2*)(G8 + row * NG + j * 1024 + col0 + bj * 128);
                    gb[m][bj] = (j < 2) ? *(const u32x2*)(G8 + row * NG + (j + 1) * 1024 + col0 + bj * 128) : (u32x2){0u, 0u}; }
#pragma unroll
            for (int m = 0; m < 4; ++m) { const size_t row = (size_t)(row0 + ai * 128 + m * 16);
#pragma unroll
                for (int bj = 0; bj < 2; ++bj) {
                    float f[8];
#pragma unroll
                    for (int e = 0; e < 4; ++e) { f[e] = g8f((ga[m][bj].x >> (8 * e)) & 0xffu); f[4 + e] = g8f((ga[m][bj].y >> (8 * e)) & 0xffu); }
                    if (j < 2) {
#pragma unroll
                        for (int e = 0; e < 4; ++e) { f[e] *= __builtin_amdgcn_rcpf(g8f((gb[m][bj].x >> (8 * e)) & 0xffu)); f[4 + e] *= __builtin_amdgcn_rcpf(g8f((gb[m][bj].y >> (8 * e)) & 0xffu)); }
                    }
#pragma unroll
                    for (int e = 0; e < 4; ++e) { acc[ai][bj][m][0][e] *= f[e]; acc[ai][bj][m][1][e] *= f[4 + e]; }
                    if (j == 2) { const f32x4 v0 = acc[ai][bj][m][0], v1 = acc[ai][bj][m][1]; u32x4 w;
                        w.x = cvt_pk_bf16(v0[0], v0[1]); w.y = cvt_pk_bf16(v0[2], v0[3]); w.z = cvt_pk_bf16(v1[0], v1[1]); w.w = cvt_pk_bf16(v1[2], v1[3]);
                        *(u32x4*)(O + row * DM + col0 + bj * 128) = w; }
                } }
        }
    }
};

struct EpiResid {
    static constexpr bool PERM = false, ACCUM = false;
    const float* xin_f; const bf16_t* xin_b; float* xout_f; bf16_t* xb; float* rowss;
    struct Pre { };
    __device__ __forceinline__ void pre(Pre&, const pg8::Unit&, int, int) const {}
    __device__ __forceinline__ void operator()(f32x4 (&acc)[2][2][4][2], const pg8::Unit& u, int wr, int wc, int fr, int fq, const Pre&) const {
        const int row0 = u.pm * 256 + wr * 64 + fr, col0 = u.pn * 256 + wc * 32 + 4 * fq;
#pragma unroll
        for (int ai = 0; ai < 2; ++ai) {
            f32x4 xr[4][2][2];
            if (xin_f) {
#pragma unroll
                for (int m = 0; m < 4; ++m)
#pragma unroll
                    for (int bj = 0; bj < 2; ++bj)
#pragma unroll
                        for (int n = 0; n < 2; ++n) xr[m][bj][n] = *(const f32x4*)(xin_f + (size_t)(row0 + ai * 128 + m * 16) * DM + col0 + bj * 128 + n * 16);
            } else {
                u32x2 xh[4][2][2];
#pragma unroll
                for (int m = 0; m < 4; ++m)
#pragma unroll
                    for (int bj = 0; bj < 2; ++bj)
#pragma unroll
                        for (int n = 0; n < 2; ++n) xh[m][bj][n] = *(const u32x2*)(xin_b + (size_t)(row0 + ai * 128 + m * 16) * DM + col0 + bj * 128 + n * 16);
#pragma unroll
                for (int m = 0; m < 4; ++m)
#pragma unroll
                    for (int bj = 0; bj < 2; ++bj)
#pragma unroll
                        for (int n = 0; n < 2; ++n) { const u32x2 h = xh[m][bj][n]; xr[m][bj][n] = (f32x4){bf_lo(h.x), bf_hi(h.x), bf_lo(h.y), bf_hi(h.y)}; }
            }
#pragma unroll
            for (int m = 0; m < 4; ++m) { const int row = row0 + ai * 128 + m * 16; const size_t off = (size_t)row * DM + col0; float ss = 0.f;
#pragma unroll
                for (int bj = 0; bj < 2; ++bj)
#pragma unroll
                    for (int n = 0; n < 2; ++n) { const size_t o = off + bj * 128 + n * 16; const f32x4 x = xr[m][bj][n] + acc[ai][bj][m][n];
                        if (xout_f) *(f32x4*)(xout_f + o) = x;
                        if (xb) { u32x2 w; w.x = cvt_pk_bf16(x[0], x[1]); w.y = cvt_pk_bf16(x[2], x[3]); *(u32x2*)(xb + o) = w; ss += (x[0] * x[0] + x[1] * x[1]) + (x[2] * x[2] + x[3] * x[3]); } }
                if (xb) { ss += __shfl_xor(ss, 16); ss += __shfl_xor(ss, 32); if (fq == 0) atomicAdd(rowss + row, ss); } }
        }
    }
};

struct EpiFF1 {
    static constexpr bool PERM = true, ACCUM = false;
    bf16_t* O; const float* rowss; int ldc;
    struct Pre { float v[2][4]; };
    __device__ __forceinline__ void pre(Pre& p, const pg8::Unit& u, int wr, int fr) const {
        const int row0 = u.pm * 256 + wr * 64 + fr;
#pragma unroll
        for (int ai = 0; ai < 2; ++ai)
#pragma unroll
            for (int m = 0; m < 4; ++m) p.v[ai][m] = rowss[row0 + ai * 128 + m * 16];
    }
    __device__ __forceinline__ void operator()(f32x4 (&acc)[2][2][4][2], const pg8::Unit& u, int wr, int wc, int fr, int fq, const Pre& p) const {
        const int row0 = u.pm * 256 + wr * 64 + fr, col0 = u.pn * 256 + wc * 32 + 8 * fq;
        float rsv[2][4];
#pragma unroll
        for (int ai = 0; ai < 2; ++ai)
#pragma unroll
            for (int m = 0; m < 4; ++m) rsv[ai][m] = rsqrtf(p.v[ai][m] * (1.f / DM) + EPS);
#pragma unroll
        for (int ai = 0; ai < 2; ++ai)
#pragma unroll
            for (int m = 0; m < 4; ++m) { const int row = row0 + ai * 128 + m * 16; const float r = rsv[ai][m]; bf16_t* rowp = O + (size_t)row * ldc + col0;
#pragma unroll
                for (int bj = 0; bj < 2; ++bj) { f32x4 v0 = acc[ai][bj][m][0] * r, v1 = acc[ai][bj][m][1] * r;
#pragma unroll
                    for (int e = 0; e < 4; ++e) { const float a = __builtin_fmaxf(v0[e], 0.f), b = __builtin_fmaxf(v1[e], 0.f); v0[e] = a * a; v1[e] = b * b; }
                    u32x4 w; w.x = cvt_pk_bf16(v0[0], v0[1]); w.y = cvt_pk_bf16(v0[2], v0[3]); w.z = cvt_pk_bf16(v1[0], v1[1]); w.w = cvt_pk_bf16(v1[2], v1[3]);
                    *(u32x4*)(rowp + bj * 128) = w; } }
    }
};

template <bool INPERM>
__device__ __forceinline__ void transpose_item(const float* W, const float* kscale, int K, int N, bf16_t* WT, LAS float* scr, int item, int lane) {
    const int nblk = N / 32, kb = item / nblk, nb = item % nblk, k0 = 64 * kb, n0 = 32 * nb;
    float v[32];
#pragma unroll
    for (int i = 0; i < 32; ++i) { const int kk = 2 * i + (lane >> 5); v[i] = __builtin_nontemporal_load(&W[(size_t)(k0 + kk) * N + n0 + (lane & 31)]); }
    if (kscale) {
#pragma unroll
        for (int i = 0; i < 32; ++i) v[i] *= kscale[k0 + 2 * i + (lane >> 5)]; }
#pragma unroll
    for (int i = 0; i < 32; ++i) { const int kk = 2 * i + (lane >> 5); scr[kk * 33 + (lane & 31)] = v[i]; }
    asm volatile("s_waitcnt lgkmcnt(0)" ::: "memory");
    const int c = lane & 7;
    const int r0 = INPERM ? inproj_phys(n0) : n0;
#pragma unroll
    for (int j = 0; j < 4; ++j) { const int n = (lane >> 3) + 8 * j; const LAS float* s = scr + (8 * c) * 33 + n;
        u32x4 o; o.x = cvt_pk_bf16(s[0 * 33], s[1 * 33]); o.y = cvt_pk_bf16(s[2 * 33], s[3 * 33]); o.z = cvt_pk_bf16(s[4 * 33], s[5 * 33]); o.w = cvt_pk_bf16(s[6 * 33], s[7 * 33]);
        *(u32x4*)(WT + (size_t)(r0 + n) * K + k0 + 8 * c) = o; }
    asm volatile("s_waitcnt lgkmcnt(0)" ::: "memory");
}
constexpr int IT_WIN = 16 * 224, IT_BR = 8 * 32, IT_OUT = 16 * 32, IT_F1 = 16 * 128, IT_F2 = 64 * 32;
__device__ __forceinline__ void convert_region_a(const Args& a, int l, LAS unsigned char* lds, int gw, int ngw, int wave, int lane) {
    LAS float* scr = (LAS float*)(lds + wave * 16384);
    unsigned char* ws = a.ws;
    constexpr int NIT = IT_WIN + 3 * IT_BR + IT_OUT;
    for (int it = gw; it < NIT; it += ngw) {
        int r = it;
        if (r < IT_WIN) { transpose_item<true>(a.in[2] + (size_t)l * DM * NIN, a.in[1] + l * DM, DM, NIN, (bf16_t*)(ws + WS_WIN), scr, r, lane); continue; } r -= IT_WIN;
        if (r < 3 * IT_BR) { const int j = r / IT_BR; transpose_item<false>(a.in[12 + j] + (size_t)l * 512 * DM, nullptr, 512, DM, (bf16_t*)(ws + WS_WBR + j * MiB), scr, r % IT_BR, lane); continue; } r -= 3 * IT_BR;
        transpose_item<false>(a.in[15] + (size_t)l * DM * DM, nullptr, DM, DM, (bf16_t*)(ws + WS_WOUT), scr, r, lane);
    }
}
__device__ __forceinline__ void convert_region_b(const Args& a, int l, LAS unsigned char* lds, int gw, int ngw, int wave, int lane) {
    LAS float* scr = (LAS float*)(lds + wave * 16384);
    unsigned char* ws = a.ws;
    constexpr int NIT = IT_F1 + IT_F2;
    for (int it = gw; it < NIT; it += ngw) {
        int r = it;
        if (r < IT_F1) { transpose_item<false>(a.in[17] + (size_t)l * DM * FF, a.in[16] + l * DM, DM, FF, (bf16_t*)(ws + WS_WF1), scr, r, lane); continue; } r -= IT_F1;
        transpose_item<false>(a.in[18] + (size_t)l * FF * DM, nullptr, FF, DM, (bf16_t*)(ws + WS_WF2), scr, r, lane);
    }
}

namespace att {
typedef short bf16x8 __attribute__((ext_vector_type(8)));
typedef short s16x4 __attribute__((ext_vector_type(4)));
typedef short v4i16_t __attribute__((ext_vector_type(4)));
typedef float f32x16 __attribute__((ext_vector_type(16)));
typedef float f32x8 __attribute__((ext_vector_type(8)));
typedef float f32x2_t __attribute__((ext_vector_type(2))); typedef __bf16 bf16x2_t __attribute__((ext_vector_type(2)));
__device__ __forceinline__ unsigned cvtpk_s(float lo, float hi) { f32x2_t v = {lo, hi}; bf16x2_t b = __builtin_convertvector(v, bf16x2_t); return __builtin_bit_cast(unsigned, b); }
__device__ __forceinline__ s16x4 vtr(const LAS unsigned char* p) { return __builtin_bit_cast(s16x4, __builtin_amdgcn_ds_read_tr16_b64_v4i16((LAS v4i16_t*)p)); }
constexpr int KSTR = 144, VSTR = 320, KMAP = 64 * KSTR, V_OFF = 2 * KMAP, BUF = V_OFF + 64 * VSTR;
__device__ __forceinline__ bf16x8 pack8(const f32x16& p, int o) {
    u32x4 w; w.x = cvtpk_s(p[o], p[o + 1]); w.y = cvtpk_s(p[o + 2], p[o + 3]); w.z = cvtpk_s(p[o + 4], p[o + 5]); w.w = cvtpk_s(p[o + 6], p[o + 7]); return __builtin_bit_cast(bf16x8, w); }

__device__ __forceinline__ void attn_unit(bf16_t* PM, bf16_t* obase, int opitch, int b, int h, int qb, float lam, float post, const float* subw, const float* knw, LAS unsigned char* lds, int tid_in) {
    int tid = tid_in; asm volatile("" : "+v"(tid));
    const int lane = tid & 63, wid = __builtin_amdgcn_readfirstlane(tid >> 6), r32 = lane & 31, hi = lane >> 5, m = wid >> 2, qs = wid & 3;
    const int qpos = 128 * qb + 32 * qs + r32;
    bf16_t* base = PM + (size_t)b * SEQ * NPM;
    bf16_t* qrow = base + (size_t)qpos * NPM + C_Q + h * 128;
    bf16_t* orow = obase + (size_t)(b * SEQ + qpos) * opitch + h * 128;
    bf16x8 qr[4];
#pragma unroll
    for (int d0 = 0; d0 < 4; ++d0) qr[d0] = *(const bf16x8*)(qrow + m * 64 + d0 * 16 + hi * 8);
    bool need_check;
    { float qn2 = 0.f;
#pragma unroll
      for (int d0 = 0; d0 < 4; ++d0) { const u32x4 w = __builtin_bit_cast(u32x4, qr[d0]);
          const float a0 = bf_lo(w.x), a1 = bf_hi(w.x), a2 = bf_lo(w.y), a3 = bf_hi(w.y), a4 = bf_lo(w.z), a5 = bf_hi(w.z), a6 = bf_lo(w.w), a7 = bf_hi(w.w);
          qn2 += (a0 * a0 + a1 * a1) + (a2 * a2 + a3 * a3) + (a4 * a4 + a5 * a5) + (a6 * a6 + a7 * a7); }
      qn2 += __shfl_xor(qn2, 32);
      float wk = __builtin_fmaxf(__builtin_fabsf(knw[lane]), __builtin_fabsf(knw[64 + lane]));
#pragma unroll
      for (int o = 1; o < 64; o <<= 1) wk = __builtin_fmaxf(wk, __shfl_xor(wk, o));
      need_check = __any(sqrtf(qn2) * 8.f * wk * 1.02f > 40.f); }
    const int NT = 2 * (qb + 1), my_nt = (qs < 2) ? NT - 1 : NT;
    const float sl2 = __builtin_amdgcn_exp2f(-2.f * (float)(h + 1)) * LOG2E;
    const bf16_t* gk = base + (size_t)(tid >> 3) * NPM + C_K + h * 128 + (tid & 7) * 8;
    const bf16_t* gv = base + (size_t)(tid >> 4) * NPM + C_V + h * 128 + (tid & 15) * 8;
    const int lk = (tid >> 3) * KSTR + (tid & 7) * 16, lv = V_OFF + (tid >> 4) * VSTR + (tid & 15) * 16;
    u32x4 st0, st1, st2, st3;
#define ATT_LOAD(t) do { const size_t ro = (size_t)(t) * 64 * NPM; st0 = *(const u32x4*)(gk + ro); st1 = *(const u32x4*)(gk + ro + 64); st2 = *(const u32x4*)(gv + ro); st3 = *(const u32x4*)(gv + ro + (size_t)32 * NPM); } while (0)
#define ATT_STORE(bufp) do { *(LAS u32x4*)((bufp) + lk) = st0; *(LAS u32x4*)((bufp) + KMAP + lk) = st1; *(LAS u32x4*)((bufp) + lv) = st2; *(LAS u32x4*)((bufp) + lv + 32 * VSTR) = st3; } while (0)
    __syncthreads();
    ATT_LOAD(0); ATT_STORE(lds);
    __syncthreads();
    f32x16 OT[4];
#pragma unroll
    for (int eb = 0; eb < 4; ++eb)
#pragma unroll
        for (int r = 0; r < 16; ++r) OT[eb][r] = 0.f;
    float mref = 0.f, lsum = 0.f;
    const float s64 = 64.f * sl2;
    const float s32 = 32.f * sl2;
    f32x16 ci0;
#pragma unroll
    for (int r = 0; r < 16; ++r) ci0[r] = sl2 * (float)(4 * hi + (r & 3) + 8 * (r >> 2) - qpos);
    for (int t = 0; t < NT; ++t) {
        LAS unsigned char* buf = lds + (t & 1) * BUF;
        if (t + 1 < NT) ATT_LOAD(t + 1);
        if (t < my_nt) {
            const LAS unsigned char* kp = buf + m * KMAP + r32 * KSTR + hi * 16;
            f32x16 p0 = ci0, p1 = ci0 + s32;
            if (t == my_nt - 1) {
                int hid = hi; asm volatile("" : "+v"(hid));
                const float qf = (float)qpos, k0 = (float)(64 * t + 4 * hid), cadd = -mref;
#pragma unroll
                for (int r = 0; r < 16; ++r) { const float kf = k0 + (float)((r & 3) + 8 * (r >> 2));
                    p0[r] = __builtin_fmaf(-sl2, __builtin_fabsf(qf - kf), cadd); p1[r] = __builtin_fmaf(-sl2, __builtin_fabsf(qf - (kf + 32.f)), cadd); }
            }
            bf16x8 ka[4], kb2[4];
#pragma unroll
            for (int d0 = 0; d0 < 4; ++d0) { ka[d0] = *(const LAS bf16x8*)(kp + d0 * 32); kb2[d0] = *(const LAS bf16x8*)(kp + 32 * KSTR + d0 * 32); }
#pragma unroll
            for (int d0 = 0; d0 < 4; ++d0) {
                p0 = __builtin_amdgcn_mfma_f32_32x32x16_bf16(ka[d0], qr[d0], p0, 0, 0, 0);
                p1 = __builtin_amdgcn_mfma_f32_32x32x16_bf16(kb2[d0], qr[d0], p1, 0, 0, 0);
            }
            const LAS unsigned char* vp = buf + V_OFF + (4 * hi + ((lane & 15) >> 2)) * VSTR + ((lane >> 4) & 1) * 32 + (lane & 3) * 8;
            s16x4 vlo[2][4], vhi[2][4];
#pragma unroll
            for (int eb = 0; eb < 4; ++eb) { vlo[0][eb] = vtr(vp + eb * 64); vhi[0][eb] = vtr(vp + 8 * VSTR + eb * 64); }
            float mt = 0.f;
            if (need_check) { mt = __builtin_fmaxf(p0[0], p1[0]);
#pragma unroll
                for (int r = 1; r < 16; ++r) mt = __builtin_fmaxf(__builtin_fmaxf(mt, p0[r]), p1[r]);
                mt = __builtin_fmaxf(mt, __shfl_xor(mt, 32)); }
            if (need_check && __any(mt > 40.f)) {
                const float dl = __builtin_fmaxf(mt, 0.f), f = __builtin_amdgcn_exp2f(-dl);
                mref += dl; lsum *= f; p0 -= dl; p1 -= dl; ci0 -= dl;
#pragma unroll
                for (int eb = 0; eb < 4; ++eb) OT[eb] *= f;
            }
#if PROBE == 13
            { float dz = 0.f;
#pragma unroll
              for (int r = 0; r < 16; ++r) { dz += __builtin_amdgcn_exp2f(p0[r] + 1.f) + __builtin_amdgcn_exp2f(p1[r] + 1.f); }
              asm volatile("" :: "v"(dz)); }
#endif
#if PROBE == 14
            { f32x16 dacc = p0;
#pragma unroll
              for (int d0 = 0; d0 < 4; ++d0) { dacc = __builtin_amdgcn_mfma_f32_32x32x16_bf16(ka[d0], qr[d0], dacc, 0, 0, 0); dacc = __builtin_amdgcn_mfma_f32_32x32x16_bf16(kb2[d0], qr[d0], dacc, 0, 0, 0); }
              asm volatile("" :: "v"(dacc)); }
#endif
#pragma unroll
            for (int r = 0; r < 16; ++r) { p0[r] = __builtin_amdgcn_exp2f(p0[r]); p1[r] = __builtin_amdgcn_exp2f(p1[r]); }
            { const f32x16 s16 = p0 + p1; const f32x8 s8 = s16.lo + s16.hi; const f32x4 s4v = s8.lo + s8.hi; const f32x2_t s2 = s4v.lo + s4v.hi; lsum += s2.x + s2.y; }
            ci0 += s64;
            bf16x8 pf[4]; pf[0] = pack8(p0, 0); pf[1] = pack8(p0, 8); pf[2] = pack8(p1, 0); pf[3] = pack8(p1, 8);
#pragma unroll
            for (int s4 = 0; s4 < 4; ++s4) {
                if (s4 < 3) {
#pragma unroll
                    for (int eb = 0; eb < 4; ++eb) { vlo[(s4 + 1) & 1][eb] = vtr(vp + (16 * (s4 + 1)) * VSTR + eb * 64); vhi[(s4 + 1) & 1][eb] = vtr(vp + (16 * (s4 + 1) + 8) * VSTR + eb * 64); }
                }
#pragma unroll
                for (int eb = 0; eb < 4; ++eb) {
                    const s16x4 a = vlo[s4 & 1][eb], c = vhi[s4 & 1][eb];
                    const bf16x8 vf = (bf16x8){a[0], a[1], a[2], a[3], c[0], c[1], c[2], c[3]};
                    OT[eb] = __builtin_amdgcn_mfma_f32_32x32x16_bf16(vf, pf[s4], OT[eb], 0, 0, 0);
                }
            }
        }
        if (t + 1 < NT) ATT_STORE(lds + ((t + 1) & 1) * BUF);
        __syncthreads();
    }
#undef ATT_LOAD
#undef ATT_STORE
    lsum += __shfl_xor(lsum, 32);
    const float inv = 1.f / lsum;
#pragma unroll
    for (int eb = 0; eb < 4; ++eb)
#pragma unroll
        for (int r = 0; r < 16; ++r) OT[eb][r] *= inv;
    int hif = hi, lanef = lane; asm volatile("" : "+v"(hif), "+v"(lanef));
    LAS float* X = (LAS float*)(lds + qs * 16384) + lanef;
    if (m == 1) {
#pragma unroll
        for (int eb = 0; eb < 4; ++eb)
#pragma unroll
            for (int r = 0; r < 16; ++r) X[(eb * 16 + r) * 64] = OT[eb][r];
    }
    __syncthreads();
    if (m == 0) {
        float ss = 0.f;
#pragma unroll
        for (int eb = 0; eb < 4; ++eb) {
            __builtin_amdgcn_sched_barrier(0);
#pragma unroll
            for (int r = 0; r < 16; ++r) { const float o = OT[eb][r] - lam * X[(eb * 16 + r) * 64]; OT[eb][r] = o; ss += o * o; } }
        __builtin_amdgcn_sched_barrier(0);
        ss += __shfl_xor(ss, 32);
        const float rn = rsqrtf(ss * (1.f / 128.f) + EPS) * post;
        f32x4 w4a[4][4];
#pragma unroll
        for (int eb = 0; eb < 4; ++eb)
#pragma unroll
            for (int rg = 0; rg < 4; ++rg) w4a[eb][rg] = *(const f32x4*)(subw + 32 * eb + 8 * rg + 4 * hif);
#pragma unroll
        for (int eb = 0; eb < 4; ++eb)
#pragma unroll
            for (int rg = 0; rg < 4; ++rg) { const int e = 32 * eb + 8 * rg + 4 * hif; const f32x4 w4 = w4a[eb][rg];
                u32x2 w; w.x = cvtpk_s(OT[eb][4 * rg] * rn * w4[0], OT[eb][4 * rg + 1] * rn * w4[1]); w.y = cvtpk_s(OT[eb][4 * rg + 2] * rn * w4[2], OT[eb][4 * rg + 3] * rn * w4[3]);
                *(u32x2*)(orow + e) = w; }
    }
}
}

__device__ __forceinline__ void gmlp_unit(bf16_t* PM, bf16_t* obase, int opitch, const float* avss, const float* vnw, const float* ws_g, const float* bs_g, int rowbase, int g, LAS unsigned char* lds, int tid) {
    constexpr int VSTR = 320, WSTR = 272, W_OFF = 128 * VSTR;
    const int lane = tid & 63, wid = __builtin_amdgcn_readfirstlane(tid >> 6), r32 = lane & 31, hi = lane >> 5;
    __syncthreads();
    {
        const int row = tid >> 2, part = tid & 3;
        const bf16_t* rp = PM + (size_t)(rowbase + row) * NPM + C_AV;
        const float r = rsqrtf(avss[rowbase + row] * (1.f / 512.f) + EPS);
        const int c0 = part * 32;
#pragma unroll
        for (int i = 0; i < 4; ++i) { const u32x4 w = *(const u32x4*)(rp + g * 128 + c0 + i * 8); const float* nw = vnw + g * 128 + c0 + i * 8;
            const f32x4 n0 = *(const f32x4*)nw, n1 = *(const f32x4*)(nw + 4); u32x4 o;
            o.x = att::cvtpk_s(bf_lo(w.x) * r * n0[0], bf_hi(w.x) * r * n0[1]); o.y = att::cvtpk_s(bf_lo(w.y) * r * n0[2], bf_hi(w.y) * r * n0[3]);
            o.z = att::cvtpk_s(bf_lo(w.z) * r * n1[0], bf_hi(w.z) * r * n1[1]); o.w = att::cvtpk_s(bf_lo(w.w) * r * n1[2], bf_hi(w.w) * r * n1[3]);
            *(LAS u32x4*)(lds + row * VSTR + (c0 + i * 8) * 2) = o; }
#pragma unroll
        for (int i = 0; i < 4; ++i) { const int e8 = (i * 512 + tid) * 8, t = e8 >> 7, s0 = e8 & 127; f32x4 a = *(const f32x4*)(ws_g + e8), b = *(const f32x4*)(ws_g + e8 + 4);
#pragma unroll
            for (int e = 0; e < 4; ++e) { if (s0 + e > t) a[e] = 0.f; if (s0 + 4 + e > t) b[e] = 0.f; }
            u32x4 o; o.x = att::cvtpk_s(a[0], a[1]); o.y = att::cvtpk_s(a[2], a[3]); o.z = att::cvtpk_s(b[0], b[1]); o.w = att::cvtpk_s(b[2], b[3]);
            *(LAS u32x4*)(lds + W_OFF + t * WSTR + s0 * 2) = o; }
    }
    __syncthreads();
    const int cb = wid & 3;
    const LAS unsigned char* vp = lds + (8 * hi + ((lane & 15) >> 2)) * VSTR + (32 * cb + 16 * ((lane >> 4) & 1) + 4 * (lane & 3)) * 2;
#pragma unroll
    for (int pass = 0; pass < 2; ++pass) {
        const int tb = pass == 0 ? (wid >> 2) : 3 - (wid >> 2);
        att::f32x16 acc;
#pragma unroll
        for (int r = 0; r < 16; ++r) acc[r] = 0.f;
        const LAS unsigned char* wp = lds + W_OFF + (32 * tb + r32) * WSTR + hi * 16;
        const int nk = 2 * (tb + 1);
        for (int kk = 0; kk < nk; ++kk) {
            const att::s16x4 vlo = att::vtr(vp + (16 * kk) * VSTR), vhi = att::vtr(vp + (16 * kk + 4) * VSTR);
            const att::bf16x8 A = (att::bf16x8){vlo[0], vlo[1], vlo[2], vlo[3], vhi[0], vhi[1], vhi[2], vhi[3]};
            const att::bf16x8 B = *(const LAS att::bf16x8*)(wp + kk * 32);
            acc = __builtin_amdgcn_mfma_f32_32x32x16_bf16(A, B, acc, 0, 0, 0);
        }
        const int t = 32 * tb + r32; const float bsv = bs_g[t];
        u32x2 uua[4];
#pragma unroll
        for (int rg = 0; rg < 4; ++rg) uua[rg] = *(const u32x2*)(PM + (size_t)(rowbase + t) * NPM + C_AU + g * 128 + 32 * cb + 8 * rg + 4 * hi);
#pragma unroll
        for (int rg = 0; rg < 4; ++rg) { const int c = 32 * cb + 8 * rg + 4 * hi;
            const u32x2 uu = uua[rg];
            u32x2 o; o.x = att::cvtpk_s(bf_lo(uu.x) * (acc[4 * rg] + bsv), bf_hi(uu.x) * (acc[4 * rg + 1] + bsv)); o.y = att::cvtpk_s(bf_lo(uu.y) * (acc[4 * rg + 2] + bsv), bf_hi(uu.y) * (acc[4 * rg + 3] + bsv));
            *(u32x2*)(obase + (size_t)(rowbase + t) * opitch + g * 128 + c) = o; }
    }
}

__device__ __forceinline__ void conv_items(bf16_t* PM, bf16_t* obase, int opitch, const float* cw, int gtid, int gthreads) {
    const int c0 = (gtid & 63) * 8;
    float cwv[3][8];
#pragma unroll
    for (int j = 0; j < 3; ++j)
#pragma unroll
        for (int e = 0; e < 8; ++e) cwv[j][e] = cw[j * 512 + c0 + e];
    for (int idx = gtid; idx < M * 64; idx += 4 * gthreads) {
        u32x4 A[4][3], B[4][3], CB[4];
#pragma unroll
        for (int u = 0; u < 4; ++u) { const int i = (idx + u * gthreads < M * 64) ? idx + u * gthreads : idx; const int row = i >> 6, spos = row & (SEQ - 1);
            const bf16_t* rp = PM + (size_t)row * NPM;
#pragma unroll
            for (int j = 0; j < 3; ++j) { const int dt = (spos >= 2 - j) ? 2 - j : 0; A[u][j] = *(const u32x4*)(rp - (size_t)dt * NPM + C_CC + c0); B[u][j] = *(const u32x4*)(rp - (size_t)dt * NPM + C_CX + c0); }
            CB[u] = *(const u32x4*)(rp + C_CB + c0); }
#pragma unroll
        for (int u = 0; u < 4; ++u) { const int i = idx + u * gthreads; if (i < M * 64) { const int row = i >> 6, spos = row & (SEQ - 1);
            float y[8];
#pragma unroll
            for (int e = 0; e < 8; ++e) y[e] = 0.f;
#pragma unroll
            for (int j = 0; j < 3; ++j) { const float mk = (spos >= 2 - j) ? 1.f : 0.f; const u32x4 a = A[u][j], b2 = B[u][j];
                y[0] += mk * cwv[j][0] * (bf_lo(a.x) * bf_lo(b2.x)); y[1] += mk * cwv[j][1] * (bf_hi(a.x) * bf_hi(b2.x)); y[2] += mk * cwv[j][2] * (bf_lo(a.y) * bf_lo(b2.y)); y[3] += mk * cwv[j][3] * (bf_hi(a.y) * bf_hi(b2.y));
                y[4] += mk * cwv[j][4] * (bf_lo(a.z) * bf_lo(b2.z)); y[5] += mk * cwv[j][5] * (bf_hi(a.z) * bf_hi(b2.z)); y[6] += mk * cwv[j][6] * (bf_lo(a.w) * bf_lo(b2.w)); y[7] += mk * cwv[j][7] * (bf_hi(a.w) * bf_hi(b2.w)); }
            const u32x4 cb = CB[u];
            u32x4 w; w.x = cvt_pk_bf16(bf_lo(cb.x) * y[0], bf_hi(cb.x) * y[1]); w.y = cvt_pk_bf16(bf_lo(cb.y) * y[2], bf_hi(cb.y) * y[3]);
            w.z = cvt_pk_bf16(bf_lo(cb.z) * y[4], bf_hi(cb.z) * y[5]); w.w = cvt_pk_bf16(bf_lo(cb.w) * y[6], bf_hi(cb.w) * y[7]);
            *(u32x4*)(obase + (size_t)row * opitch + c0) = w; } }
    }
}

constexpr int N_PHASES = 1 + 6 * DEPTH;
__global__ void __launch_bounds__(NWAVES * 64, 2) fwd_kernel(Args args) {
    extern __shared__ __attribute__((aligned(16))) unsigned char lds_raw[];
    LAS unsigned char* lds = (LAS unsigned char*)lds_raw;
    const int G = gridDim.x, bx = blockIdx.x, ngw = G * NWAVES, gthreads = G * NWAVES * 64;
#define TIDS() int tid_ = threadIdx.x; asm volatile("" : "+v"(tid_)); const int tid = tid_, lane = tid & 63, wave = __builtin_amdgcn_readfirstlane(tid >> 6), gw = bx * NWAVES + wave, gtid = bx * (NWAVES * 64) + tid; (void)lane; (void)gw; (void)gtid
    unsigned char* ws = args.ws;
    float* ROWSS = (float*)(ws + WS_CTL);
    bf16_t* XB = (bf16_t*)(ws + WS_XB); bf16_t* PM = (bf16_t*)(ws + WS_PM); bf16_t* XBM = (bf16_t*)(ws + WS_PM); bf16_t* HB = (bf16_t*)(ws + WS_HB);
    unsigned char* G8 = ws + WS_G8;
    const int lo = args.ph_lo, hi = args.ph_hi;
#if !MK_MULTI
    cg::grid_group grid = cg::this_grid();
    volatile LAS unsigned* bst = (volatile LAS unsigned*)(lds + RING_BYTES + 512);
    if (threadIdx.x < 2) bst[threadIdx.x] = 0u;
    __syncthreads();
    const XcdBarrier xbar = xcd_barrier_post((unsigned*)(ws + WS_BAR), bst);
#define SEAM(ph) do { if ((ph) + 1 < hi) { if (PROBE != 12 && hi > 1000) grid.sync();   xcd_barrier(xbar); if (PROBE == 6) { xcd_barrier(xbar); xcd_barrier(xbar); } } } while (0)
#else
#define SEAM(ph) do { } while (0)
#endif
#define IN(k) (lo <= (k) && (k) < hi)
#if PROBE >= 20
    unsigned long long tp_acc = 0, tp_t0 = 0;
#define TP_BEGIN(type) do { if (PROBE - 20 == (type)) tp_t0 = __builtin_amdgcn_s_memrealtime(); } while (0)
#define TP_END(type) do { if (PROBE - 20 == (type)) tp_acc += __builtin_amdgcn_s_memrealtime() - tp_t0; } while (0)
#else
#define TP_BEGIN(type) do { } while (0)
#define TP_END(type) do { } while (0)
#endif

    TP_BEGIN(0);
    if (IN(0)) {
        TIDS();
        for (int rep = 0; rep < (PROBE == 1 ? 2 : 1); ++rep) {
        convert_region_a(args, 0, lds, gw, ngw, wave, lane);
        convert_region_b(args, 0, lds, gw, ngw, wave, lane); }
        const float* x = args.in[0];
        for (int r = gw; r < M; r += 2 * ngw) {
            const int r2 = (r + ngw < M) ? r + ngw : r;
            const f32x4* xr = (const f32x4*)(x + (size_t)r * DM) + lane; const f32x4* xr2 = (const f32x4*)(x + (size_t)r2 * DM) + lane;
            f32x4 va[4], vb[4];
#pragma unroll
            for (int j = 0; j < 4; ++j) { va[j] = __builtin_nontemporal_load(&xr[64 * j]); vb[j] = __builtin_nontemporal_load(&xr2[64 * j]); }
            u32x2* o = (u32x2*)(XB + (size_t)r * DM) + lane; u32x2* o2 = (u32x2*)(XB + (size_t)r2 * DM) + lane; float s = 0.f, s2 = 0.f;
#pragma unroll
            for (int j = 0; j < 4; ++j) { const f32x4 v = va[j]; s += (v[0] * v[0] + v[1] * v[1]) + (v[2] * v[2] + v[3] * v[3]); u32x2 w; w.x = cvt_pk_bf16(v[0], v[1]); w.y = cvt_pk_bf16(v[2], v[3]); o[64 * j] = w;
                const f32x4 q = vb[j]; s2 += (q[0] * q[0] + q[1] * q[1]) + (q[2] * q[2] + q[3] * q[3]); u32x2 w2; w2.x = cvt_pk_bf16(q[0], q[1]); w2.y = cvt_pk_bf16(q[2], q[3]); o2[64 * j] = w2; }
            s = wave_sum(s); s2 = wave_sum(s2); if (lane == 0) { ROWSS[r] = s; ROWSS[r2] = s2; }
        }
        SEAM(0);
    }
    TP_END(0);
    for (int l = 0; l < DEPTH; ++l) {
        const int pb = 1 + 6 * l;
        const float* xres_in = (l == 0) ? args.in[0] : args.out;
        TP_BEGIN(1);
        if (IN(pb + 0)) {
            pg8::Gemm g{XB, (const bf16_t*)(ws + WS_WIN), DM, DM, 0, 0, 0}; pg8::StaticOrder S; S.init(M, NIN, G, bx, 1, WGM_IN);
            EpiInProj E{PM, G8, ROWSS + (size_t)(2 * l) * M, args.in[3] + l * NG, args.in[7] + l * 128, args.in[8] + l * 128, ROWSS + (size_t)(4 + l) * M};
            pg8::gemm_phase<EpiInProj, pg8::StaticOrder>(lds, g, S, E);
#if PROBE == 2
            pg8::gemm_phase<EpiInProj, pg8::StaticOrder>(lds, g, S, E);
#endif
            SEAM(pb + 0);
        }
        TP_END(1);
        TP_BEGIN(2);
        if (IN(pb + 1)) {
            TIDS();
            if (l == 1) convert_region_b(args, 1, lds, gw, ngw, wave, lane);
            const float* lp = args.in[9] + l * 256;
            const float sa = wave_sum(lp[lane] * lp[64 + lane]), sb = wave_sum(lp[128 + lane] * lp[192 + lane]);
            const float lam_init = 0.8f - 0.6f * expf(-0.3f * (float)l);
            const float lam = expf(sa) - expf(sb) + lam_init;
#if PROBE == 4
            for (int pi = bx; pi < 256; pi += G) { const int bh = pi >> 4, sq = pi & 15;
                att::attn_unit(PM, XB, DM, bh >> 2, bh & 3, 31 - sq, lam, 1.f - lam_init, args.in[10] + l * 128, args.in[8] + l * 128, lds, tid);
                att::attn_unit(PM, XB, DM, bh >> 2, bh & 3, sq, lam, 1.f - lam_init, args.in[10] + l * 128, args.in[8] + l * 128, lds, tid); }
#endif
            for (int pi = bx; pi < 256; pi += G) { const int bh = pi >> 4, sq = pi & 15;
                att::attn_unit(PM, PM + C_Q, NPM, bh >> 2, bh & 3, 31 - sq, lam, 1.f - lam_init, args.in[10] + l * 128, args.in[8] + l * 128, lds, tid);
                att::attn_unit(PM, PM + C_Q, NPM, bh >> 2, bh & 3, sq, lam, 1.f - lam_init, args.in[10] + l * 128, args.in[8] + l * 128, lds, tid); }
#if PROBE == 5
            for (int uu = bx; uu < 512; uu += G) { const int g4 = uu & 3, blk = uu >> 2;
                gmlp_unit(PM, XB, DM, ROWSS + (size_t)(4 + l) * M, args.in[4] + l * 512, args.in[5] + (size_t)(l * 4 + g4) * 16384, args.in[6] + (l * 4 + g4) * 128, blk * 128, g4, lds, tid); }
#endif
            for (int uu = bx; uu < 512; uu += G) { const int g4 = uu & 3, blk = uu >> 2;
                gmlp_unit(PM, PM + C_AU, NPM, ROWSS + (size_t)(4 + l) * M, args.in[4] + l * 512, args.in[5] + (size_t)(l * 4 + g4) * 16384, args.in[6] + (l * 4 + g4) * 128, blk * 128, g4, lds, tid); }
#if PROBE == 8
            conv_items(PM, XB, DM, args.in[11] + l * 1536, gtid, gthreads);
#endif
            conv_items(PM, PM + C_CB, NPM, args.in[11] + l * 1536, gtid, gthreads);
            SEAM(pb + 1);
        }
        TP_END(2);
        TP_BEGIN(3);
        if (IN(pb + 2)) {
            pg8::Gemm g{PM + C_AU, (const bf16_t*)(ws + WS_WBR), NPM, 512, (size_t)(C_Q - C_AU) * 2, (size_t)(C_CB - C_AU) * 2, MiB}; pg8::StaticOrder S; S.init(M, DM, G, bx, 3, WGM_N1);
            EpiBranch E{(bf16_t*)args.out, G8};
            pg8::gemm_phase<EpiBranch, pg8::StaticOrder>(lds, g, S, E);
#if PROBE == 7
            pg8::gemm_phase<EpiBranch, pg8::StaticOrder>(lds, g, S, E);
#endif
            SEAM(pb + 2);
        }
        TP_END(3);
        TP_BEGIN(4);
        if (IN(pb + 3)) {
            pg8::Gemm g{(const bf16_t*)args.out, (const bf16_t*)(ws + WS_WOUT), DM, DM, 0, 0, 0}; pg8::StaticOrder S; S.init(M, DM, G, bx, 1, WGM_N1);
            EpiResid E{(l == 0) ? args.in[0] : nullptr, (l == 0) ? nullptr : XB, nullptr, XBM, ROWSS + (size_t)(2 * l + 1) * M};
#if 0
            { EpiResid E2{args.in[0], (float*)(ws + WS_HB), nullptr, nullptr}; pg8::gemm_phase<EpiResid, pg8::StaticOrder>(lds, g, S, E2); }
#endif
            pg8::gemm_phase<EpiResid, pg8::StaticOrder>(lds, g, S, E);
            SEAM(pb + 3);
        }
        TP_END(4);
        TP_BEGIN(5);
        if (IN(pb + 4)) {
            if (l == 0) { TIDS(); convert_region_a(args, 1, lds, gw, ngw, wave, lane); }
            __syncthreads();
            pg8::Gemm g{XBM, (const bf16_t*)(ws + WS_WF1), DM, DM, 0, 0, 0}; pg8::StaticOrder S; S.init(M, FF, G, bx, 1, WGM_FF);
            EpiFF1 E{HB, ROWSS + (size_t)(2 * l + 1) * M, FF};
            pg8::gemm_phase<EpiFF1, pg8::StaticOrder>(lds, g, S, E);
#if PROBE == 3
            pg8::gemm_phase<EpiFF1, pg8::StaticOrder>(lds, g, S, E);
#endif
            SEAM(pb + 4);
        }
        TP_END(5);
        TP_BEGIN(6);
        if (IN(pb + 5)) {
            pg8::Gemm g{HB, (const bf16_t*)(ws + WS_WF2), FF, FF, 0, 0, 0}; pg8::StaticOrder S; S.init(M, DM, G, bx, 1, WGM_N1);
            EpiResid E{nullptr, XBM, (l + 1 < DEPTH) ? nullptr : args.out, (l + 1 < DEPTH) ? XB : nullptr, ROWSS + (size_t)(2 * l + 2 < 4 ? 2 * l + 2 : 0) * M};
#if 0
            { EpiFF1 E2{XBM, ROWSS + (size_t)(2 * l + 1) * M, DM}; pg8::gemm_phase<EpiFF1, pg8::StaticOrder>(lds, g, S, E2); }
#endif
            pg8::gemm_phase<EpiResid, pg8::StaticOrder>(lds, g, S, E);
            SEAM(pb + 5);
        }
        TP_END(6);
    }
#if PROBE >= 20
    if (blockIdx.x == 0 && threadIdx.x == 0) { const unsigned long long tb = __builtin_amdgcn_s_memrealtime(); while (__builtin_amdgcn_s_memrealtime() - tb < 4 * tp_acc) __builtin_amdgcn_s_sleep(8); }
#endif
#undef IN
#undef SEAM
}

extern "C" void kernel_launch(void* const* d_in, const int* in_sizes, int n_in, void* d_out, int out_size, void* d_ws, size_t ws_size, hipStream_t stream) {
    static int grid = 0;
    if (grid == 0) {
        if (n_in != 19 || in_sizes[0] != M * DM || out_size != M * DM || ws_size < WS_END) { fprintf(stderr, "kernel_launch: unexpected shapes / workspace (%d inputs, ws %zu)\n", n_in, ws_size); grid = -1; return; }
        int dev = 0, cus = 0, per_cu = 0;
        if (hipGetDevice(&dev) != hipSuccess || hipDeviceGetAttribute(&cus, hipDeviceAttributeMultiprocessorCount, dev) != hipSuccess) { grid = -1; return; }
        if (hipFuncSetAttribute((const void*)fwd_kernel, hipFuncAttributeMaxDynamicSharedMemorySize, LDS_BYTES) != hipSuccess) { fprintf(stderr, "kernel_launch: hipFuncSetAttribute failed\n"); grid = -1; return; }
        if (hipOccupancyMaxActiveBlocksPerMultiprocessor(&per_cu, (const void*)fwd_kernel, NWAVES * 64, LDS_BYTES) != hipSuccess || per_cu < 1) { fprintf(stderr, "kernel_launch: occupancy query says %d blocks per CU\n", per_cu); grid = -1; return; }
        grid = cus;
    }
    if (grid < 0) return;
    (void)hipMemsetAsync((char*)d_ws + WS_CTL, 0, CTL_BYTES, stream);
#if PROBE == 11
    (void)hipMemsetAsync((char*)d_ws + WS_END, 0, CTL_BYTES, stream);
    (void)hipMemsetAsync((char*)d_ws + WS_END + CTL_BYTES, 0, CTL_BYTES, stream);
#endif
    Args a{};
    for (int i = 0; i < 19; ++i) a.in[i] = (const float*)d_in[i];
    a.out = (float*)d_out; a.ws = (unsigned char*)d_ws;
#if MK_MULTI
    for (int p = 0; p < N_PHASES; ++p) { a.ph_lo = p; a.ph_hi = p + 1; hipLaunchKernelGGL(fwd_kernel, dim3(grid), dim3(NWAVES * 64), LDS_BYTES, stream, a); }
#else
    a.ph_lo = 0; a.ph_hi = N_PHASES;
    void* kargs[] = {&a};
#if PROBE == 12
    (void)kargs; hipLaunchKernelGGL(fwd_kernel, dim3(grid), dim3(NWAVES * 64), LDS_BYTES, stream, a); hipError_t e = hipSuccess;
#else
    hipError_t e = hipLaunchCooperativeKernel((const void*)fwd_kernel, dim3(grid), dim3(NWAVES * 64), kargs, LDS_BYTES, stream);
#endif
    if (e != hipSuccess) fprintf(stderr, "kernel_launch: cooperative launch failed: %s (grid %d)\n", hipGetErrorString(e), grid);
#endif
}
```

```cpp
#include <hip/hip_runtime.h>
#include <hip/hip_cooperative_groups.h>
#include <cstdio>
#include <cstdint>
namespace cg = cooperative_groups;

#ifndef PROBE
#define PROBE 0
#endif
#ifndef WGM_IN
#define WGM_IN 4
#endif
#ifndef WGM_FF
#define WGM_FF 4
#endif
#ifndef WGM_N1
#define WGM_N1 4
#endif
#ifndef MK_MULTI
#define MK_MULTI 0
#endif

namespace pg8 {
#define PG8_LAS __attribute__((address_space(3)))
typedef unsigned short bf16_t;
typedef short bf16x8 __attribute__((ext_vector_type(8)));
typedef float f32x4 __attribute__((ext_vector_type(4)));
typedef unsigned u32x4 __attribute__((ext_vector_type(4)));
typedef unsigned u32x2 __attribute__((ext_vector_type(2)));
constexpr int BM = 256, BK = 64, HALF = 128, HTB = HALF * BK * 2, STAGE_BYTES = 8 * HTB, NXCD = 8;

__host__ __device__ __forceinline__ int lds_byte(int r, int c) { const int st = (r >> 4) * 2 + (c >> 5), rr = r & 15, cc = c & 31, ob = rr * 64 + cc * 2; return st * 1024 + (ob ^ (((ob >> 9) & 1) << 5)); }
__host__ __device__ __forceinline__ void stage_rc(int b, int& R, int& C) { const int st = b / 1024, sb = b % 1024, swz = sb ^ (((sb >> 9) & 1) << 5); R = (st >> 1) * 16 + swz / 64; C = (st & 1) * 32 + (swz % 64) / 2; }
__host__ __device__ __forceinline__ int perm32(int rho) { const int n = rho >> 4, i = rho & 15; return 8 * (i >> 2) + 4 * n + (i & 3); }

struct Unit { int pm, pn, j; };
struct Gemm { const bf16_t* A; const bf16_t* Bt; int lda, K; size_t a_j1, a_j2, b_j;
    __device__ __forceinline__ size_t aoff(int j) const { return j == 0 ? (size_t)0 : (j == 1 ? a_j1 : a_j2); } };

struct StaticOrder {
    int nM, nN, nwg, G, c, NJ, WGM;
    __host__ __device__ void init(int M, int N, int G_, int c_, int NJ_ = 1, int WGM_ = 4) { nM = M / BM; nN = N / BM; nwg = nM * nN; G = G_; c = c_; NJ = NJ_; WGM = WGM_; }
    __host__ __device__ bool next(int i, Unit& u) const {
        const int ti = i / NJ; u.j = i - ti * NJ;
        const long L = (long)ti * G + c; if (L >= nwg) return false;
        int wgid = (int)L; { const int q = nwg / NXCD, r = nwg % NXCD, xcd = wgid % NXCD, off = wgid / NXCD; wgid = (xcd < r ? xcd * (q + 1) : r * (q + 1) + (xcd - r) * q) + off; }
        const int nig = WGM * nN, gid = wgid / nig, fm = gid * WGM, gsz = (nM - fm) < WGM ? (nM - fm) : WGM;
        u.pm = fm + ((wgid % nig) % gsz); u.pn = (wgid % nig) / gsz; return true;
    }
};

__device__ __forceinline__ unsigned cvt_pk_bf16(float lo, float hi) { unsigned r; asm volatile("v_cvt_pk_bf16_f32 %0, %1, %2" : "=v"(r) : "v"(lo), "v"(hi)); return r; }

template <class Epi, class Sched>
__device__ __forceinline__ void gemm_phase(PG8_LAS unsigned char* lds, const Gemm g, const Sched& S, const Epi& E) {
    int tid_ = threadIdx.x; asm volatile("" : "+v"(tid_));
    const int tid = tid_, wid = __builtin_amdgcn_readfirstlane(tid >> 6), lane = tid & 63, wr = wid >> 2, wc = wid & 3, fr = lane & 15, fq = lane >> 4;
    const int K = g.K, nt = K / BK, lda = g.lda;
    unsigned voffA[2], voffB[2];
#pragma unroll
    for (int i = 0; i < 2; ++i) { int R, C; stage_rc(tid * 16 + i * 8192, R, C); const int Rb = Epi::PERM ? ((R & ~31) + perm32(R & 31)) : R;
        voffA[i] = (unsigned)(R * lda + C) * 2u; voffB[i] = (unsigned)(Rb * K + C) * 2u; }
    const size_t kstep = (size_t)(BK * 2);
    const size_t hstepA = (size_t)HALF * lda * 2, hstepB = (size_t)HALF * K * 2;
    const size_t tstepA = 2 * hstepA, tstepB = 2 * hstepB;
    const unsigned ldsw = (unsigned)wid * 1024u;
    const int aoff = lds_byte(wr * 64 + fr, fq * 8), boff = lds_byte(wc * 32 + fr, fq * 8);
#define PG8_SA(b, h) (((b) * 2 + (h)) * HTB)
#define PG8_SB(b, h) ((4 + (b) * 2 + (h)) * HTB)
#define PG8_STAGE(bufoff, gbase, voff) do { _Pragma("unroll") for (int _i = 0; _i < 2; ++_i) \
        __builtin_amdgcn_global_load_lds((const unsigned*)((const char*)(gbase) + (voff)[_i]), (PG8_LAS unsigned*)(lds + (bufoff) + ldsw + _i * 8192), 16, 0, 0); } while (0)
#define PG8_LDA(dst, b, h) do { _Pragma("unroll") for (int m = 0; m < 4; ++m) _Pragma("unroll") for (int k = 0; k < 2; ++k) dst[m][k] = *(const PG8_LAS bf16x8*)(lds + PG8_SA(b, h) + aoff + m * 2048 + k * 1024); } while (0)
#define PG8_LDB(dst, b, h) do { _Pragma("unroll") for (int n = 0; n < 2; ++n) _Pragma("unroll") for (int k = 0; k < 2; ++k) dst[n][k] = *(const PG8_LAS bf16x8*)(lds + PG8_SB(b, h) + boff + n * 2048 + k * 1024); } while (0)
#define PG8_MMA(ai, bj, At, Bt) do { __builtin_amdgcn_s_setprio(1); _Pragma("unroll") for (int m = 0; m < 4; ++m) _Pragma("unroll") for (int n = 0; n < 2; ++n) _Pragma("unroll") for (int k = 0; k < 2; ++k) \
        acc[ai][bj][m][n] = __builtin_amdgcn_mfma_f32_16x16x32_bf16(Bt[n][k], At[m][k], acc[ai][bj][m][n], 0, 0, 0); __builtin_amdgcn_s_setprio(0); } while (0)
#define PG8_WAIT_V(n) asm volatile("s_waitcnt vmcnt(" #n ")" ::: "memory")
#define PG8_WAIT_L(n) asm volatile("s_waitcnt lgkmcnt(" #n ")" ::: "memory")
#define PG8_BAR __builtin_amdgcn_s_barrier()
#define PG8_SCHED __builtin_amdgcn_sched_barrier(0)
    Unit cur, nxt; int ui = 0;
    if (!S.next(0, cur)) return;
    typename Epi::Pre epre;
    f32x4 acc[2][2][4][2];
#pragma unroll
    for (int a = 0; a < 2; ++a)
#pragma unroll
        for (int b = 0; b < 2; ++b)
#pragma unroll
            for (int m = 0; m < 4; ++m)
#pragma unroll
                for (int n = 0; n < 2; ++n) acc[a][b][m][n] = (f32x4){0.f, 0.f, 0.f, 0.f};
    bf16x8 At[4][2], B0[2][2], B1[2][2];
    const char* cA = (const char*)g.A + (size_t)cur.pm * tstepA + g.aoff(cur.j); const char* cB = (const char*)g.Bt + (size_t)cur.pn * tstepB + (size_t)cur.j * g.b_j;
    {
        PG8_STAGE(PG8_SB(0, 0), cB, voffB); PG8_STAGE(PG8_SB(0, 1), cB + hstepB, voffB); PG8_STAGE(PG8_SA(0, 0), cA, voffA); PG8_STAGE(PG8_SA(0, 1), cA + hstepA, voffA);
        if (wr == 1) PG8_BAR;
        PG8_WAIT_V(2); PG8_BAR;
        PG8_STAGE(PG8_SB(1, 0), cB + kstep, voffB); PG8_STAGE(PG8_SA(1, 0), cA + kstep, voffA); PG8_STAGE(PG8_SB(1, 1), cB + hstepB + kstep, voffB);
        PG8_WAIT_V(6); PG8_BAR;
    }
    for (;;) {
        const bool has_next = S.next(ui + 1, nxt);
        const char* nA = has_next ? (const char*)g.A + (size_t)nxt.pm * tstepA + g.aoff(nxt.j) : cA; const char* nB = has_next ? (const char*)g.Bt + (size_t)nxt.pn * tstepB + (size_t)nxt.j * g.b_j : cB;
        for (int t = 0; t < nt; t += 2) {
            const bool last = (t == nt - 2);
            if (last) E.pre(epre, cur, wr, fr);
            const char* a1 = cA + (size_t)(t + 1) * kstep;
            const char* a2 = last ? nA : cA + (size_t)(t + 2) * kstep; const char* b2 = last ? nB : cB + (size_t)(t + 2) * kstep;
            const char* a3 = a2 + kstep; const char* b3 = b2 + kstep;
            PG8_LDB(B0, 0, 0); PG8_LDB(B1, 0, 1); PG8_SCHED; PG8_LDA(At, 0, 0); PG8_STAGE(PG8_SA(1, 1), a1 + hstepA, voffA);
            PG8_WAIT_V(8); PG8_WAIT_L(0); PG8_BAR; PG8_MMA(0, 0, At, B0); PG8_MMA(0, 1, At, B1); PG8_BAR; PG8_SCHED;
            PG8_LDA(At, 0, 1); PG8_STAGE(PG8_SB(0, 0), b2, voffB); PG8_STAGE(PG8_SB(0, 1), b2 + hstepB, voffB); PG8_STAGE(PG8_SA(0, 0), a2, voffA);
            PG8_WAIT_V(8); PG8_WAIT_L(0); PG8_BAR; PG8_MMA(1, 0, At, B0); PG8_MMA(1, 1, At, B1); PG8_BAR; PG8_SCHED;
            PG8_LDB(B0, 1, 0); PG8_LDB(B1, 1, 1); PG8_SCHED; PG8_LDA(At, 1, 0); PG8_STAGE(PG8_SA(0, 1), a2 + hstepA, voffA);
            PG8_WAIT_V(8); PG8_WAIT_L(0); PG8_BAR; PG8_MMA(0, 0, At, B0); PG8_MMA(0, 1, At, B1); PG8_BAR; PG8_SCHED;
            PG8_LDA(At, 1, 1); PG8_STAGE(PG8_SB(1, 0), b3, voffB); PG8_STAGE(PG8_SB(1, 1), b3 + hstepB, voffB); PG8_STAGE(PG8_SA(1, 0), a3, voffA);
            PG8_WAIT_V(8); PG8_WAIT_L(0); PG8_BAR; PG8_MMA(1, 0, At, B0); PG8_MMA(1, 1, At, B1); PG8_BAR; PG8_SCHED;
        }
        if (wr == 0) PG8_BAR;
        E(acc, cur, wr, wc, fr, fq, epre);
        if (!has_next) break;
        if (!(Epi::ACCUM && nxt.j != 0)) {
#pragma unroll
        for (int a = 0; a < 2; ++a)
#pragma unroll
            for (int b = 0; b < 2; ++b)
#pragma unroll
                for (int m = 0; m < 4; ++m)
#pragma unroll
                    for (int n = 0; n < 2; ++n) acc[a][b][m][n] = (f32x4){0.f, 0.f, 0.f, 0.f};
        }
        cur = nxt; cA = nA; cB = nB; ++ui;
        if (wr == 1) PG8_BAR;
    }
    PG8_WAIT_V(0);
    PG8_BAR;
#undef PG8_SA
#undef PG8_SB
#undef PG8_STAGE
#undef PG8_LDA
#undef PG8_LDB
#undef PG8_MMA
#undef PG8_WAIT_V
#undef PG8_WAIT_L
#undef PG8_BAR
#undef PG8_SCHED
}
}

using pg8::bf16_t; using pg8::f32x4; using pg8::u32x4; using pg8::u32x2; using pg8::cvt_pk_bf16;
#define LAS __attribute__((address_space(3)))

constexpr int DM = 1024, NB = 4, SEQ = 4096, M = NB * SEQ, DEPTH = 2;
constexpr int NIN = 7168, NPM = 4096, NG = 3072, FF = 4096;
constexpr int C_AU = 0, C_AV = 512, C_Q = 1024, C_K = 1536, C_V = 2048, C_CB = 2560, C_CC = 3072, C_CX = 3584;
constexpr float EPS = 1e-6f;
constexpr float LOG2E = 1.4426950408889634f;

constexpr size_t MiB = 1u << 20;
constexpr size_t WS_CTL = 0, CTL_BYTES = 1 * MiB, WS_BAR = 512 * 1024;
constexpr size_t WS_WIN = 1 * MiB, WS_WBR = 15 * MiB, WS_WOUT = 18 * MiB;
constexpr size_t WS_WF1 = 20 * MiB, WS_WF2 = 28 * MiB;
constexpr size_t WS_XB = 36 * MiB;
constexpr size_t WS_PM = 68 * MiB;
constexpr size_t WS_G8 = 196 * MiB;
constexpr size_t WS_HB = 100 * MiB;
constexpr size_t WS_END = 244 * MiB;

constexpr int NWAVES = 8;
constexpr int RING_BYTES = 131072, LDS_BYTES = 139264;

struct Args { const float* in[19]; float* out; unsigned char* ws; int ph_lo, ph_hi; };

#define GAS __attribute__((address_space(1)))
#define XB_TMO      128
#define XB_XCNT(j)  (256  + 64 * (j))
#define XB_XSUB(j)  (1280 + 64 * (j))
#define XB_XGEN(j)  (2304 + 64 * (j))
#define XB_TOP      3328
#define XB_TOPGEN   3392
#define XCD_BAR_WORDS 3456
#define XB_SPIN_CAP (1u << 18)

__device__ __forceinline__ unsigned xb_ld(unsigned* p)              { return __hip_atomic_load(p, __ATOMIC_RELAXED, __HIP_MEMORY_SCOPE_AGENT); }
__device__ __forceinline__ unsigned xb_add(unsigned* p, unsigned v) { return __hip_atomic_fetch_add(p, v, __ATOMIC_RELAXED, __HIP_MEMORY_SCOPE_AGENT); }
__device__ __forceinline__ unsigned xb_xcc_id() { return (unsigned)__builtin_amdgcn_s_getreg((3 << 11) | 20) & 0xFu; }
#define XB_SPIN(cond, bar) do { unsigned _sp = 0; while (cond) { __builtin_amdgcn_s_sleep(1); \
    if ((++_sp & 255u) == 0u) { if (xb_ld(&(bar)[XB_TMO])) break; if (_sp > XB_SPIN_CAP) { atomicAdd(&(bar)[XB_TMO], 1u); break; } } } } while (0)

struct XcdBarrier {
    unsigned* bar; unsigned x;
    volatile LAS unsigned* st;
};

__device__ __forceinline__ XcdBarrier xcd_barrier_post(unsigned* bar, volatile LAS unsigned* st) {
    XcdBarrier b; b.bar = bar; b.x = xb_xcc_id(); b.st = st;
    if (threadIdx.x == 0) (void)xb_add(&bar[XB_XCNT(b.x)], 1u);
    return b;
}
__device__ __forceinline__ void xcd_barrier_complete(unsigned* bar, unsigned x, unsigned& nloc, unsigned& nx) {
    const unsigned G = gridDim.x * gridDim.y * gridDim.z;
    unsigned sum, cnt, mine, sp = 0u;
    for (;;) {
        sum = 0u; cnt = 0u; mine = 0u;
#pragma unroll
        for (unsigned j = 0; j < 16; ++j) { const unsigned c = xb_ld(&bar[XB_XCNT(j)]); sum += c; cnt += (c > 0u) ? 1u : 0u; mine = (j == x) ? c : mine; }
        if (sum == G) break;
        __builtin_amdgcn_s_sleep(1);
        if ((++sp & 255u) == 0u) { if (xb_ld(&bar[XB_TMO])) break; if (sp > XB_SPIN_CAP) { atomicAdd(&bar[XB_TMO], 1u); break; } }
    }
    nloc = mine > 0u ? mine : 1u; nx = cnt > 0u ? cnt : 1u;
}

__device__ __forceinline__ void xcd_barrier(const XcdBarrier& b) {
    asm volatile("s_waitcnt vmcnt(0)" ::: "memory");
    __syncthreads();
    if (threadIdx.x == 0) {
        unsigned* bar = b.bar;
        __builtin_amdgcn_s_waitcnt(0);
        unsigned nloc = b.st[0], nx = b.st[1];
        if (nloc == 0u) { xcd_barrier_complete(bar, b.x, nloc, nx); b.st[0] = nloc; b.st[1] = nx; }
        const unsigned old = xb_add(&bar[XB_XSUB(b.x)], 1u);
        const unsigned gen = old / nloc;
        if (old + 1u == (gen + 1u) * nloc) {
            __builtin_amdgcn_fence(__ATOMIC_RELEASE, "agent");
            asm volatile("s_waitcnt vmcnt(0)" ::: "memory");
            const unsigned og = xb_add(&bar[XB_TOP], 1u);
            const unsigned tg = og / nx;
            if (og + 1u == (tg + 1u) * nx) xb_add(&bar[XB_TOPGEN], 1u);
            else XB_SPIN(xb_ld(&bar[XB_TOPGEN]) == tg, bar);
            __builtin_amdgcn_fence(__ATOMIC_ACQUIRE, "agent");
            asm volatile("s_waitcnt vmcnt(0)" ::: "memory");
        } else {
            XB_SPIN(xb_ld(&bar[XB_TOPGEN]) == gen, bar);
            __builtin_amdgcn_fence(__ATOMIC_ACQUIRE, "agent");
            asm volatile("s_waitcnt vmcnt(0)" ::: "memory");
        }
    }
    __syncthreads();
}

__device__ __forceinline__ float bf_lo(unsigned w) { return __uint_as_float(w << 16); }
__device__ __forceinline__ float bf_hi(unsigned w) { return __uint_as_float(w & 0xffff0000u); }
__device__ __forceinline__ float wave_sum(float v) {
#pragma unroll
    for (int o = 1; o < 64; o <<= 1) v += __shfl_xor(v, o);
    return v;
}
__device__ __forceinline__ float gelu_tanh(float x) {
    const float u = 0.7978845608028654f * (x + 0.044715f * x * x * x);
    return x * __builtin_amdgcn_rcpf(1.f + __builtin_amdgcn_exp2f(-2.f * LOG2E * u));
}
__device__ __forceinline__ float sigmoidf(float x) { return __builtin_amdgcn_rcpf(1.f + __builtin_amdgcn_exp2f(-LOG2E * x)); }
__device__ __forceinline__ float g8f(unsigned b) { return ((float)b + 0.5f) * (1.f / 256.f); }

__device__ __forceinline__ int inproj_phys(int n) {
    if (n < C_Q || n >= C_V) return n;
    const int t = n & ~255, g = (n & 255) >> 6, d = n & 63;
    return t + ((d >> 5) << 7) + (g << 5) + (d & 31);
}

struct EpiInProj {
    static constexpr bool PERM = true, ACCUM = false;
    bf16_t* PM; unsigned char* G8; const float* rowss; const float* gate_b; const float* qnw; const float* knw; float* avss;
    struct Pre { float v[2][4]; };
    __device__ __forceinline__ void pre(Pre& p, const pg8::Unit& u, int wr, int fr) const {
        const int row0 = u.pm * 256 + wr * 64 + fr;
#pragma unroll
        for (int ai = 0; ai < 2; ++ai)
#pragma unroll
            for (int m = 0; m < 4; ++m) p.v[ai][m] = rowss[row0 + ai * 128 + m * 16];
    }
    __device__ __forceinline__ void operator()(f32x4 (&acc)[2][2][4][2], const pg8::Unit& u, int wr, int wc, int fr, int fq, const Pre& p) const {
        const int row0 = u.pm * 256 + wr * 64 + fr;
        float rs[2][4];
#pragma unroll
        for (int ai = 0; ai < 2; ++ai)
#pragma unroll
            for (int m = 0; m < 4; ++m) rs[ai][m] = rsqrtf(p.v[ai][m] * (1.f / DM) + EPS);
        const int pn = u.pn;
        if (pn < 4) {
            const int col0 = pn * 256 + wc * 32 + 8 * fq;
#pragma unroll
            for (int ai = 0; ai < 2; ++ai)
#pragma unroll
                for (int m = 0; m < 4; ++m) { bf16_t* rowp = PM + (size_t)(row0 + ai * 128 + m * 16) * NPM + col0; const float r = rs[ai][m]; float ss = 0.f;
#pragma unroll
                    for (int bj = 0; bj < 2; ++bj) { const f32x4 v0 = acc[ai][bj][m][0] * r, v1 = acc[ai][bj][m][1] * r; u32x4 w; float gl[8];
#pragma unroll
                        for (int e = 0; e < 4; ++e) { gl[e] = gelu_tanh(v0[e]); gl[4 + e] = gelu_tanh(v1[e]); }
#pragma unroll
                        for (int e = 0; e < 8; ++e) ss += gl[e] * gl[e];
                        w.x = cvt_pk_bf16(gl[0], gl[1]); w.y = cvt_pk_bf16(gl[2], gl[3]); w.z = cvt_pk_bf16(gl[4], gl[5]); w.w = cvt_pk_bf16(gl[6], gl[7]);
                        *(u32x4*)(rowp + bj * 128) = w; }
                    if (pn >= 2) { ss += __shfl_xor(ss, 16); ss += __shfl_xor(ss, 32); if (fq == 0) atomicAdd(avss + row0 + ai * 128 + m * 16, ss); } }
        } else if (pn < 8) {
            const bool isq = pn < 6;
            const float* nw = (isq ? qnw : knw) + (wc & 1) * 64 + 8 * fq;
            const float extra = isq ? 0.125f * LOG2E : 1.f;
            float wv[2][8];
#pragma unroll
            for (int bj = 0; bj < 2; ++bj)
#pragma unroll
                for (int i = 0; i < 8; ++i) wv[bj][i] = nw[32 * bj + i] * extra;
            const int col0 = pn * 256 + 64 * wc + 8 * fq;
#pragma unroll
            for (int ai = 0; ai < 2; ++ai)
#pragma unroll
                for (int m = 0; m < 4; ++m) { bf16_t* rowp = PM + (size_t)(row0 + ai * 128 + m * 16) * NPM + col0; const float r = rs[ai][m];
                    f32x4 v[2][2]; float ss = 0.f;
#pragma unroll
                    for (int bj = 0; bj < 2; ++bj)
#pragma unroll
                        for (int n = 0; n < 2; ++n) { v[bj][n] = acc[ai][bj][m][n] * r; const f32x4 x = v[bj][n]; ss += (x[0] * x[0] + x[1] * x[1]) + (x[2] * x[2] + x[3] * x[3]); }
                    ss += __shfl_xor(ss, 16); ss += __shfl_xor(ss, 32);
                    const float rn = rsqrtf(ss * (1.f / 64.f) + EPS);
#pragma unroll
                    for (int bj = 0; bj < 2; ++bj) { const f32x4 v0 = v[bj][0] * rn, v1 = v[bj][1] * rn; u32x4 w;
                        w.x = cvt_pk_bf16(v0[0] * wv[bj][0], v0[1] * wv[bj][1]); w.y = cvt_pk_bf16(v0[2] * wv[bj][2], v0[3] * wv[bj][3]);
                        w.z = cvt_pk_bf16(v1[0] * wv[bj][4], v1[1] * wv[bj][5]); w.w = cvt_pk_bf16(v1[2] * wv[bj][6], v1[3] * wv[bj][7]);
                        *(u32x4*)(rowp + bj * 32) = w; } }
        } else if (pn < 16) {
            const int col0 = pn * 256 + wc * 32 + 8 * fq;
#pragma unroll
            for (int ai = 0; ai < 2; ++ai)
#pragma unroll
                for (int m = 0; m < 4; ++m) { bf16_t* rowp = PM + (size_t)(row0 + ai * 128 + m * 16) * NPM + col0; const float r = rs[ai][m];
#pragma unroll
                    for (int bj = 0; bj < 2; ++bj) { const f32x4 v0 = acc[ai][bj][m][0] * r, v1 = acc[ai][bj][m][1] * r; u32x4 w;
                        w.x = cvt_pk_bf16(v0[0], v0[1]); w.y = cvt_pk_bf16(v0[2], v0[3]); w.z = cvt_pk_bf16(v1[0], v1[1]); w.w = cvt_pk_bf16(v1[2], v1[3]);
                        *(u32x4*)(rowp + bj * 128) = w; } }
        } else {
            const int col0 = (pn - 16) * 256 + wc * 32 + 8 * fq;
            f32x4 bv[2][2];
#pragma unroll
            for (int bj = 0; bj < 2; ++bj)
#pragma unroll
                for (int n = 0; n < 2; ++n) bv[bj][n] = *(const f32x4*)(gate_b + col0 + bj * 128 + 4 * n);
#pragma unroll
            for (int ai = 0; ai < 2; ++ai)
#pragma unroll
                for (int m = 0; m < 4; ++m) { unsigned char* rowp = G8 + (size_t)(row0 + ai * 128 + m * 16) * NG + col0; const float r = rs[ai][m];
#pragma unroll
                    for (int bj = 0; bj < 2; ++bj) { unsigned q[8];
#pragma unroll
                        for (int n = 0; n < 2; ++n)
#pragma unroll
                            for (int e = 0; e < 4; ++e) { const float gx = sigmoidf(acc[ai][bj][m][n][e] * r + bv[bj][n][e]); q[4 * n + e] = (unsigned)__builtin_fminf(gx * 256.f, 255.f); }
                        u32x2 w; w.x = q[0] | (q[1] << 8) | (q[2] << 16) | (q[3] << 24); w.y = q[4] | (q[5] << 8) | (q[6] << 16) | (q[7] << 24);
                        *(u32x2*)(rowp + bj * 128) = w; } }
        }
    }
};

struct EpiBranch {
    static constexpr bool PERM = true, ACCUM = true;
    bf16_t* O; const unsigned char* G8;
    struct Pre { };
    __device__ __forceinline__ void pre(Pre&, const pg8::Unit&, int, int) const {}
    __device__ __forceinline__ void operator()(f32x4 (&acc)[2][2][4][2], const pg8::Unit& u, int wr, int wc, int fr, int fq, const Pre&) const {
        const int row0 = u.pm * 256 + wr * 64 + fr, col0 = u.pn * 256 + wc * 32 + 8 * fq, j = u.j;
#pragma unroll
        for (int ai = 0; ai < 2; ++ai) {
            u32x2 ga[4][2], gb[4][2];
#pragma unroll
            for (int m = 0; m < 4; ++m)
#pragma unroll
                for (int bj = 0; bj < 2; ++bj) { const size_t row = (size_t)(row0 + ai * 128 + m * 16);
                    ga[m][bj] = *(const u32x2*)(G8 + row * NG + j * 1024 + col0 + bj * 128);
                    gb[m][bj] = (j < 2) ? *(const u32x2*)(G8 + row * NG + (j + 1) * 1024 + col0 + bj * 128) : (u32x2){0u, 0u}; }
#pragma unroll
            for (int m = 0; m < 4; ++m) { const size_t row = (size_t)(row0 + ai * 128 + m * 16);
#pragma unroll
                for (int bj = 0; bj < 2; ++bj) {
                    float f[8];
#pragma unroll
                    for (int e = 0; e < 4; ++e) { f[e] = g8f((ga[m][bj].x >> (8 * e)) & 0xffu); f[4 + e] = g8f((ga[m][bj].y >> (8 * e)) & 0xffu); }
                    if (j < 2) {
#pragma unroll
                        for (int e = 0; e < 4; ++e) { f[e] *= __builtin_amdgcn_rcpf(g8f((gb[m][bj].x >> (8 * e)) & 0xffu)); f[4 + e] *= __builtin_amdgcn_rcpf(g8f((gb[m][bj].y >> (8 * e)) & 0xffu)); }
                    }
#pragma unroll
                    for (int e = 0; e < 4; ++e) { acc[ai][bj][m][0][e] *= f[e]; acc[ai][bj][m][1][e] *= f[4 + e]; }
                    if (j == 2) { const f32x4 v0 = acc[ai][bj][m][0], v1 = acc[ai][bj][m][1]; u32x4 w;
                        w.x = cvt_pk_bf16(v0[0], v0[1]); w.y = cvt_pk_bf16(v0[2], v0[3]); w.z = cvt_pk_bf16(v1[0], v1[1]); w.w = cvt_pk_bf16(v1[2], v1[3]);
                        *(u32x4*)(O + row * DM + col0 + bj * 128) = w; }
                } }
        }
    }
};

struct EpiResid {
    static constexpr bool PERM = false, ACCUM = false;
    const float* xin_f; const bf16_t* xin_b; float* xout_f; bf16_t* xb; float* rowss;
    struct Pre { };
    __device__ __forceinline__ void pre(Pre&, const pg8::Unit&, int, int) const {}
    __device__ __forceinline__ void operator()(f32x4 (&acc)[2][2][4][2], const pg8::Unit& u, int wr, int wc, int fr, int fq, const Pre&) const {
        const int row0 = u.pm * 256 + wr * 64 + fr, col0 = u.pn * 256 + wc * 32 + 4 * fq;
#pragma unroll
        for (int ai = 0; ai < 2; ++ai) {
            f32x4 xr[4][2][2];
            if (xin_f) {
#pragma unroll
                for (int m = 0; m < 4; ++m)
#pragma unroll
                    for (int bj = 0; bj < 2; ++bj)
#pragma unroll
                        for (int n = 0; n < 2; ++n) xr[m][bj][n] = *(const f32x4*)(xin_f + (size_t)(row0 + ai * 128 + m * 16) * DM + col0 + bj * 128 + n * 16);
            } else {
                u32x2 xh[4][2][2];
#pragma unroll
                for (int m = 0; m < 4; ++m)
#pragma unroll
                    for (int bj = 0; bj < 2; ++bj)
#pragma unroll
                        for (int n = 0; n < 2; ++n) xh[m][bj][n] = *(const u32x2*)(xin_b + (size_t)(row0 + ai * 128 + m * 16) * DM + col0 + bj * 128 + n * 16);
#pragma unroll
                for (int m = 0; m < 4; ++m)
#pragma unroll
                    for (int bj = 0; bj < 2; ++bj)
#pragma unroll
                        for (int n = 0; n < 2; ++n) { const u32x2 h = xh[m][bj][n]; xr[m][bj][n] = (f32x4){bf_lo(h.x), bf_hi(h.x), bf_lo(h.y), bf_hi(h.y)}; }
            }
#pragma unroll
            for (int m = 0; m < 4; ++m) { const int row = row0 + ai * 128 + m * 16; const size_t off = (size_t)row * DM + col0; float ss = 0.f;
#pragma unroll
                for (int bj = 0; bj < 2; ++bj)
#pragma unroll
                    for (int n = 0; n < 2; ++n) { const size_t o = off + bj * 128 + n * 16; const f32x4 x = xr[m][bj][n] + acc[ai][bj][m][n];
                        if (xout_f) *(f32x4*)(xout_f + o) = x;
                        if (xb) { u32x2 w; w.x = cvt_pk_bf16(x[0], x[1]); w.y = cvt_pk_bf16(x[2], x[3]); *(u32x2*)(xb + o) = w; ss += (x[0] * x[0] + x[1] * x[1]) + (x[2] * x[2] + x[3] * x[3]); } }
                if (xb) { ss += __shfl_xor(ss, 16); ss += __shfl_xor(ss, 32); if (fq == 0) atomicAdd(rowss + row, ss); } }
        }
    }
};

struct EpiFF1 {
    static constexpr bool PERM = true, ACCUM = false;
    bf16_t* O; const float* rowss; int ldc;
    struct Pre { float v[2][4]; };
    __device__ __forceinline__ void pre(Pre& p, const pg8::Unit& u, int wr, int fr) const {
        const int row0 = u.pm * 256 + wr * 64 + fr;
#pragma unroll
        for (int ai = 0; ai < 2; ++ai)
#pragma unroll
            for (int m = 0; m < 4; ++m) p.v[ai][m] = rowss[row0 + ai * 128 + m * 16];
    }
    __device__ __forceinline__ void operator()(f32x4 (&acc)[2][2][4][2], const pg8::Unit& u, int wr, int wc, int fr, int fq, const Pre& p) const {
        const int row0 = u.pm * 256 + wr * 64 + fr, col0 = u.pn * 256 + wc * 32 + 8 * fq;
        float rsv[2][4];
#pragma unroll
        for (int ai = 0; ai < 2; ++ai)
#pragma unroll
            for (int m = 0; m < 4; ++m) rsv[ai][m] = rsqrtf(p.v[ai][m] * (1.f / DM) + EPS);
#pragma unroll
        for (int ai = 0; ai < 2; ++ai)
#pragma unroll
            for (int m = 0; m < 4; ++m) { const int row = row0 + ai * 128 + m * 16; const float r = rsv[ai][m]; bf16_t* rowp = O + (size_t)row * ldc + col0;
#pragma unroll
                for (int bj = 0; bj < 2; ++bj) { f32x4 v0 = acc[ai][bj][m][0] * r, v1 = acc[ai][bj][m][1] * r;
#pragma unroll
                    for (int e = 0; e < 4; ++e) { const float a = __builtin_fmaxf(v0[e], 0.f), b = __builtin_fmaxf(v1[e], 0.f); v0[e] = a * a; v1[e] = b * b; }
                    u32x4 w; w.x = cvt_pk_bf16(v0[0], v0[1]); w.y = cvt_pk_bf16(v0[2], v0[3]); w.z = cvt_pk_bf16(v1[0], v1[1]); w.w = cvt_pk_bf16(v1[2], v1[3]);
                    *(u32x4*)(rowp + bj * 128) = w; } }
    }
};

template <bool INPERM>
__device__ __forceinline__ void transpose_item(const float* W, const float* kscale, int K, int N, bf16_t* WT, LAS float* scr, int item, int lane) {
    const int nblk = N / 32, kb = item / nblk, nb = item % nblk, k0 = 64 * kb, n0 = 32 * nb;
    float v[32];
#pragma unroll
    for (int i = 0; i < 32; ++i) { const int kk = 2 * i + (lane >> 5); v[i] = __builtin_nontemporal_load(&W[(size_t)(k0 + kk) * N + n0 + (lane & 31)]); }
    if (kscale) {
#pragma unroll
        for (int i = 0; i < 32; ++i) v[i] *= kscale[k0 + 2 * i + (lane >> 5)]; }
#pragma unroll
    for (int i = 0; i < 32; ++i) { const int kk = 2 * i + (lane >> 5); scr[kk * 33 + (lane & 31)] = v[i]; }
    asm volatile("s_waitcnt lgkmcnt(0)" ::: "memory");
    const int c = lane & 7;
    const int r0 = INPERM ? inproj_phys(n0) : n0;
#pragma unroll
    for (int j = 0; j < 4; ++j) { const int n = (lane >> 3) + 8 * j; const LAS float* s = scr + (8 * c) * 33 + n;
        u32x4 o; o.x = cvt_pk_bf16(s[0 * 33], s[1 * 33]); o.y = cvt_pk_bf16(s[2 * 33], s[3 * 33]); o.z = cvt_pk_bf16(s[4 * 33], s[5 * 33]); o.w = cvt_pk_bf16(s[6 * 33], s[7 * 33]);
        *(u32x4*)(WT + (size_t)(r0 + n) * K + k0 + 8 * c) = o; }
    asm volatile("s_waitcnt lgkmcnt(0)" ::: "memory");
}
constexpr int IT_WIN = 16 * 224, IT_BR = 8 * 32, IT_OUT = 16 * 32, IT_F1 = 16 * 128, IT_F2 = 64 * 32;
__device__ __forceinline__ void convert_region_a(const Args& a, int l, LAS unsigned char* lds, int gw, int ngw, int wave, int lane) {
    LAS float* scr = (LAS float*)(lds + wave * 16384);
    unsigned char* ws = a.ws;
    constexpr int NIT = IT_WIN + 3 * IT_BR + IT_OUT;
    for (int it = gw; it < NIT; it += ngw) {
        int r = it;
        if (r < IT_WIN) { transpose_item<true>(a.in[2] + (size_t)l * DM * NIN, a.in[1] + l * DM, DM, NIN, (bf16_t*)(ws + WS_WIN), scr, r, lane); continue; } r -= IT_WIN;
        if (r < 3 * IT_BR) { const int j = r / IT_BR; transpose_item<false>(a.in[12 + j] + (size_t)l * 512 * DM, nullptr, 512, DM, (bf16_t*)(ws + WS_WBR + j * MiB), scr, r % IT_BR, lane); continue; } r -= 3 * IT_BR;
        transpose_item<false>(a.in[15] + (size_t)l * DM * DM, nullptr, DM, DM, (bf16_t*)(ws + WS_WOUT), scr, r, lane);
    }
}
__device__ __forceinline__ void convert_region_b(const Args& a, int l, LAS unsigned char* lds, int gw, int ngw, int wave, int lane) {
    LAS float* scr = (LAS float*)(lds + wave * 16384);
    unsigned char* ws = a.ws;
    constexpr int NIT = IT_F1 + IT_F2;
    for (int it = gw; it < NIT; it += ngw) {
        int r = it;
        if (r < IT_F1) { transpose_item<false>(a.in[17] + (size_t)l * DM * FF, a.in[16] + l * DM, DM, FF, (bf16_t*)(ws + WS_WF1), scr, r, lane); continue; } r -= IT_F1;
        transpose_item<false>(a.in[18] + (size_t)l * FF * DM, nullptr, FF, DM, (bf16_t*)(ws + WS_WF2), scr, r, lane);
    }
}

namespace att {
typedef short bf16x8 __attribute__((ext_vector_type(8)));
typedef short s16x4 __attribute__((ext_vector_type(4)));
typedef short v4i16_t __attribute__((ext_vector_type(4)));
typedef float f32x16 __attribute__((ext_vector_type(16)));
typedef float f32x8 __attribute__((ext_vector_type(8)));
typedef float f32x2_t __attribute__((ext_vector_type(2))); typedef __bf16 bf16x2_t __attribute__((ext_vector_type(2)));
__device__ __forceinline__ unsigned cvtpk_s(float lo, float hi) { f32x2_t v = {lo, hi}; bf16x2_t b = __builtin_convertvector(v, bf16x2_t); return __builtin_bit_cast(unsigned, b); }
__device__ __forceinline__ s16x4 vtr(const LAS unsigned char* p) { return __builtin_bit_cast(s16x4, __builtin_amdgcn_ds_read_tr16_b64_v4i16((LAS v4i16_t*)p)); }
constexpr int KSTR = 144, VSTR = 320, KMAP = 64 * KSTR, V_OFF = 2 * KMAP, BUF = V_OFF + 64 * VSTR;
__device__ __forceinline__ bf16x8 pack8(const f32x16& p, int o) {
    u32x4 w; w.x = cvtpk_s(p[o], p[o + 1]); w.y = cvtpk_s(p[o + 2], p[o + 3]); w.z = cvtpk_s(p[o + 4], p[o + 5]); w.w = cvtpk_s(p[o + 6], p[o + 7]); return __builtin_bit_cast(bf16x8, w); }

__device__ __forceinline__ void attn_unit(bf16_t* PM, bf16_t* obase, int opitch, int b, int h, int qb, float lam, float post, const float* subw, const float* knw, LAS unsigned char* lds, int tid_in) {
    int tid = tid_in; asm volatile("" : "+v"(tid));
    const int lane = tid & 63, wid = __builtin_amdgcn_readfirstlane(tid >> 6), r32 = lane & 31, hi = lane >> 5, m = wid >> 2, qs = wid & 3;
    const int qpos = 128 * qb + 32 * qs + r32;
    bf16_t* base = PM + (size_t)b * SEQ * NPM;
    bf16_t* qrow = base + (size_t)qpos * NPM + C_Q + h * 128;
    bf16_t* orow = obase + (size_t)(b * SEQ + qpos) * opitch + h * 128;
    bf16x8 qr[4];
#pragma unroll
    for (int d0 = 0; d0 < 4; ++d0) qr[d0] = *(const bf16x8*)(qrow + m * 64 + d0 * 16 + hi * 8);
    bool need_check;
    { float qn2 = 0.f;
#pragma unroll
      for (int d0 = 0; d0 < 4; ++d0) { const u32x4 w = __builtin_bit_cast(u32x4, qr[d0]);
          const float a0 = bf_lo(w.x), a1 = bf_hi(w.x), a2 = bf_lo(w.y), a3 = bf_hi(w.y), a4 = bf_lo(w.z), a5 = bf_hi(w.z), a6 = bf_lo(w.w), a7 = bf_hi(w.w);
          qn2 += (a0 * a0 + a1 * a1) + (a2 * a2 + a3 * a3) + (a4 * a4 + a5 * a5) + (a6 * a6 + a7 * a7); }
      qn2 += __shfl_xor(qn2, 32);
      float wk = __builtin_fmaxf(__builtin_fabsf(knw[lane]), __builtin_fabsf(knw[64 + lane]));
#pragma unroll
      for (int o = 1; o < 64; o <<= 1) wk = __builtin_fmaxf(wk, __shfl_xor(wk, o));
      need_check = __any(sqrtf(qn2) * 8.f * wk * 1.02f > 40.f); }
    const int NT = 2 * (qb + 1), my_nt = (qs < 2) ? NT - 1 : NT;
    const float sl2 = __builtin_amdgcn_exp2f(-2.f * (float)(h + 1)) * LOG2E;
    const bf16_t* gk = base + (size_t)(tid >> 3) * NPM + C_K + h * 128 + (tid & 7) * 8;
    const bf16_t* gv = base + (size_t)(tid >> 4) * NPM + C_V + h * 128 + (tid & 15) * 8;
    const int lk = (tid >> 3) * KSTR + (tid & 7) * 16, lv = V_OFF + (tid >> 4) * VSTR + (tid & 15) * 16;
    u32x4 st0, st1, st2, st3;
#define ATT_LOAD(t) do { const size_t ro = (size_t)(t) * 64 * NPM; st0 = *(const u32x4*)(gk + ro); st1 = *(const u32x4*)(gk + ro + 64); st2 = *(const u32x4*)(gv + ro); st3 = *(const u32x4*)(gv + ro + (size_t)32 * NPM); } while (0)
#define ATT_STORE(bufp) do { *(LAS u32x4*)((bufp) + lk) = st0; *(LAS u32x4*)((bufp) + KMAP + lk) = st1; *(LAS u32x4*)((bufp) + lv) = st2; *(LAS u32x4*)((bufp) + lv + 32 * VSTR) = st3; } while (0)
    __syncthreads();
    ATT_LOAD(0); ATT_STORE(lds);
    __syncthreads();
    f32x16 OT[4];
#pragma unroll
    for (int eb = 0; eb < 4; ++eb)
#pragma unroll
        for (int r = 0; r < 16; ++r) OT[eb][r] = 0.f;
    float mref = 0.f, lsum = 0.f;
    const float s64 = 64.f * sl2;
    const float s32 = 32.f * sl2;
    f32x16 ci0;
#pragma unroll
    for (int r = 0; r < 16; ++r) ci0[r] = sl2 * (float)(4 * hi + (r & 3) + 8 * (r >> 2) - qpos);
    for (int t = 0; t < NT; ++t) {
        LAS unsigned char* buf = lds + (t & 1) * BUF;
        if (t + 1 < NT) ATT_LOAD(t + 1);
        if (t < my_nt) {
            const LAS unsigned char* kp = buf + m * KMAP + r32 * KSTR + hi * 16;
            f32x16 p0 = ci0, p1 = ci0 + s32;
            if (t == my_nt - 1) {
                int hid = hi; asm volatile("" : "+v"(hid));
                const float qf = (float)qpos, k0 = (float)(64 * t + 4 * hid), cadd = -mref;
#pragma unroll
                for (int r = 0; r < 16; ++r) { const float kf = k0 + (float)((r & 3) + 8 * (r >> 2));
                    p0[r] = __builtin_fmaf(-sl2, __builtin_fabsf(qf - kf), cadd); p1[r] = __builtin_fmaf(-sl2, __builtin_fabsf(qf - (kf + 32.f)), cadd); }
            }
            bf16x8 ka[4], kb2[4];
#pragma unroll
            for (int d0 = 0; d0 < 4; ++d0) { ka[d0] = *(const LAS bf16x8*)(kp + d0 * 32); kb2[d0] = *(const LAS bf16x8*)(kp + 32 * KSTR + d0 * 32); }
#pragma unroll
            for (int d0 = 0; d0 < 4; ++d0) {
                p0 = __builtin_amdgcn_mfma_f32_32x32x16_bf16(ka[d0], qr[d0], p0, 0, 0, 0);
                p1 = __builtin_amdgcn_mfma_f32_32x32x16_bf16(kb2[d0], qr[d0], p1, 0, 0, 0);
            }
            const LAS unsigned char* vp = buf + V_OFF + (4 * hi + ((lane & 15) >> 2)) * VSTR + ((lane >> 4) & 1) * 32 + (lane & 3) * 8;
            s16x4 vlo[2][4], vhi[2][4];
#pragma unroll
            for (int eb = 0; eb < 4; ++eb) { vlo[0][eb] = vtr(vp + eb * 64); vhi[0][eb] = vtr(vp + 8 * VSTR + eb * 64); }
            float mt = 0.f;
            if (need_check) { mt = __builtin_fmaxf(p0[0], p1[0]);
#pragma unroll
                for (int r = 1; r < 16; ++r) mt = __builtin_fmaxf(__builtin_fmaxf(mt, p0[r]), p1[r]);
                mt = __builtin_fmaxf(mt, __shfl_xor(mt, 32)); }
            if (need_check && __any(mt > 40.f)) {
                const float dl = __builtin_fmaxf(mt, 0.f), f = __builtin_amdgcn_exp2f(-dl);
                mref += dl; lsum *= f; p0 -= dl; p1 -= dl; ci0 -= dl;
#pragma unroll
                for (int eb = 0; eb < 4; ++eb) OT[eb] *= f;
            }
#if PROBE == 13
            { float dz = 0.f;
#pragma unroll
              for (int r = 0; r < 16; ++r) { dz += __builtin_amdgcn_exp2f(p0[r] + 1.f) + __builtin_amdgcn_exp2f(p1[r] + 1.f); }
              asm volatile("" :: "v"(dz)); }
#endif
#if PROBE == 14
            { f32x16 dacc = p0;
#pragma unroll
              for (int d0 = 0; d0 < 4; ++d0) { dacc = __builtin_amdgcn_mfma_f32_32x32x16_bf16(ka[d0], qr[d0], dacc, 0, 0, 0); dacc = __builtin_amdgcn_mfma_f32_32x32x16_bf16(kb2[d0], qr[d0], dacc, 0, 0, 0); }
              asm volatile("" :: "v"(dacc)); }
#endif
#pragma unroll
            for (int r = 0; r < 16; ++r) { p0[r] = __builtin_amdgcn_exp2f(p0[r]); p1[r] = __builtin_amdgcn_exp2f(p1[r]); }
            { const f32x16 s16 = p0 + p1; const f32x8 s8 = s16.lo + s16.hi; const f32x4 s4v = s8.lo + s8.hi; const f32x2_t s2 = s4v.lo + s4v.hi; lsum += s2.x + s2.y; }
            ci0 += s64;
            bf16x8 pf[4]; pf[0] = pack8(p0, 0); pf[1] = pack8(p0, 8); pf[2] = pack8(p1, 0); pf[3] = pack8(p1, 8);
#pragma unroll
            for (int s4 = 0; s4 < 4; ++s4) {
                if (s4 < 3) {
#pragma unroll
                    for (int eb = 0; eb < 4; ++eb) { vlo[(s4 + 1) & 1][eb] = vtr(vp + (16 * (s4 + 1)) * VSTR + eb * 64); vhi[(s4 + 1) & 1][eb] = vtr(vp + (16 * (s4 + 1) + 8) * VSTR + eb * 64); }
                }
#pragma unroll
                for (int eb = 0; eb < 4; ++eb) {
                    const s16x4 a = vlo[s4 & 1][eb], c = vhi[s4 & 1][eb];
                    const bf16x8 vf = (bf16x8){a[0], a[1], a[2], a[3], c[0], c[1], c[2], c[3]};
                    OT[eb] = __builtin_amdgcn_mfma_f32_32x32x16_bf16(vf, pf[s4], OT[eb], 0, 0, 0);
                }
            }
        }
        if (t + 1 < NT) ATT_STORE(lds + ((t + 1) & 1) * BUF);
        __syncthreads();
    }
#undef ATT_LOAD
#undef ATT_STORE
    lsum += __shfl_xor(lsum, 32);
    const float inv = 1.f / lsum;
#pragma unroll
    for (int eb = 0; eb < 4; ++eb)
#pragma unroll
        for (int r = 0; r < 16; ++r) OT[eb][r] *= inv;
    int hif = hi, lanef = lane; asm volatile("" : "+v"(hif), "+v"(lanef));
    LAS float* X = (LAS float*)(lds + qs * 16384) + lanef;
    if (m == 1) {
#pragma unroll
        for (int eb = 0; eb < 4; ++eb)
#pragma unroll
            for (int r = 0; r < 16; ++r) X[(eb * 16 + r) * 64] = OT[eb][r];
    }
    __syncthreads();
    if (m == 0) {
        float ss = 0.f;
#pragma unroll
        for (int eb = 0; eb < 4; ++eb) {
            __builtin_amdgcn_sched_barrier(0);
#pragma unroll
            for (int r = 0; r < 16; ++r) { const float o = OT[eb][r] - lam * X[(eb * 16 + r) * 64]; OT[eb][r] = o; ss += o * o; } }
        __builtin_amdgcn_sched_barrier(0);
        ss += __shfl_xor(ss, 32);
        const float rn = rsqrtf(ss * (1.f / 128.f) + EPS) * post;
        f32x4 w4a[4][4];
#pragma unroll
        for (int eb = 0; eb < 4; ++eb)
#pragma unroll
            for (int rg = 0; rg < 4; ++rg) w4a[eb][rg] = *(const f32x4*)(subw + 32 * eb + 8 * rg + 4 * hif);
#pragma unroll
        for (int eb = 0; eb < 4; ++eb)
#pragma unroll
            for (int rg = 0; rg < 4; ++rg) { const int e = 32 * eb + 8 * rg + 4 * hif; const f32x4 w4 = w4a[eb][rg];
                u32x2 w; w.x = cvtpk_s(OT[eb][4 * rg] * rn * w4[0], OT[eb][4 * rg + 1] * rn * w4[1]); w.y = cvtpk_s(OT[eb][4 * rg + 2] * rn * w4[2], OT[eb][4 * rg + 3] * rn * w4[3]);
                *(u32x2*)(orow + e) = w; }
    }
}
}

__device__ __forceinline__ void gmlp_unit(bf16_t* PM, bf16_t* obase, int opitch, const float* avss, const float* vnw, const float* ws_g, const float* bs_g, int rowbase, int g, LAS unsigned char* lds, int tid) {
    constexpr int VSTR = 320, WSTR = 272, W_OFF = 128 * VSTR;
    const int lane = tid & 63, wid = __builtin_amdgcn_readfirstlane(tid >> 6), r32 = lane & 31, hi = lane >> 5;
    __syncthreads();
    {
        const int row = tid >> 2, part = tid & 3;
        const bf16_t* rp = PM + (size_t)(rowbase + row) * NPM + C_AV;
        const float r = rsqrtf(avss[rowbase + row] * (1.f / 512.f) + EPS);
        const int c0 = part * 32;
#pragma unroll
        for (int i = 0; i < 4; ++i) { const u32x4 w = *(const u32x4*)(rp + g * 128 + c0 + i * 8); const float* nw = vnw + g * 128 + c0 + i * 8;
            const f32x4 n0 = *(const f32x4*)nw, n1 = *(const f32x4*)(nw + 4); u32x4 o;
            o.x = att::cvtpk_s(bf_lo(w.x) * r * n0[0], bf_hi(w.x) * r * n0[1]); o.y = att::cvtpk_s(bf_lo(w.y) * r * n0[2], bf_hi(w.y) * r * n0[3]);
            o.z = att::cvtpk_s(bf_lo(w.z) * r * n1[0], bf_hi(w.z) * r * n1[1]); o.w = att::cvtpk_s(bf_lo(w.w) * r * n1[2], bf_hi(w.w) * r * n1[3]);
            *(LAS u32x4*)(lds + row * VSTR + (c0 + i * 8) * 2) = o; }
#pragma unroll
        for (int i = 0; i < 4; ++i) { const int e8 = (i * 512 + tid) * 8, t = e8 >> 7, s0 = e8 & 127; f32x4 a = *(const f32x4*)(ws_g + e8), b = *(const f32x4*)(ws_g + e8 + 4);
#pragma unroll
            for (int e = 0; e < 4; ++e) { if (s0 + e > t) a[e] = 0.f; if (s0 + 4 + e > t) b[e] = 0.f; }
            u32x4 o; o.x = att::cvtpk_s(a[0], a[1]); o.y = att::cvtpk_s(a[2], a[3]); o.z = att::cvtpk_s(b[0], b[1]); o.w = att::cvtpk_s(b[2], b[3]);
            *(LAS u32x4*)(lds + W_OFF + t * WSTR + s0 * 2) = o; }
    }
    __syncthreads();
    const int cb = wid & 3;
    const LAS unsigned char* vp = lds + (8 * hi + ((lane & 15) >> 2)) * VSTR + (32 * cb + 16 * ((lane >> 4) & 1) + 4 * (lane & 3)) * 2;
#pragma unroll
    for (int pass = 0; pass < 2; ++pass) {
        const int tb = pass == 0 ? (wid >> 2) : 3 - (wid >> 2);
        att::f32x16 acc;
#pragma unroll
        for (int r = 0; r < 16; ++r) acc[r] = 0.f;
        const LAS unsigned char* wp = lds + W_OFF + (32 * tb + r32) * WSTR + hi * 16;
        const int nk = 2 * (tb + 1);
        for (int kk = 0; kk < nk; ++kk) {
            const att::s16x4 vlo = att::vtr(vp + (16 * kk) * VSTR), vhi = att::vtr(vp + (16 * kk + 4) * VSTR);
            const att::bf16x8 A = (att::bf16x8){vlo[0], vlo[1], vlo[2], vlo[3], vhi[0], vhi[1], vhi[2], vhi[3]};
            const att::bf16x8 B = *(const LAS att::bf16x8*)(wp + kk * 32);
            acc = __builtin_amdgcn_mfma_f32_32x32x16_bf16(A, B, acc, 0, 0, 0);
        }
        const int t = 32 * tb + r32; const float bsv = bs_g[t];
        u32x2 uua[4];
#pragma unroll
        for (int rg = 0; rg < 4; ++rg) uua[rg] = *(const u32x2*)(PM + (size_t)(rowbase + t) * NPM + C_AU + g * 128 + 32 * cb + 8 * rg + 4 * hi);
#pragma unroll
        for (int rg = 0; rg < 4; ++rg) { const int c = 32 * cb + 8 * rg + 4 * hi;
            const u32x2 uu = uua[rg];
            u32x2 o; o.x = att::cvtpk_s(bf_lo(uu.x) * (acc[4 * rg] + bsv), bf_hi(uu.x) * (acc[4 * rg + 1] + bsv)); o.y = att::cvtpk_s(bf_lo(uu.y) * (acc[4 * rg + 2] + bsv), bf_hi(uu.y) * (acc[4 * rg + 3] + bsv));
            *(u32x2*)(obase + (size_t)(rowbase + t) * opitch + g * 128 + c) = o; }
    }
}

__device__ __forceinline__ void conv_items(bf16_t* PM, bf16_t* obase, int opitch, const float* cw, int gtid, int gthreads) {
    const int c0 = (gtid & 63) * 8;
    float cwv[3][8];
#pragma unroll
    for (int j = 0; j < 3; ++j)
#pragma unroll
        for (int e = 0; e < 8; ++e) cwv[j][e] = cw[j * 512 + c0 + e];
    for (int idx = gtid; idx < M * 64; idx += 4 * gthreads) {
        u32x4 A[4][3], B[4][3], CB[4];
#pragma unroll
        for (int u = 0; u < 4; ++u) { const int i = (idx + u * gthreads < M * 64) ? idx + u * gthreads : idx; const int row = i >> 6, spos = row & (SEQ - 1);
            const bf16_t* rp = PM + (size_t)row * NPM;
#pragma unroll
            for (int j = 0; j < 3; ++j) { const int dt = (spos >= 2 - j) ? 2 - j : 0; A[u][j] = *(const u32x4*)(rp - (size_t)dt * NPM + C_CC + c0); B[u][j] = *(const u32x4*)(rp - (size_t)dt * NPM + C_CX + c0); }
            CB[u] = *(const u32x4*)(rp + C_CB + c0); }
#pragma unroll
        for (int u = 0; u < 4; ++u) { const int i = idx + u * gthreads; if (i < M * 64) { const int row = i >> 6, spos = row & (SEQ - 1);
            float y[8];
#pragma unroll
            for (int e = 0; e < 8; ++e) y[e] = 0.f;
#pragma unroll
            for (int j = 0; j < 3; ++j) { const float mk = (spos >= 2 - j) ? 1.f : 0.f; const u32x4 a = A[u][j], b2 = B[u][j];
                y[0] += mk * cwv[j][0] * (bf_lo(a.x) * bf_lo(b2.x)); y[1] += mk * cwv[j][1] * (bf_hi(a.x) * bf_hi(b2.x)); y[2] += mk * cwv[j][2] * (bf_lo(a.y) * bf_lo(b2.y)); y[3] += mk * cwv[j][3] * (bf_hi(a.y) * bf_hi(b2.y));
                y[4] += mk * cwv[j][4] * (bf_lo(a.z) * bf_lo(b2.z)); y[5] += mk * cwv[j][5] * (bf_hi(a.z) * bf_hi(b2.z)); y[6] += mk * cwv[j][6] * (bf_lo(a.w) * bf_lo(b2.w)); y[7] += mk * cwv[j][7] * (bf_hi(a.w) * bf_hi(b2.w)); }
            const u32x4 cb = CB[u];
            u32x4 w; w.x = cvt_pk_bf16(bf_lo(cb.x) * y[0], bf_hi(cb.x) * y[1]); w.y = cvt_pk_bf16(bf_lo(cb.y) * y[2], bf_hi(cb.y) * y[3]);
            w.z = cvt_pk_bf16(bf_lo(cb.z) * y[4], bf_hi(cb.z) * y[5]); w.w = cvt_pk_bf16(bf_lo(cb.w) * y[6], bf_hi(cb.w) * y[7]);
            *(u32x4*)(obase + (size_t)row * opitch + c0) = w; } }
    }
}

constexpr int N_PHASES = 1 + 6 * DEPTH;
__global__ void __launch_bounds__(NWAVES * 64, 2) fwd_kernel(Args args) {
    extern __shared__ __attribute__((aligned(16))) unsigned char lds_raw[];
    LAS unsigned char* lds = (LAS unsigned char*)lds_raw;
    const int G = gridDim.x, bx = blockIdx.x, ngw = G * NWAVES, gthreads = G * NWAVES * 64;
#define TIDS() int tid_ = threadIdx.x; asm volatile("" : "+v"(tid_)); const int tid = tid_, lane = tid & 63, wave = __builtin_amdgcn_readfirstlane(tid >> 6), gw = bx * NWAVES + wave, gtid = bx * (NWAVES * 64) + tid; (void)lane; (void)gw; (void)gtid
    unsigned char* ws = args.ws;
    float* ROWSS = (float*)(ws + WS_CTL);
    bf16_t* XB = (bf16_t*)(ws + WS_XB); bf16_t* PM = (bf16_t*)(ws + WS_PM); bf16_t* XBM = (bf16_t*)(ws + WS_PM); bf16_t* HB = (bf16_t*)(ws + WS_HB);
    unsigned char* G8 = ws + WS_G8;
    const int lo = args.ph_lo, hi = args.ph_hi;
#if !MK_MULTI
    cg::grid_group grid = cg::this_grid();
    volatile LAS unsigned* bst = (volatile LAS unsigned*)(lds + RING_BYTES + 512);
    if (threadIdx.x < 2) bst[threadIdx.x] = 0u;
    __syncthreads();
    const XcdBarrier xbar = xcd_barrier_post((unsigned*)(ws + WS_BAR), bst);
#define SEAM(ph) do { if ((ph) + 1 < hi) { if (PROBE != 12 && hi > 1000) grid.sync();   xcd_barrier(xbar); if (PROBE == 6) { xcd_barrier(xbar); xcd_barrier(xbar); } } } while (0)
#else
#define SEAM(ph) do { } while (0)
#endif
#define IN(k) (lo <= (k) && (k) < hi)
#if PROBE >= 20
    unsigned long long tp_acc = 0, tp_t0 = 0;
#define TP_BEGIN(type) do { if (PROBE - 20 == (type)) tp_t0 = __builtin_amdgcn_s_memrealtime(); } while (0)
#define TP_END(type) do { if (PROBE - 20 == (type)) tp_acc += __builtin_amdgcn_s_memrealtime() - tp_t0; } while (0)
#else
#define TP_BEGIN(type) do { } while (0)
#define TP_END(type) do { } while (0)
#endif

    TP_BEGIN(0);
    if (IN(0)) {
        TIDS();
        for (int rep = 0; rep < (PROBE == 1 ? 2 : 1); ++rep) {
        convert_region_a(args, 0, lds, gw, ngw, wave, lane);
        convert_region_b(args, 0, lds, gw, ngw, wave, lane); }
        const float* x = args.in[0];
        for (int r = gw; r < M; r += 2 * ngw) {
            const int r2 = (r + ngw < M) ? r + ngw : r;
            const f32x4* xr = (const f32x4*)(x + (size_t)r * DM) + lane; const f32x4* xr2 = (const f32x4*)(x + (size_t)r2 * DM) + lane;
            f32x4 va[4], vb[4];
#pragma unroll
            for (int j = 0; j < 4; ++j) { va[j] = __builtin_nontemporal_load(&xr[64 * j]); vb[j] = __builtin_nontemporal_load(&xr2[64 * j]); }
            u32x2* o = (u32x2*)(XB + (size_t)r * DM) + lane; u32x2* o2 = (u32x2*)(XB + (size_t)r2 * DM) + lane; float s = 0.f, s2 = 0.f;
#pragma unroll
            for (int j = 0; j < 4; ++j) { const f32x4 v = va[j]; s += (v[0] * v[0] + v[1] * v[1]) + (v[2] * v[2] + v[3] * v[3]); u32x2 w; w.x = cvt_pk_bf16(v[0], v[1]); w.y = cvt_pk_bf16(v[2], v[3]); o[64 * j] = w;
                const f32x4 q = vb[j]; s2 += (q[0] * q[0] + q[1] * q[1]) + (q[2] * q[2] + q[3] * q[3]); u32x2 w2; w2.x = cvt_pk_bf16(q[0], q[1]); w2.y = cvt_pk_bf16(q[2], q[3]); o2[64 * j] = w2; }
            s = wave_sum(s); s2 = wave_sum(s2); if (lane == 0) { ROWSS[r] = s; ROWSS[r2] = s2; }
        }
        SEAM(0);
    }
    TP_END(0);
    for (int l = 0; l < DEPTH; ++l) {
        const int pb = 1 + 6 * l;
        const float* xres_in = (l == 0) ? args.in[0] : args.out;
        TP_BEGIN(1);
        if (IN(pb + 0)) {
            pg8::Gemm g{XB, (const bf16_t*)(ws + WS_WIN), DM, DM, 0, 0, 0}; pg8::StaticOrder S; S.init(M, NIN, G, bx, 1, WGM_IN);
            EpiInProj E{PM, G8, ROWSS + (size_t)(2 * l) * M, args.in[3] + l * NG, args.in[7] + l * 128, args.in[8] + l * 128, ROWSS + (size_t)(4 + l) * M};
            pg8::gemm_phase<EpiInProj, pg8::StaticOrder>(lds, g, S, E);
#if PROBE == 2
            pg8::gemm_phase<EpiInProj, pg8::StaticOrder>(lds, g, S, E);
#endif
            SEAM(pb + 0);
        }
        TP_END(1);
        TP_BEGIN(2);
        if (IN(pb + 1)) {
            TIDS();
            if (l == 1) convert_region_b(args, 1, lds, gw, ngw, wave, lane);
            const float* lp = args.in[9] + l * 256;
            const float sa = wave_sum(lp[lane] * lp[64 + lane]), sb = wave_sum(lp[128 + lane] * lp[192 + lane]);
            const float lam_init = 0.8f - 0.6f * expf(-0.3f * (float)l);
            const float lam = expf(sa) - expf(sb) + lam_init;
#if PROBE == 4
            for (int pi = bx; pi < 256; pi += G) { const int bh = pi >> 4, sq = pi & 15;
                att::attn_unit(PM, XB, DM, bh >> 2, bh & 3, 31 - sq, lam, 1.f - lam_init, args.in[10] + l * 128, args.in[8] + l * 128, lds, tid);
                att::attn_unit(PM, XB, DM, bh >> 2, bh & 3, sq, lam, 1.f - lam_init, args.in[10] + l * 128, args.in[8] + l * 128, lds, tid); }
#endif
            for (int pi = bx; pi < 256; pi += G) { const int bh = pi >> 4, sq = pi & 15;
                att::attn_unit(PM, PM + C_Q, NPM, bh >> 2, bh & 3, 31 - sq, lam, 1.f - lam_init, args.in[10] + l * 128, args.in[8] + l * 128, lds, tid);
                att::attn_unit(PM, PM + C_Q, NPM, bh >> 2, bh & 3, sq, lam, 1.f - lam_init, args.in[10] + l * 128, args.in[8] + l * 128, lds, tid); }
#if PROBE == 5
            for (int uu = bx; uu < 512; uu += G) { const int g4 = uu & 3, blk = uu >> 2;
                gmlp_unit(PM, XB, DM, ROWSS + (size_t)(4 + l) * M, args.in[4] + l * 512, args.in[5] + (size_t)(l * 4 + g4) * 16384, args.in[6] + (l * 4 + g4) * 128, blk * 128, g4, lds, tid); }
#endif
            for (int uu = bx; uu < 512; uu += G) { const int g4 = uu & 3, blk = uu >> 2;
                gmlp_unit(PM, PM + C_AU, NPM, ROWSS + (size_t)(4 + l) * M, args.in[4] + l * 512, args.in[5] + (size_t)(l * 4 + g4) * 16384, args.in[6] + (l * 4 + g4) * 128, blk * 128, g4, lds, tid); }
#if PROBE == 8
            conv_items(PM, XB, DM, args.in[11] + l * 1536, gtid, gthreads);
#endif
            conv_items(PM, PM + C_CB, NPM, args.in[11] + l * 1536, gtid, gthreads);
            SEAM(pb + 1);
        }
        TP_END(2);
        TP_BEGIN(3);
        if (IN(pb + 2)) {
            pg8::Gemm g{PM + C_AU, (const bf16_t*)(ws + WS_WBR), NPM, 512, (size_t)(C_Q - C_AU) * 2, (size_t)(C_CB - C_AU) * 2, MiB}; pg8::StaticOrder S; S.init(M, DM, G, bx, 3, WGM_N1);
            EpiBranch E{(bf16_t*)args.out, G8};
            pg8::gemm_phase<EpiBranch, pg8::StaticOrder>(lds, g, S, E);
#if PROBE == 7
            pg8::gemm_phase<EpiBranch, pg8::StaticOrder>(lds, g, S, E);
#endif
            SEAM(pb + 2);
        }
        TP_END(3);
        TP_BEGIN(4);
        if (IN(pb + 3)) {
            pg8::Gemm g{(const bf16_t*)args.out, (const bf16_t*)(ws + WS_WOUT), DM, DM, 0, 0, 0}; pg8::StaticOrder S; S.init(M, DM, G, bx, 1, WGM_N1);
            EpiResid E{(l == 0) ? args.in[0] : nullptr, (l == 0) ? nullptr : XB, nullptr, XBM, ROWSS + (size_t)(2 * l + 1) * M};
#if 0
            { EpiResid E2{args.in[0], (float*)(ws + WS_HB), nullptr, nullptr}; pg8::gemm_phase<EpiResid, pg8::StaticOrder>(lds, g, S, E2); }
#endif
            pg8::gemm_phase<EpiResid, pg8::StaticOrder>(lds, g, S, E);
            SEAM(pb + 3);
        }
        TP_END(4);
        TP_BEGIN(5);
        if (IN(pb + 4)) {
            if (l == 0) { TIDS(); convert_region_a(args, 1, lds, gw, ngw, wave, lane); }
            __syncthreads();
            pg8::Gemm g{XBM, (const bf16_t*)(ws + WS_WF1), DM, DM, 0, 0, 0}; pg8::StaticOrder S; S.init(M, FF, G, bx, 1, WGM_FF);
            EpiFF1 E{HB, ROWSS + (size_t)(2 * l + 1) * M, FF};
            pg8::gemm_phase<EpiFF1, pg8::StaticOrder>(lds, g, S, E);
#if PROBE == 3
            pg8::gemm_phase<EpiFF1, pg8::StaticOrder>(lds, g, S, E);
#endif
            SEAM(pb + 4);
        }
        TP_END(5);
        TP_BEGIN(6);
        if (IN(pb + 5)) {
            pg8::Gemm g{HB, (const bf16_t*)(ws + WS_WF2), FF, FF, 0, 0, 0}; pg8::StaticOrder S; S.init(M, DM, G, bx, 1, WGM_N1);
            EpiResid E{nullptr, XBM, (l + 1 < DEPTH) ? nullptr : args.out, (l + 1 < DEPTH) ? XB : nullptr, ROWSS + (size_t)(2 * l + 2 < 4 ? 2 * l + 2 : 0) * M};
#if 0
            { EpiFF1 E2{XBM, ROWSS + (size_t)(2 * l + 1) * M, DM}; pg8::gemm_phase<EpiFF1, pg8::StaticOrder>(lds, g, S, E2); }
#endif
            pg8::gemm_phase<EpiResid, pg8::StaticOrder>(lds, g, S, E);
            SEAM(pb + 5);
        }
        TP_END(6);
    }
#if PROBE >= 20
    if (blockIdx.x == 0 && threadIdx.x == 0) { const unsigned long long tb = __builtin_amdgcn_s_memrealtime(); while (__builtin_amdgcn_s_memrealtime() - tb < 4 * tp_acc) __builtin_amdgcn_s_sleep(8); }
#endif
#undef IN
#undef SEAM
}

extern "C" void kernel_launch(void* const* d_in, const int* in_sizes, int n_in, void* d_out, int out_size, void* d_ws, size_t ws_size, hipStream_t stream) {
    static int grid = 0;
    if (grid == 0) {
        if (n_in != 19 || in_sizes[0] != M * DM || out_size != M * DM || ws_size < WS_END) { fprintf(stderr, "kernel_launch: unexpected shapes / workspace (%d inputs, ws %zu)\n", n_in, ws_size); grid = -1; return; }
        int dev = 0, cus = 0, per_cu = 0;
        if (hipGetDevice(&dev) != hipSuccess || hipDeviceGetAttribute(&cus, hipDeviceAttributeMultiprocessorCount, dev) != hipSuccess) { grid = -1; return; }
        if (hipFuncSetAttribute((const void*)fwd_kernel, hipFuncAttributeMaxDynamicSharedMemorySize, LDS_BYTES) != hipSuccess) { fprintf(stderr, "kernel_launch: hipFuncSetAttribute failed\n"); grid = -1; return; }
        if (hipOccupancyMaxActiveBlocksPerMultiprocessor(&per_cu, (const void*)fwd_kernel, NWAVES * 64, LDS_BYTES) != hipSuccess || per_cu < 1) { fprintf(stderr, "kernel_launch: occupancy query says %d blocks per CU\n", per_cu); grid = -1; return; }
        grid = cus;
    }
    if (grid < 0) return;
    (void)hipMemsetAsync((char*)d_ws + WS_CTL, 0, CTL_BYTES, stream);
#if PROBE == 11
    (void)hipMemsetAsync((char*)d_ws + WS_END, 0, CTL_BYTES, stream);
    (void)hipMemsetAsync((char*)d_ws + WS_END + CTL_BYTES, 0, CTL_BYTES, stream);
#endif
    Args a{};
    for (int i = 0; i < 19; ++i) a.in[i] = (const float*)d_in[i];
    a.out = (float*)d_out; a.ws = (unsigned char*)d_ws;
#if MK_MULTI
    for (int p = 0; p < N_PHASES; ++p) { a.ph_lo = p; a.ph_hi = p + 1; hipLaunchKernelGGL(fwd_kernel, dim3(grid), dim3(NWAVES * 64), LDS_BYTES, stream, a); }
#else
    a.ph_lo = 0; a.ph_hi = N_PHASES;
    void* kargs[] = {&a};
#if PROBE == 12
    (void)kargs; hipLaunchKernelGGL(fwd_kernel, dim3(grid), dim3(NWAVES * 64), LDS_BYTES, stream, a); hipError_t e = hipSuccess;
#else
    hipError_t e = hipLaunchCooperativeKernel((const void*)fwd_kernel, dim3(grid), dim3(NWAVES * 64), kargs, LDS_BYTES, stream);
#endif
    if (e != hipSuccess) fprintf(stderr, "kernel_launch: cooperative launch failed: %s (grid %d)\n", hipGetErrorString(e), grid);
#endif
}
```
